# Optimizing an MI355X kernel written in HIP

```python
import jax, jax.numpy as jnp
from jax import lax
import numpy as np

D_MODEL = 1024
BATCH = 2
SEQ = 8192
DEPTH = 1
DEC_BATCH = 32
DEC_SEQ = 1
PAST_LEN = 8192
PAGE_SIZE = 128

HEAD_DIM = 64
NSA_HEADS = 8
NSA_KV_HEADS = 2
NSA_REP = NSA_HEADS // NSA_KV_HEADS
CMP_LEN = 32
CMP_STRIDE = 16
SEL_LEN = 64
SEL_TOPK = 16
WINDOW = 512
Q_BLOCK = 128
ROPE_THETA = 10000.0
GDN_HEADS = 4
GDN_DK = 128
GDN_DV = 128
CONV_W = 4
GDN_CHUNK = 64
NSA_Q_W = NSA_HEADS * HEAD_DIM
NSA_KV_W = NSA_KV_HEADS * HEAD_DIM
GDN_QK_W = GDN_HEADS * GDN_DK
GDN_V_W = GDN_HEADS * GDN_DV
GDN_CONV_CH = 2 * GDN_QK_W + GDN_V_W
MIX_W = NSA_Q_W + GDN_V_W
IN_W = NSA_Q_W + 6 * NSA_KV_W + 3 * NSA_HEADS + GDN_CONV_CH + GDN_V_W + 2 * GDN_HEADS
_FF_RAW = -(-8 * D_MODEL // 3)
D_FF = -(-_FF_RAW // 256) * 256
NEG = -1e30
SEL_BONUS = 1e4
EPS = 1e-6

kernel_name = 'hybrid_nsa_gdn_decode_step'

F32 = jnp.float32


def rms_norm(x, g):
    xf = x.astype(F32)
    y = xf * lax.rsqrt(jnp.mean(xf * xf, axis=-1, keepdims=True) + EPS)
    return (y * g.astype(F32)).astype(x.dtype)


def rope(x, pos):
    half = HEAD_DIM // 2
    inv = jnp.power(ROPE_THETA, -jnp.arange(half, dtype=F32) * 2.0 / HEAD_DIM)
    ang = pos.astype(F32)[:, None] * inv[None, :]
    cos = jnp.cos(ang)[None, :, None, :]
    sin = jnp.sin(ang)[None, :, None, :]
    xf = x.astype(F32)
    x1, x2 = xf[..., :half], xf[..., half:]
    return jnp.concatenate([x1 * cos - x2 * sin, x2 * cos + x1 * sin], axis=-1).astype(x.dtype)


def masked_softmax(s, mask):
    p = jax.nn.softmax(jnp.where(mask, s, NEG), axis=-1)
    return jnp.where(mask, p, 0.0)


def l2norm(x):
    return x * lax.rsqrt(jnp.sum(x * x, axis=-1, keepdims=True) + EPS)


def split_proj(proj, pos):
    B, T, _ = proj.shape
    G, R, dh = NSA_KV_HEADS, NSA_REP, HEAD_DIM
    cuts = np.cumsum([NSA_Q_W, 6 * NSA_KV_W, 3 * NSA_HEADS, GDN_CONV_CH, GDN_V_W, GDN_HEADS]).tolist()
    q, kv, gt, conv_in, z, a, b = jnp.split(proj, cuts, axis=-1)
    q = rope(q.reshape(B, T, NSA_HEADS, dh), pos).reshape(B, T, G, R, dh)
    kv = kv.reshape(B, T, 3, 2, G, dh)
    k = rope(kv[:, :, :, 0].reshape(B, T, 3 * G, dh), pos).reshape(B, T, 3, G, dh)
    v = kv[:, :, :, 1]
    kv4 = jnp.stack([k[:, :, 0], v[:, :, 0], k[:, :, 1], v[:, :, 1]], axis=2)
    kvw = jnp.stack([k[:, :, 2], v[:, :, 2]], axis=2)
    gates = jax.nn.sigmoid(gt.astype(F32)).reshape(B, T, G, R, 3)
    return q, gates, kv4, kvw, conv_in, z, a, b


def compress(k, pe, w):
    L = k.shape[1]
    n_cmp = (L - CMP_LEN) // CMP_STRIDE + 1
    idx = jnp.arange(n_cmp)[:, None] * CMP_STRIDE + jnp.arange(CMP_LEN)[None, :]
    blk = k[:, idx] + pe[None, None, :, None, :]
    return jnp.einsum('bnlgd,lde->bnge', blk, w)


def sel_blocks(k):
    B, L, G, dh = k.shape
    n_sel = -(-L // SEL_LEN)
    kp = jnp.pad(k, ((0, 0), (0, n_sel * SEL_LEN - L), (0, 0), (0, 0)))
    return kp.reshape(B, n_sel, SEL_LEN, G, dh).transpose(0, 3, 1, 2, 4)


def cmp_to_sel(n_cmp, n_sel):
    cs = jnp.arange(n_cmp)[:, None] * CMP_STRIDE
    ss = jnp.arange(n_sel)[None, :] * SEL_LEN
    return ((cs < ss + SEL_LEN) & (cs + CMP_LEN > ss)).astype(F32)


def nsa_core(q, q_pos, gates, ck, cv, ksb, vsb, kw, vw, kw_pos):
    B, Tq, G, R, dh = q.shape
    n_cmp = ck.shape[1]
    n_sel = ksb.shape[2]
    qf = q.astype(F32) * (HEAD_DIM ** -0.5)
    cmp_end = jnp.arange(n_cmp) * CMP_STRIDE + CMP_LEN - 1
    m_cmp = (cmp_end[None, :] <= q_pos[:, None])[None, :, None, None, :]
    p_cmp = masked_softmax(jnp.einsum('bqgrd,bngd->bqgrn', qf, ck.astype(F32)), m_cmp)
    o_cmp = jnp.einsum('bqgrn,bngd->bqgrd', p_cmp, cv.astype(F32))
    imp = jnp.einsum('bqgrn,ns->bqgs', p_cmp, cmp_to_sel(n_cmp, n_sel))
    blk = jnp.arange(n_sel)[None, :]
    cur = (q_pos // SEL_LEN)[:, None]
    valid = blk * SEL_LEN <= q_pos[:, None]
    forced = (blk == 0) | (blk == cur) | (blk == cur - 1)
    score = jnp.where(valid[None, :, None, :], imp + jnp.where(forced, SEL_BONUS, 0.0)[None, :, None, :], NEG)
    top_val, top_idx = lax.top_k(score, min(SEL_TOPK, n_sel))
    kk = top_idx.shape[-1]
    idx = top_idx.transpose(0, 2, 1, 3)
    sel_ok = (top_val > NEG / 2).transpose(0, 2, 1, 3)
    bi = jnp.arange(B)[:, None, None, None]
    gi = jnp.arange(G)[None, :, None, None]
    kg = ksb[bi, gi, idx]
    vg = vsb[bi, gi, idx]
    tok = idx[..., None] * SEL_LEN + jnp.arange(SEL_LEN)
    m_sel = ((tok <= q_pos[None, None, :, None, None]) & sel_ok[..., None]).reshape(B, G, Tq, 1, kk * SEL_LEN)
    s_sel = jnp.einsum('bqgrd,bgqkld->bgqrkl', qf, kg.astype(F32)).reshape(B, G, Tq, R, kk * SEL_LEN)
    p_sel = masked_softmax(s_sel, m_sel).reshape(B, G, Tq, R, kk, SEL_LEN)
    o_sel = jnp.einsum('bgqrkl,bgqkld->bqgrd', p_sel, vg.astype(F32))
    m_win = ((kw_pos[None, :] <= q_pos[:, None]) & (kw_pos[None, :] >= q_pos[:, None] - WINDOW)
             & (kw_pos[None, :] >= 0))[None, :, None, None, :]
    p_win = masked_softmax(jnp.einsum('bqgrd,bsgd->bqgrs', qf, kw.astype(F32)), m_win)
    o_win = jnp.einsum('bqgrs,bsgd->bqgrd', p_win, vw.astype(F32))
    g = gates.astype(F32)
    return g[..., 0:1] * o_cmp + g[..., 1:2] * o_sel + g[..., 2:3] * o_win


def nsa_prompt(q, gates, kv4, kvw, pe, wc):
    B, T, G, R, dh = q.shape
    ck = compress(kv4[:, :, 0], pe[0], wc[0])
    cv = compress(kv4[:, :, 1], pe[1], wc[1])
    ksb = sel_blocks(kv4[:, :, 2])
    vsb = sel_blocks(kv4[:, :, 3])
    padw = ((0, 0), (WINDOW, 0), (0, 0), (0, 0))
    kwp = jnp.pad(kvw[:, :, 0], padw)
    vwp = jnp.pad(kvw[:, :, 1], padw)
    nb = T // Q_BLOCK
    qb = q.reshape(B, nb, Q_BLOCK, G, R, dh).swapaxes(0, 1)
    gb = gates.reshape(B, nb, Q_BLOCK, G, R, 3).swapaxes(0, 1)

    def block(args):
        qi, gi, i = args
        start = i * Q_BLOCK
        q_pos = start + jnp.arange(Q_BLOCK)
        kw = lax.dynamic_slice_in_dim(kwp, start, WINDOW + Q_BLOCK, axis=1)
        vw = lax.dynamic_slice_in_dim(vwp, start, WINDOW + Q_BLOCK, axis=1)
        kw_pos = start - WINDOW + jnp.arange(WINDOW + Q_BLOCK)
        return nsa_core(qi, q_pos, gi, ck, cv, ksb, vsb, kw, vw, kw_pos)

    ob = lax.map(block, (qb, gb, jnp.arange(nb, dtype=jnp.int32)))
    return ob.swapaxes(0, 1).reshape(B, T, NSA_Q_W)


def nsa_sample(q, gates, kv4, kvw, kv_past, win_buf, pos, pe, wc):
    B, T = q.shape[0], q.shape[1]
    P = kv_past.shape[1]
    W = win_buf.shape[1]
    kv_all = jnp.concatenate([kv_past.astype(kv4.dtype), kv4], axis=1)
    ck = compress(kv_all[:, :, 0], pe[0], wc[0])
    cv = compress(kv_all[:, :, 1], pe[1], wc[1])
    ksb = sel_blocks(kv_all[:, :, 2])
    vsb = sel_blocks(kv_all[:, :, 3])
    kw_all = jnp.concatenate([win_buf.astype(kvw.dtype), kvw], axis=1)
    kw_pos = P - W + jnp.arange(W + T)
    o = nsa_core(q, pos, gates, ck, cv, ksb, vsb, kw_all[:, :, 0], kw_all[:, :, 1], kw_pos)
    new_win = kw_all[:, -min(WINDOW, P + T):]
    return o.reshape(B, T, NSA_Q_W), new_win


def gated_delta(q, k, v, g, beta, S0, C):
    B, T, H, dk = q.shape
    dv = v.shape[-1]
    N = T // C
    qc = q.reshape(B, N, C, H, dk).transpose(1, 0, 3, 2, 4)
    kc = k.reshape(B, N, C, H, dk).transpose(1, 0, 3, 2, 4)
    vc = v.reshape(B, N, C, H, dv).transpose(1, 0, 3, 2, 4)
    gc = g.reshape(B, N, C, H).transpose(1, 0, 3, 2)
    bc = beta.reshape(B, N, C, H).transpose(1, 0, 3, 2)
    gcum = jnp.cumsum(gc, axis=-1)
    ii = jnp.arange(C)[:, None]
    jj = jnp.arange(C)[None, :]
    incl = ii >= jj
    strict = ii > jj
    diff = gcum[..., :, None] - gcum[..., None, :]
    dec = jnp.where(incl, jnp.exp(jnp.where(incl, diff, 0.0)), 0.0)
    kb = kc * bc[..., None]
    Lm = jnp.where(strict, jnp.einsum('nbhid,nbhjd->nbhij', kb, kc) * dec, 0.0)
    A = Lm + jnp.eye(C, dtype=F32)
    rhs = jnp.concatenate([vc * bc[..., None], kb * jnp.exp(gcum)[..., None]], axis=-1)
    sol = lax.linalg.triangular_solve(A, rhs, left_side=True, lower=True)
    u, w = sol[..., :dv], sol[..., dv:]
    aqk = jnp.einsum('nbhid,nbhjd->nbhij', qc, kc) * dec
    qg = qc * jnp.exp(gcum)[..., None]
    kg = kc * jnp.exp(gcum[..., -1:] - gcum)[..., None]
    glast = jnp.exp(gcum[..., -1])

    def step(S, xs):
        u_i, w_i, aqk_i, qg_i, kg_i, gl_i = xs
        vn = u_i - jnp.einsum('bhck,bhkv->bhcv', w_i, S)
        o = jnp.einsum('bhck,bhkv->bhcv', qg_i, S) + jnp.einsum('bhij,bhjv->bhiv', aqk_i, vn)
        S = S * gl_i[..., None, None] + jnp.einsum('bhck,bhcv->bhkv', kg_i, vn)
        return S, o

    S, o = lax.scan(step, S0, (u, w, aqk, qg, kg, glast))
    return o.transpose(1, 0, 3, 2, 4).reshape(B, T, H, dv), S


def gdn_mixer(conv_in, z, a, b, conv_buf, S0, conv_w, a_log, dt_bias, norm_w, chunk):
    B, T, _ = conv_in.shape
    xp = jnp.concatenate([conv_buf.astype(conv_in.dtype), conv_in], axis=1)
    conv = xp[:, 0:T] * conv_w[0]
    for j in range(1, CONV_W):
        conv = conv + xp[:, j:j + T] * conv_w[j]
    c = jax.nn.silu(conv.astype(F32))
    qg, kg, vg = jnp.split(c, [GDN_QK_W, 2 * GDN_QK_W], axis=-1)
    qg = l2norm(qg.reshape(B, T, GDN_HEADS, GDN_DK)) * (GDN_DK ** -0.5)
    kg = l2norm(kg.reshape(B, T, GDN_HEADS, GDN_DK))
    vg = vg.reshape(B, T, GDN_HEADS, GDN_DV)
    beta = jax.nn.sigmoid(b.astype(F32))
    g = -jnp.exp(a_log.astype(F32)) * jax.nn.softplus(a.astype(F32) + dt_bias.astype(F32))
    o, S = gated_delta(qg, kg, vg, g, beta, S0.astype(F32), chunk)
    o = o * lax.rsqrt(jnp.mean(o * o, axis=-1, keepdims=True) + EPS) * norm_w.astype(F32)
    o = o * jax.nn.silu(z.astype(F32).reshape(B, T, GDN_HEADS, GDN_DV))
    return o.reshape(B, T, GDN_V_W), S, xp[:, -(CONV_W - 1):]


def channel_mix(h, g, w_gate_up, w_down):
    gate, up = jnp.split(rms_norm(h, g) @ w_gate_up, 2, axis=-1)
    return h + (jax.nn.silu(gate) * up) @ w_down


def setup_inputs(seed: int = 0) -> dict:
    key = jax.random.key(seed)
    ks = jax.random.split(key, 20)
    n_pages = PAST_LEN // PAGE_SIZE
    n_pool = DEC_BATCH * n_pages * 5 // 4
    w_buf = min(WINDOW, PAST_LEN)
    G, dh = NSA_KV_HEADS, HEAD_DIM
    nrm = jax.random.normal
    page_table = jax.random.permutation(ks[0], n_pool)[:DEC_BATCH * n_pages].reshape(DEC_BATCH, n_pages).astype(jnp.int32)
    return {
        'x_prompt': nrm(ks[1], (BATCH, SEQ, D_MODEL), F32),
        'x_sample': nrm(ks[2], (DEC_BATCH, DEC_SEQ, D_MODEL), F32),
        'cache_nsa_kv': nrm(ks[3], (DEPTH, n_pool, PAGE_SIZE, 4, G, dh), F32),
        'cache_nsa_win': nrm(ks[4], (DEPTH, DEC_BATCH, w_buf, 2, G, dh), F32),
        'state_gdn_S': 0.1 * nrm(ks[5], (DEPTH, DEC_BATCH, GDN_HEADS, GDN_DK, GDN_DV), F32),
        'state_gdn_conv': nrm(ks[6], (DEPTH, DEC_BATCH, CONV_W - 1, GDN_CONV_CH), F32),
        'page_table': page_table,
        'norm_mix': 1.0 + 0.02 * nrm(ks[7], (DEPTH, D_MODEL), F32),
        'w_in': nrm(ks[8], (DEPTH, D_MODEL, IN_W), F32) * D_MODEL ** -0.5,
        'nsa_cmp_pe': 0.1 * nrm(ks[9], (DEPTH, 2, CMP_LEN, dh), F32),
        'nsa_cmp_w': nrm(ks[10], (DEPTH, 2, CMP_LEN, dh, dh), F32) * (CMP_LEN * dh) ** -0.5,
        'gdn_conv_w': 0.5 * nrm(ks[11], (DEPTH, CONV_W, GDN_CONV_CH), F32),
        'gdn_a_log': jnp.log(jax.random.uniform(ks[12], (DEPTH, GDN_HEADS), F32, 1.0, 16.0)),
        'gdn_dt_bias': jnp.log(jnp.expm1(jax.random.uniform(ks[13], (DEPTH, GDN_HEADS), F32, 0.001, 0.1))),
        'gdn_norm': 1.0 + 0.02 * nrm(ks[14], (DEPTH, GDN_DV), F32),
        'w_out': nrm(ks[15], (DEPTH, MIX_W, D_MODEL), F32) * MIX_W ** -0.5,
        'norm_ffn': 1.0 + 0.02 * nrm(ks[16], (DEPTH, D_MODEL), F32),
        'w_gate_up': nrm(ks[17], (DEPTH, D_MODEL, 2 * D_FF), F32) * D_MODEL ** -0.5,
        'w_down': nrm(ks[18], (DEPTH, D_FF, D_MODEL), F32) * D_FF ** -0.5,
        'norm_final': 1.0 + 0.02 * nrm(ks[19], (D_MODEL,), F32),
    }


def reference(x_prompt, x_sample, cache_nsa_kv, cache_nsa_win, state_gdn_S, state_gdn_conv, page_table,
              norm_mix, w_in, nsa_cmp_pe, nsa_cmp_w, gdn_conv_w, gdn_a_log, gdn_dt_bias, gdn_norm,
              w_out, norm_ffn, w_gate_up, w_down, norm_final):
    Bp, Tp, _ = x_prompt.shape
    Bs, Ts, _ = x_sample.shape
    n_pages = page_table.shape[1]
    past_len = n_pages * PAGE_SIZE
    pos_p = jnp.arange(Tp, dtype=jnp.int32)
    pos_s = past_len + jnp.arange(Ts, dtype=jnp.int32)
    hp, hs = x_prompt, x_sample
    kv_p, win_p, S_p, conv_p = [], [], [], []
    kv_s, win_s, S_s, conv_s = [], [], [], []
    for l in range(DEPTH):
        proj = rms_norm(hp, norm_mix[l]) @ w_in[l]
        q, gates, kv4, kvw, conv_in, z, a, b = split_proj(proj, pos_p)
        o_nsa = nsa_prompt(q, gates, kv4, kvw, nsa_cmp_pe[l], nsa_cmp_w[l])
        buf0 = jnp.zeros((Bp, CONV_W - 1, GDN_CONV_CH), proj.dtype)
        S0 = jnp.zeros((Bp, GDN_HEADS, GDN_DK, GDN_DV), F32)
        o_gdn, S_new, conv_new = gdn_mixer(conv_in, z, a, b, buf0, S0, gdn_conv_w[l], gdn_a_log[l],
                                           gdn_dt_bias[l], gdn_norm[l], min(GDN_CHUNK, Tp))
        hp = hp + jnp.concatenate([o_nsa, o_gdn], axis=-1).astype(hp.dtype) @ w_out[l]
        hp = channel_mix(hp, norm_ffn[l], w_gate_up[l], w_down[l])
        kv_p.append(kv4)
        win_p.append(kvw[:, -min(WINDOW, Tp):])
        S_p.append(S_new)
        conv_p.append(conv_new)
        proj = rms_norm(hs, norm_mix[l]) @ w_in[l]
        q, gates, kv4, kvw, conv_in, z, a, b = split_proj(proj, pos_s)
        kv_past = cache_nsa_kv[l][page_table].reshape(Bs, past_len, 4, NSA_KV_HEADS, HEAD_DIM)
        o_nsa, win_new = nsa_sample(q, gates, kv4, kvw, kv_past, cache_nsa_win[l], pos_s,
                                    nsa_cmp_pe[l], nsa_cmp_w[l])
        o_gdn, S_new, conv_new = gdn_mixer(conv_in, z, a, b, state_gdn_conv[l], state_gdn_S[l],
                                           gdn_conv_w[l], gdn_a_log[l], gdn_dt_bias[l], gdn_norm[l], Ts)
        hs = hs + jnp.concatenate([o_nsa, o_gdn], axis=-1).astype(hs.dtype) @ w_out[l]
        hs = channel_mix(hs, norm_ffn[l], w_gate_up[l], w_down[l])
        kv_s.append(kv4)
        win_s.append(win_new)
        S_s.append(S_new)
        conv_s.append(conv_new)
    y_prompt = rms_norm(hp, norm_final)
    y_sample = rms_norm(hs, norm_final)
    return (y_prompt, y_sample,
            jnp.stack(kv_p), jnp.stack(win_p), jnp.stack(S_p), jnp.stack(conv_p),
            jnp.stack(kv_s), jnp.stack(win_s), jnp.stack(S_s), jnp.stack(conv_s))
```

```cpp
#include <hip/hip_runtime.h>
#include <hip/hip_cooperative_groups.h>
#include <cstdio>
#include <cstdint>
namespace cg = cooperative_groups;

#define DI __device__ __forceinline__
#define LAS __attribute__((address_space(3)))
typedef unsigned short bf16_t;
typedef short bf16x8 __attribute__((ext_vector_type(8)));
typedef short s16x4 __attribute__((ext_vector_type(4)));
typedef float f32x4 __attribute__((ext_vector_type(4)));
typedef float f32x2 __attribute__((ext_vector_type(2)));
typedef float f32x16 __attribute__((ext_vector_type(16)));
typedef unsigned u32x4 __attribute__((ext_vector_type(4)));
typedef unsigned u32x2 __attribute__((ext_vector_type(2)));
typedef __bf16 bf16x2_t __attribute__((ext_vector_type(2)));

constexpr int DM = 1024, TP = 8192, NBP = 2, MP = NBP * TP, NBS = 32, MROWS = 16640  ;
constexpr int HD = 64, NQH = 8, NG = 2, NREP = 4;
constexpr int NPAGES = 64, PAGE = 128, NPOOL = 2560;
constexpr int GH = 4, GDK = 128, GDV = 128, CCH = 1536, NCHUNK = 128;
constexpr int INW = 3360, INW_PAD = 3584, DFF = 2816;
constexpr int NCMP = 511;
constexpr float EPS = 1e-6f, LOG2E = 1.4426950408889634f, QSCALE = 0.125f * LOG2E, NEGBIG = -1e30f;

constexpr size_t O_YP = 0, O_YS = 16777216, O_KVP = 16809984, O_WINP = 25198592, O_SP = 25460736, O_CONVP = 25591808,
                 O_KVS = 25601024, O_WINS = 25617408, O_SS = 29811712, O_CONVS = 31908864, O_END = 32056320;

constexpr size_t MiB = 1u << 20;
constexpr size_t WS_CTL = 0;
constexpr size_t WS_SSQ1 = 1 * MiB, WS_SSQ2 = WS_SSQ1 + 128 * 1024;
constexpr size_t WS_ZERO_BYTES = 2 * MiB;
constexpr size_t WS_WIN = 2 * MiB;
constexpr size_t WS_WOUT = 10 * MiB;
constexpr size_t WS_WGU = 12 * MiB;
constexpr size_t WS_WDN = 24 * MiB;
constexpr size_t WS_WCMP = 30 * MiB;
constexpr size_t WS_CST = 31 * MiB;
constexpr size_t WS_ROPE = 32 * MiB;
constexpr size_t WS_XN = 36 * MiB;
constexpr size_t WS_QB = 70 * MiB;
constexpr size_t WS_KC = 88 * MiB, WS_VC = 93 * MiB;
constexpr size_t WS_KSEL = 98 * MiB, WS_VSELT = 103 * MiB;
constexpr size_t WS_KWIN = 108 * MiB, WS_VWINT = 113 * MiB;
constexpr size_t WS_CI = 118 * MiB;
constexpr size_t WS_Z = 168 * MiB;
constexpr size_t WS_GT = 186 * MiB;
constexpr size_t WS_CKP = 190 * MiB, WS_CVTP = 191 * MiB;
constexpr size_t WS_CKS = 192 * MiB, WS_CVS = 200 * MiB;
constexpr size_t WS_MIX = 208 * MiB;
constexpr size_t WS_HP = 242 * MiB;
constexpr size_t WS_HPB = 308 * MiB;
constexpr size_t WS_HID = 342 * MiB;
constexpr size_t WS_GW = 432 * MiB;
constexpr size_t WS_GQG = 448 * MiB;
constexpr size_t WS_GKGT = 464 * MiB;
constexpr size_t WS_GAQK = 480 * MiB;
constexpr size_t WS_GU = 488 * MiB;
constexpr size_t WS_GGL = 520 * MiB;
constexpr size_t WS_OG = 521 * MiB;
constexpr size_t WS_END = 560 * MiB;
constexpr int CW_Q3 = 64;

struct Params {
    const float *x_prompt, *x_sample, *cache_kv, *cache_win, *state_S, *state_conv;
    const int* page_table;
    const float *norm_mix, *w_in, *cmp_pe, *cmp_w, *conv_w, *a_log, *dt_bias, *gdn_norm, *w_out, *norm_ffn, *w_gate_up, *w_down, *norm_final;
    float* out;
    unsigned char* ws;
};

DI unsigned pk2(float lo, float hi) { f32x2 v = {lo, hi}; bf16x2_t b = __builtin_convertvector(v, bf16x2_t); return __builtin_bit_cast(unsigned, b); }
DI bf16_t f2bf(float f) { return (bf16_t)(pk2(f, 0.f) & 0xffffu); }
DI float bf2f(bf16_t h) { return __uint_as_float(((unsigned)h) << 16); }
DI float sigmoidf_(float x) { return 1.f / (1.f + __expf(-x)); }
DI float siluf_(float x) { return x / (1.f + __expf(-x)); }
DI float wave_sum(float v) {
#pragma unroll
    for (int o = 1; o < 64; o <<= 1) v += __shfl_xor(v, o);
    return v;
}
#define MFMA32(a, b, c) __builtin_amdgcn_mfma_f32_32x32x16_bf16((a), (b), (c), 0, 0, 0)
DI int crow(int r, int hi) { return (r & 3) + 8 * (r >> 2) + 4 * hi; }
#define LDS_FADD(ptr, v) (void)__hip_atomic_fetch_add((ptr), (v), __ATOMIC_RELAXED, __HIP_MEMORY_SCOPE_WORKGROUP)
namespace pg8 {
#define PG8_LAS __attribute__((address_space(3)))
typedef ::bf16_t bf16_t;
typedef ::bf16x8 bf16x8;
typedef ::f32x4 f32x4;
typedef ::u32x4 u32x4;
constexpr int BM = 256, BK = 64, HALF = 128, HTB = HALF * BK * 2  , STAGE_BYTES = 8 * HTB, NXCD = 8, WGM = 8;

__host__ __device__ __forceinline__ int lds_byte(int r, int c) { const int st = (r >> 4) * 2 + (c >> 5), rr = r & 15, cc = c & 31, ob = rr * 64 + cc * 2; return st * 1024 + (ob ^ (((ob >> 9) & 1) << 5)); }
__host__ __device__ __forceinline__ void stage_rc(int b, int& R, int& C) { const int st = b / 1024, sb = b % 1024, swz = sb ^ (((sb >> 9) & 1) << 5); R = (st >> 1) * 16 + swz / 64; C = (st & 1) * 32 + (swz % 64) / 2; }
__host__ __device__ __forceinline__ int perm32(int rho) { const int n = rho >> 4, i = rho & 15; return 8 * (i >> 2) + 4 * n + (i & 3); }

struct Unit { int pm, pn; };
struct Gemm { const bf16_t* A; const bf16_t* Bt; int M, N, K; };

struct StaticOrder {
    int nM, nN, nwg, G, c;
    __host__ __device__ void init(int M, int N, int G_, int c_) { nM = M / BM; nN = N / BM; nwg = nM * nN; G = G_; c = c_; }
    __host__ __device__ bool next(int i, Unit& u) const {
        const long L = (long)i * G + c; if (L >= nwg) return false;
        int wgid = (int)L; { const int q = nwg / NXCD, r = nwg % NXCD, xcd = wgid % NXCD, off = wgid / NXCD; wgid = (xcd < r ? xcd * (q + 1) : r * (q + 1) + (xcd - r) * q) + off; }
        const int nig = WGM * nN, gid = wgid / nig, fm = gid * WGM, gsz = (nM - fm) < WGM ? (nM - fm) : WGM;
        u.pm = fm + ((wgid % nig) % gsz); u.pn = (wgid % nig) / gsz; return true;
    }
    __device__ __forceinline__ void a_ready(const Unit&) const {}
    __device__ __forceinline__ void done(const Unit&) const {}
};


template <class Epi, class Sched, bool ALIGN_EPI = false, bool SP2 = false>
__device__ __forceinline__ void gemm_phase(PG8_LAS unsigned char* lds, const Gemm g, const Sched& S, const Epi& E) {
    int tid_ = threadIdx.x; asm volatile("" : "+v"(tid_)); const int tid = tid_, wid = __builtin_amdgcn_readfirstlane(tid >> 6), lane = tid & 63, wr = wid >> 2, wc = wid & 3, fr = lane & 15, fq = lane >> 4;
    const int K = g.K, nt = K / BK;
    unsigned voffA[2], voffB[2];
#pragma unroll
    for (int i = 0; i < 2; ++i) { int R, C; stage_rc(tid * 16 + i * 8192, R, C); const int Rb = Epi::PERM ? ((R & ~31) + perm32(R & 31)) : R;
        voffA[i] = (unsigned)(R * K + C) * 2u; voffB[i] = (unsigned)(Rb * K + C) * 2u; }
    const size_t kstep = (size_t)(BK * 2);
    const size_t hstep = (size_t)HALF * K * 2;
    const size_t tstep = 2 * hstep;
    const unsigned ldsw = (unsigned)wid * 1024u;
    const int aoff = lds_byte(wr * 64 + fr, fq * 8), boff = lds_byte(wc * 32 + fr, fq * 8);
#define PG8_SA(b, h) (((b) * 2 + (h)) * HTB)
#define PG8_SB(b, h) ((4 + (b) * 2 + (h)) * HTB)
#define PG8_STAGE(bufoff, gbase, voff) do { _Pragma("unroll") for (int _i = 0; _i < 2; ++_i) \
        __builtin_amdgcn_global_load_lds((const unsigned*)((const char*)(gbase) + (voff)[_i]), (PG8_LAS unsigned*)(lds + (bufoff) + ldsw + _i * 8192), 16, 0, 0); } while (0)
#define PG8_LDA(dst, b, h) do { _Pragma("unroll") for (int m = 0; m < 4; ++m) _Pragma("unroll") for (int k = 0; k < 2; ++k) dst[m][k] = *(const PG8_LAS bf16x8*)(lds + PG8_SA(b, h) + aoff + m * 2048 + k * 1024); } while (0)
#define PG8_LDB(dst, b, h) do { _Pragma("unroll") for (int n = 0; n < 2; ++n) _Pragma("unroll") for (int k = 0; k < 2; ++k) dst[n][k] = *(const PG8_LAS bf16x8*)(lds + PG8_SB(b, h) + boff + n * 2048 + k * 1024); } while (0)
#define PG8_MMA(ai, bj, At, Bt) do { __builtin_amdgcn_s_setprio(1); _Pragma("unroll") for (int m = 0; m < 4; ++m) _Pragma("unroll") for (int n = 0; n < 2; ++n) _Pragma("unroll") for (int k = 0; k < 2; ++k) \
        acc[ai][bj][m][n] = __builtin_amdgcn_mfma_f32_16x16x32_bf16(Bt[n][k], At[m][k], acc[ai][bj][m][n], 0, 0, 0); __builtin_amdgcn_s_setprio(0); } while (0)
#define PG8_WAIT_V(n) asm volatile("s_waitcnt vmcnt(" #n ")" ::: "memory")
#define PG8_WAIT_L(n) asm volatile("s_waitcnt lgkmcnt(" #n ")" ::: "memory")
#define PG8_BAR __builtin_amdgcn_s_barrier()
#define PG8_SCHED __builtin_amdgcn_sched_barrier(0)
    Unit cur, nxt; int ui = 0;
    if (!S.next(0, cur)) return;
    f32x4 acc[2][2][4][2];
#pragma unroll
    for (int a = 0; a < 2; ++a)
#pragma unroll
        for (int b = 0; b < 2; ++b)
#pragma unroll
            for (int m = 0; m < 4; ++m)
#pragma unroll
                for (int n = 0; n < 2; ++n) acc[a][b][m][n] = (f32x4){0.f, 0.f, 0.f, 0.f};
    bf16x8 At[4][2], B0[2][2], B1[2][2];
    const char* cA = (const char*)g.A + (size_t)cur.pm * tstep; const char* cB = (const char*)g.Bt + (size_t)cur.pn * tstep;
    S.a_ready(cur);
    if constexpr (SP2) {
        PG8_STAGE(PG8_SB(0, 0), cB, voffB); PG8_STAGE(PG8_SB(0, 1), cB + hstep, voffB); PG8_STAGE(PG8_SA(0, 0), cA, voffA); PG8_STAGE(PG8_SA(0, 1), cA + hstep, voffA);
        if (wr == 1) PG8_BAR;
        PG8_WAIT_V(2); PG8_BAR;
        PG8_STAGE(PG8_SB(1, 0), cB + kstep, voffB); PG8_STAGE(PG8_SA(1, 0), cA + kstep, voffA); PG8_STAGE(PG8_SB(1, 1), cB + hstep + kstep, voffB);
        PG8_WAIT_V(6); PG8_BAR;
    } else {
        PG8_STAGE(PG8_SB(0, 0), cB, voffB); PG8_STAGE(PG8_SA(0, 0), cA, voffA); PG8_STAGE(PG8_SB(0, 1), cB + hstep, voffB); PG8_STAGE(PG8_SA(0, 1), cA + hstep, voffA);
        if (wr == 1) PG8_BAR;
        PG8_WAIT_V(4); PG8_BAR;
        PG8_STAGE(PG8_SB(1, 0), cB + kstep, voffB); PG8_STAGE(PG8_SA(1, 0), cA + kstep, voffA); PG8_STAGE(PG8_SB(1, 1), cB + hstep + kstep, voffB);
        PG8_WAIT_V(6); PG8_BAR;
    }
    for (;;) {
        const bool has_next = S.next(ui + 1, nxt);
        const char* nA = has_next ? (const char*)g.A + (size_t)nxt.pm * tstep : cA; const char* nB = has_next ? (const char*)g.Bt + (size_t)nxt.pn * tstep : cB;
        for (int t = 0; t < nt; t += 2) {
            const bool last = (t == nt - 2);
            const char* a1 = cA + (size_t)(t + 1) * kstep;
            const char* a2 = last ? nA : cA + (size_t)(t + 2) * kstep; const char* b2 = last ? nB : cB + (size_t)(t + 2) * kstep;
            const char* a3 = a2 + kstep; const char* b3 = b2 + kstep;
            if (last && has_next) S.a_ready(nxt);
            if constexpr (SP2) {
            PG8_LDB(B0, 0, 0); PG8_LDB(B1, 0, 1); PG8_SCHED; PG8_LDA(At, 0, 0); PG8_STAGE(PG8_SA(1, 1), a1 + hstep, voffA);
            PG8_WAIT_V(8); PG8_WAIT_L(0); PG8_BAR; PG8_MMA(0, 0, At, B0); PG8_MMA(0, 1, At, B1); PG8_BAR; PG8_SCHED;
            PG8_LDA(At, 0, 1); PG8_STAGE(PG8_SB(0, 0), b2, voffB); PG8_STAGE(PG8_SB(0, 1), b2 + hstep, voffB); PG8_STAGE(PG8_SA(0, 0), a2, voffA);
            PG8_WAIT_V(8); PG8_WAIT_L(0); PG8_BAR; PG8_MMA(1, 0, At, B0); PG8_MMA(1, 1, At, B1); PG8_BAR; PG8_SCHED;
            PG8_LDB(B0, 1, 0); PG8_LDB(B1, 1, 1); PG8_SCHED; PG8_LDA(At, 1, 0); PG8_STAGE(PG8_SA(0, 1), a2 + hstep, voffA);
            PG8_WAIT_V(8); PG8_WAIT_L(0); PG8_BAR; PG8_MMA(0, 0, At, B0); PG8_MMA(0, 1, At, B1); PG8_BAR; PG8_SCHED;
            PG8_LDA(At, 1, 1); PG8_STAGE(PG8_SB(1, 0), b3, voffB); PG8_STAGE(PG8_SB(1, 1), b3 + hstep, voffB); PG8_STAGE(PG8_SA(1, 0), a3, voffA);
            PG8_WAIT_V(8); PG8_WAIT_L(0); PG8_BAR; PG8_MMA(1, 0, At, B0); PG8_MMA(1, 1, At, B1); PG8_BAR; PG8_SCHED;
            } else {
            PG8_LDB(B0, 0, 0); PG8_SCHED; PG8_LDA(At, 0, 0); PG8_STAGE(PG8_SA(1, 1), a1 + hstep, voffA);
            PG8_WAIT_L(8); PG8_BAR; PG8_WAIT_L(0); PG8_MMA(0, 0, At, B0); PG8_BAR; PG8_SCHED;
            PG8_LDB(B1, 0, 1); PG8_STAGE(PG8_SB(0, 0), b2, voffB);
            PG8_BAR; PG8_WAIT_L(0); PG8_MMA(0, 1, At, B1); PG8_BAR;
            PG8_LDA(At, 0, 1); PG8_STAGE(PG8_SA(0, 0), a2, voffA);
            PG8_BAR; PG8_WAIT_L(0); PG8_MMA(1, 0, At, B0); PG8_BAR; PG8_SCHED;
            PG8_STAGE(PG8_SB(0, 1), b2 + hstep, voffB);
            PG8_WAIT_V(6); PG8_BAR; PG8_MMA(1, 1, At, B1); PG8_BAR;
            PG8_LDB(B0, 1, 0); PG8_SCHED; PG8_LDA(At, 1, 0); PG8_STAGE(PG8_SA(0, 1), a2 + hstep, voffA);
            PG8_WAIT_L(8); PG8_BAR; PG8_WAIT_L(0); PG8_MMA(0, 0, At, B0); PG8_BAR; PG8_SCHED;
            PG8_LDB(B1, 1, 1); PG8_STAGE(PG8_SB(1, 0), b3, voffB);
            PG8_BAR; PG8_WAIT_L(0); PG8_MMA(0, 1, At, B1); PG8_BAR;
            PG8_LDA(At, 1, 1); PG8_STAGE(PG8_SA(1, 0), a3, voffA);
            PG8_BAR; PG8_WAIT_L(0); PG8_MMA(1, 0, At, B0); PG8_BAR; PG8_SCHED;
            PG8_STAGE(PG8_SB(1, 1), b3 + hstep, voffB);
            PG8_WAIT_V(6); PG8_BAR; PG8_MMA(1, 1, At, B1); PG8_BAR;
            }
        }
        if constexpr (ALIGN_EPI) { if (wr == 0) PG8_BAR; }
        if constexpr (!Epi::AFTER_DRAIN) { E(acc, cur, wr, wc, fr, fq); S.done(cur); }
        if (!has_next) break;
#pragma unroll
        for (int a = 0; a < 2; ++a)
#pragma unroll
            for (int b = 0; b < 2; ++b)
#pragma unroll
                for (int m = 0; m < 4; ++m)
#pragma unroll
                    for (int n = 0; n < 2; ++n) acc[a][b][m][n] = (f32x4){0.f, 0.f, 0.f, 0.f};
        cur = nxt; cA = nA; cB = nB; ++ui;
        if constexpr (ALIGN_EPI) { if (wr == 1) PG8_BAR; }
    }
    PG8_WAIT_V(0);
    if constexpr (!ALIGN_EPI) { if (wr == 0) PG8_BAR; }
    PG8_BAR;
    if constexpr (Epi::AFTER_DRAIN) { E.fused(acc, cur, wr, wc, fr, fq, lds, wid, lane); S.done(cur); }
#undef PG8_SA
#undef PG8_SB
#undef PG8_STAGE
#undef PG8_LDA
#undef PG8_LDB
#undef PG8_MMA
#undef PG8_WAIT_V
#undef PG8_WAIT_L
#undef PG8_BAR
#undef PG8_SCHED
}
}
namespace epi {
using pg8::Unit;
#define EPI_V8(ai, bj, m) const float v[8] = {acc[ai][bj][m][0][0], acc[ai][bj][m][0][1], acc[ai][bj][m][0][2], acc[ai][bj][m][0][3], acc[ai][bj][m][1][0], acc[ai][bj][m][1][1], acc[ai][bj][m][1][2], acc[ai][bj][m][1][3]}
DI void st_bf16x8(bf16_t* p, const float* v) { u32x4 w; w.x = pk2(v[0], v[1]); w.y = pk2(v[2], v[3]); w.z = pk2(v[4], v[5]); w.w = pk2(v[6], v[7]); *(u32x4*)p = w; }
DI void st_bf16x4(bf16_t* p, float a, float b, float c, float d) { u32x2 w; w.x = pk2(a, b); w.y = pk2(c, d); *(u32x2*)p = w; }
DI void st_f32x4(float* p, float a, float b, float c, float d) { *(f32x4*)p = (f32x4){a, b, c, d}; }

struct EpiProj {
    static constexpr bool PERM = true, AFTER_DRAIN = false;
    float* out; unsigned char* ws; const float* a_log; const float* dt_bias;
    DI void operator()(const f32x4 (&acc)[2][2][4][2], const Unit& u, int wr, int wc, int fr, int fq) const {
        const int pn = u.pn;
        const float* cosT = (const float*)(ws + WS_ROPE); const float* sinT = cosT + 8193 * 32;
#pragma unroll
        for (int ai = 0; ai < 2; ++ai)
#pragma unroll
            for (int m = 0; m < 4; ++m) {
                const int row = u.pm * 256 + ai * 128 + wr * 64 + m * 16 + fr;
                if (row >= MP + NBS) continue;
                const bool samp = row >= MP; const int b = row >> 13, t = row & (TP - 1), bs = row - MP;
                const int pos = samp ? TP : t;
#pragma unroll
                for (int bj = 0; bj < 2; ++bj) {
                    EPI_V8(ai, bj, m);
                    const int cw = bj * 128 + wc * 32 + fq * 8;
                    if (pn < 2) {
                        const int head = (pn * 256 + cw) >> 6, i0 = (cw & 63) >> 1;
                        const f32x4 c4 = *(const f32x4*)(cosT + pos * 32 + i0), s4 = *(const f32x4*)(sinT + pos * 32 + i0);
                        float o1[4], o2[4];
#pragma unroll
                        for (int q = 0; q < 4; ++q) { const float x1 = v[2 * q], x2 = v[2 * q + 1]; o1[q] = (x1 * c4[q] - x2 * s4[q]) * QSCALE; o2[q] = (x2 * c4[q] + x1 * s4[q]) * QSCALE; }
                        bf16_t* qb = (bf16_t*)(ws + WS_QB) + (size_t)row * 512 + head * 64 + i0;
                        st_bf16x4(qb, o1[0], o1[1], o1[2], o1[3]); st_bf16x4(qb + 32, o2[0], o2[1], o2[2], o2[3]);
                    } else if (pn < 5) {
                        const int br = pn - 2, g = wc >> 1, cc = (wc & 1) * 32 + fq * 8;
                        float* dst;
                        if (!samp) dst = (br < 2) ? out + O_KVP + ((size_t)(b * TP + t) * 4 + 2 * br + bj) * 128 + g * 64
                                                  : (t >= TP - 512 ? out + O_WINP + ((size_t)(b * 512 + t - (TP - 512)) * 2 + bj) * 128 + g * 64 : nullptr);
                        else dst = (br < 2) ? out + O_KVS + ((size_t)bs * 4 + 2 * br + bj) * 128 + g * 64 : out + O_WINS + ((size_t)(bs * 512 + 511) * 2 + bj) * 128 + g * 64;
                        const size_t hb = ((size_t)(b * 2 + g) * TP + t) * 64;
                        if (bj == 0) {
                            const int i0 = cc >> 1;
                            const f32x4 c4 = *(const f32x4*)(cosT + pos * 32 + i0), s4 = *(const f32x4*)(sinT + pos * 32 + i0);
                            float o1[4], o2[4];
#pragma unroll
                            for (int q = 0; q < 4; ++q) { const float x1 = v[2 * q], x2 = v[2 * q + 1]; o1[q] = x1 * c4[q] - x2 * s4[q]; o2[q] = x2 * c4[q] + x1 * s4[q]; }
                            if (dst) { st_f32x4(dst + i0, o1[0], o1[1], o1[2], o1[3]); st_f32x4(dst + 32 + i0, o2[0], o2[1], o2[2], o2[3]); }
                            if (!samp) { bf16_t* kb = (bf16_t*)(ws + (br == 0 ? WS_KC : br == 1 ? WS_KSEL : WS_KWIN)) + hb + i0;
                                st_bf16x4(kb, o1[0], o1[1], o1[2], o1[3]); st_bf16x4(kb + 32, o2[0], o2[1], o2[2], o2[3]); }
                        } else {
                            if (dst) { st_f32x4(dst + cc, v[0], v[1], v[2], v[3]); st_f32x4(dst + cc + 4, v[4], v[5], v[6], v[7]); }
                            if (!samp) {
                                if (br == 0) st_bf16x8((bf16_t*)(ws + WS_VC) + hb + cc, v);
                                else { bf16_t* vt = (bf16_t*)(ws + (br == 1 ? WS_VSELT : WS_VWINT)) + ((size_t)(b * 2 + g) * 64 + cc) * TP + t;
#pragma unroll
                                    for (int j = 0; j < 8; ++j) vt[(size_t)j * TP] = f2bf(v[j]); }
                            }
                        }
                    } else if (pn < 11) {
                        const int ch0 = (pn - 5) * 256 + cw;
                        st_bf16x8((bf16_t*)(ws + WS_CI) + (size_t)row * CCH + ch0, v);
                        float* dst = nullptr;
                        if (!samp) { if (t >= TP - 3) dst = out + O_CONVP + (size_t)(b * 3 + t - (TP - 3)) * CCH + ch0; }
                        else dst = out + O_CONVS + (size_t)(bs * 3 + 2) * CCH + ch0;
                        if (dst) { st_f32x4(dst, v[0], v[1], v[2], v[3]); st_f32x4(dst + 4, v[4], v[5], v[6], v[7]); }
                    } else if (pn < 13) {
                        st_bf16x8((bf16_t*)(ws + WS_Z) + (size_t)row * 512 + (pn - 11) * 256 + cw, v);
                    } else {
                        if (bj == 0 && wc == 0) {
                            float o[8];
                            if (fq < 3) {
#pragma unroll
                                for (int j = 0; j < 8; ++j) o[j] = sigmoidf_(v[j]);
                            } else {
#pragma unroll
                                for (int j = 0; j < 4; ++j) { const float xx = v[j] + dt_bias[j]; const float sp = fmaxf(xx, 0.f) + log1pf(__expf(-fabsf(xx))); o[j] = -__expf(a_log[j]) * sp; }
#pragma unroll
                                for (int j = 4; j < 8; ++j) o[j] = sigmoidf_(v[j]);
                            }
                            float* gt = (float*)(ws + WS_GT) + (size_t)row * 32 + fq * 8;
                            st_f32x4(gt, o[0], o[1], o[2], o[3]); st_f32x4(gt + 4, o[4], o[5], o[6], o[7]);
                        }
                    }
                }
            }
    }
};

struct EpiOut {
    static constexpr bool PERM = true, AFTER_DRAIN = false;
    const float* xp; const float* xs; unsigned char* ws;
    DI void operator()(const f32x4 (&acc)[2][2][4][2], const Unit& u, int wr, int wc, int fr, int fq) const {
        float* hp = (float*)(ws + WS_HP); bf16_t* hpb = (bf16_t*)(ws + WS_HPB); float* ssq = (float*)(ws + WS_SSQ1);
#pragma unroll
        for (int ai = 0; ai < 2; ++ai)
#pragma unroll
            for (int m = 0; m < 4; ++m) {
                const int row = u.pm * 256 + ai * 128 + wr * 64 + m * 16 + fr;
                const float* xr = row < MP ? xp + (size_t)row * DM : (row < MP + NBS ? xs + (size_t)(row - MP) * DM : nullptr);
                float sq = 0.f;
#pragma unroll
                for (int bj = 0; bj < 2; ++bj) {
                    EPI_V8(ai, bj, m);
                    const int col = u.pn * 256 + bj * 128 + wc * 32 + fq * 8;
                    float h[8];
                    if (xr) { const f32x4 x0 = *(const f32x4*)(xr + col), x1 = *(const f32x4*)(xr + col + 4);
#pragma unroll
                        for (int j = 0; j < 4; ++j) { h[j] = x0[j] + v[j]; h[4 + j] = x1[j] + v[4 + j]; } }
                    else {
#pragma unroll
                        for (int j = 0; j < 8; ++j) h[j] = 0.f; }
#pragma unroll
                    for (int j = 0; j < 8; ++j) sq += h[j] * h[j];
                    st_f32x4(hp + (size_t)row * DM + col, h[0], h[1], h[2], h[3]); st_f32x4(hp + (size_t)row * DM + col + 4, h[4], h[5], h[6], h[7]);
                    st_bf16x8(hpb + (size_t)row * DM + col, h);
                }
                sq += __shfl_xor(sq, 16); sq += __shfl_xor(sq, 32);
                if (fq == 0) atomicAdd(ssq + row, sq);
            }
    }
};

struct EpiUp {
    static constexpr bool PERM = true, AFTER_DRAIN = false;
    unsigned char* ws;
    DI void operator()(const f32x4 (&acc)[2][2][4][2], const Unit& u, int wr, int wc, int fr, int fq) const {
        const float* ssq = (const float*)(ws + WS_SSQ1); bf16_t* hid = (bf16_t*)(ws + WS_HID);
#pragma unroll
        for (int ai = 0; ai < 2; ++ai)
#pragma unroll
            for (int m = 0; m < 4; ++m) {
                const int row = u.pm * 256 + ai * 128 + wr * 64 + m * 16 + fr;
                const float rs = rsqrtf(ssq[row] * (1.f / DM) + EPS);
#pragma unroll
                for (int bj = 0; bj < 2; ++bj) {
                    EPI_V8(ai, bj, m);
                    const int j0 = (u.pn * 256 + bj * 128 + wc * 32 + fq * 8) >> 1;
                    float h[4];
#pragma unroll
                    for (int q = 0; q < 4; ++q) { const float gte = v[2 * q] * rs, up = v[2 * q + 1] * rs; h[q] = siluf_(gte) * up; }
                    st_bf16x4(hid + (size_t)row * DFF + j0, h[0], h[1], h[2], h[3]);
                }
            }
    }
};

struct EpiDown {
    static constexpr bool PERM = true, AFTER_DRAIN = false;
    unsigned char* ws;
    DI void operator()(const f32x4 (&acc)[2][2][4][2], const Unit& u, int wr, int wc, int fr, int fq) const {
        float* hp = (float*)(ws + WS_HP); float* ssq = (float*)(ws + WS_SSQ2);
#pragma unroll
        for (int ai = 0; ai < 2; ++ai)
#pragma unroll
            for (int m = 0; m < 4; ++m) {
                const int row = u.pm * 256 + ai * 128 + wr * 64 + m * 16 + fr;
                float sq = 0.f;
#pragma unroll
                for (int bj = 0; bj < 2; ++bj) {
                    EPI_V8(ai, bj, m);
                    float* hr = hp + (size_t)row * DM + u.pn * 256 + bj * 128 + wc * 32 + fq * 8;
                    const f32x4 x0 = *(const f32x4*)hr, x1 = *(const f32x4*)(hr + 4);
                    float h[8];
#pragma unroll
                    for (int j = 0; j < 4; ++j) { h[j] = x0[j] + v[j]; h[4 + j] = x1[j] + v[4 + j]; }
#pragma unroll
                    for (int j = 0; j < 8; ++j) sq += h[j] * h[j];
                    st_f32x4(hr, h[0], h[1], h[2], h[3]); st_f32x4(hr + 4, h[4], h[5], h[6], h[7]);
                }
                (void)sq; (void)ssq;
            }
    }
};
}
namespace p0 {
DI int perm_in(int n) {
    if (n < 512) { const int cc = n & 63; return (n & ~63) + ((cc & 1) ? (cc >> 1) + 32 : (cc >> 1)); }
    if (n < 1280) { const int m = n - 512, grp = m >> 6, cc = m & 63, br = grp >> 2, kvi = (grp >> 1) & 1, g = grp & 1;
        const int d = kvi == 0 ? ((cc & 1) ? (cc >> 1) + 32 : (cc >> 1)) : cc; return 512 + br * 256 + kvi * 128 + g * 64 + d; }
    if (n < 2816) return 1304 + (n - 1280);
    if (n < 3328) return 2840 + (n - 2816);
    if (n < 3352) return 1280 + (n - 3328);
    if (n < 3360) return n;
    return -1;
}
template <int MODE> DI void wt_item(const float* W, int Nsrc, bf16_t* WT, int Kdst, int n0, int k0, const float* kscale, int lane) {
    const int n = n0 + lane;
    int src;
    if (MODE == 0) src = perm_in(n);
    else if (MODE == 1) src = n;
    else src = (n & 1) ? DFF + (n >> 1) : (n >> 1);
#pragma unroll 2
    for (int kk = 0; kk < 64; kk += 8) {
        float v[8];
#pragma unroll
        for (int i = 0; i < 8; ++i) { const int k = k0 + kk + i; float x = src >= 0 ? W[(size_t)k * Nsrc + src] : 0.f; if (kscale) x *= kscale[k]; v[i] = x; }
        epi::st_bf16x8(WT + (size_t)n * Kdst + k0 + kk, v);
    }
}
DI void run(const Params& p) {
    int tid_ = threadIdx.x; asm volatile("" : "+v"(tid_)); const int tid = tid_, lane = tid & 63, wave = tid >> 6;
    const int gw = blockIdx.x * 8 + wave, NGW = gridDim.x * 8;
    const int gt = blockIdx.x * 512 + tid, NGT = gridDim.x * 512;
    unsigned char* ws = p.ws;
    constexpr int I_IN = (INW_PAD / 64) * (DM / 64), I_OUT = (DM / 64) * (DM / 64), I_GU = (2 * DFF / 64) * (DM / 64), I_DN = (DM / 64) * (DFF / 64), I_CMP = 2 * 32;
    constexpr int NIT = I_IN + I_OUT + I_GU + I_DN + I_CMP;
    for (int it = gw; it < NIT; it += NGW) {
        int r = it;
        if (r < I_IN) { wt_item<0>(p.w_in, INW, (bf16_t*)(ws + WS_WIN), DM, (r / 16) * 64, (r % 16) * 64, nullptr, lane); continue; } r -= I_IN;
        if (r < I_OUT) { wt_item<1>(p.w_out, DM, (bf16_t*)(ws + WS_WOUT), DM, (r / 16) * 64, (r % 16) * 64, nullptr, lane); continue; } r -= I_OUT;
        if (r < I_GU) { wt_item<2>(p.w_gate_up, 2 * DFF, (bf16_t*)(ws + WS_WGU), DM, (r / 16) * 64, (r % 16) * 64, p.norm_ffn, lane); continue; } r -= I_GU;
        if (r < I_DN) { wt_item<1>(p.w_down, DM, (bf16_t*)(ws + WS_WDN), DFF, (r / 44) * 64, (r % 44) * 64, nullptr, lane); continue; } r -= I_DN;
        { const int kv = r / 32; wt_item<1>(p.cmp_w + (size_t)kv * 2048 * 64, 64, (bf16_t*)(ws + WS_WCMP) + (size_t)kv * 64 * 2048, 2048, 0, (r % 32) * 64, nullptr, lane); }
    }
    for (int o = gw; o < 128; o += NGW) {
        const int kv = o >> 6, e = o & 63; float s = 0.f;
        for (int k = lane; k < 2048; k += 64) s += p.cmp_pe[kv * 2048 + k] * p.cmp_w[((size_t)kv * 2048 + k) * 64 + e];
        s = wave_sum(s);
        if (lane == 0) ((float*)(ws + WS_CST))[o] = s;
    }
    { float* cosT = (float*)(ws + WS_ROPE); float* sinT = cosT + 8193 * 32;
      for (int i = gt; i < 8193 * 32; i += NGT) { const int pos = i >> 5, j = i & 31;
          const double a = (double)pos * pow(10000.0, -(double)j / 32.0); cosT[i] = (float)cos(a); sinT[i] = (float)sin(a); } }
    for (int row = gw; row < MROWS; row += NGW) {
        bf16_t* o = (bf16_t*)(ws + WS_XN) + (size_t)row * DM;
        if (row >= MP + NBS) { for (int j = 0; j < 4; ++j) *(u32x2*)(o + (j * 64 + lane) * 4) = (u32x2){0u, 0u}; continue; }
        const float* xr = row < MP ? p.x_prompt + (size_t)row * DM : p.x_sample + (size_t)(row - MP) * DM;
        f32x4 v[4]; float s = 0.f;
#pragma unroll
        for (int j = 0; j < 4; ++j) { v[j] = *(const f32x4*)(xr + (j * 64 + lane) * 4); s += v[j][0] * v[j][0] + v[j][1] * v[j][1] + v[j][2] * v[j][2] + v[j][3] * v[j][3]; }
        const float rs = rsqrtf(wave_sum(s) * (1.f / DM) + EPS);
#pragma unroll
        for (int j = 0; j < 4; ++j) { const f32x4 g = *(const f32x4*)(p.norm_mix + (j * 64 + lane) * 4);
            epi::st_bf16x4(o + (j * 64 + lane) * 4, v[j][0] * rs * g[0], v[j][1] * rs * g[1], v[j][2] * rs * g[2], v[j][3] * rs * g[3]); }
    }
    { const f32x4* src = (const f32x4*)p.cache_win; f32x4* dst = (f32x4*)(p.out + O_WINS);
      for (int i = gt; i < NBS * 511 * 64; i += NGT) { const int bs = i / (511 * 64), r = i % (511 * 64); dst[(size_t)bs * 512 * 64 + r] = src[(size_t)bs * 512 * 64 + 64 + r]; } }
    { const f32x4* src = (const f32x4*)p.state_conv; f32x4* dst = (f32x4*)(p.out + O_CONVS);
      for (int i = gt; i < NBS * 2 * (CCH / 4); i += NGT) { const int bs = i / (2 * (CCH / 4)), r = i % (2 * (CCH / 4)); dst[(size_t)bs * 3 * (CCH / 4) + r] = src[(size_t)bs * 3 * (CCH / 4) + (CCH / 4) + r]; } }
}
}
namespace attn {
constexpr int KSTR = 72, VSTR = 68;
constexpr int KT_BYTES = 64 * KSTR * 2, VT_BYTES = 64 * VSTR * 2, TILE_BYTES = KT_BYTES + VT_BYTES;
constexpr int OFF_IMP = 36864, IMP_STR = 132;
constexpr int LDS_NEED = OFF_IMP + 8 * 8 * IMP_STR * 4;

DI void ld_tile(const bf16_t* kbase, const bf16_t* vtbase, size_t vts, u32x4& kr, u32x4& vr, int tid) {
    kr = *(const u32x4*)(kbase + (tid >> 3) * 64 + (tid & 7) * 8);
    vr = *(const u32x4*)(vtbase + (size_t)(tid >> 3) * vts + (tid & 7) * 8);
}
DI void st_tile(LAS unsigned char* buf, const u32x4& kr, const u32x4& vr, int tid) {
    *(LAS u32x4*)(buf + ((tid >> 3) * KSTR + (tid & 7) * 8) * 2) = kr;
    LAS u32x2* vp = (LAS u32x2*)(buf + KT_BYTES + ((tid >> 3) * VSTR + (tid & 7) * 8) * 2);
    vp[0] = (u32x2){vr.x, vr.y}; vp[1] = (u32x2){vr.z, vr.w};
}
DI void qk_tile(const LAS unsigned char* kb, const bf16x8 (&qf)[4], f32x16& s0, f32x16& s1, int lane) {
    const LAS unsigned char* p0 = kb + ((lane & 31) * KSTR + (lane >> 5) * 8) * 2;
    f32x16 z; for (int i = 0; i < 16; ++i) z[i] = 0.f;
    s0 = z; s1 = z;
#pragma unroll
    for (int kd = 0; kd < 4; ++kd) {
        const bf16x8 a0 = *(const LAS bf16x8*)(p0 + kd * 32), a1 = *(const LAS bf16x8*)(p0 + 32 * KSTR * 2 + kd * 32);
        s0 = MFMA32(a0, qf[kd], s0); s1 = MFMA32(a1, qf[kd], s1);
    }
}
DI bf16x8 pack8(const f32x16& p, int base) {
    u32x4 w; w.x = pk2(p[base], p[base + 1]); w.y = pk2(p[base + 2], p[base + 3]); w.z = pk2(p[base + 4], p[base + 5]); w.w = pk2(p[base + 6], p[base + 7]);
    return __builtin_bit_cast(bf16x8, w);
}
DI void pv_tile(const LAS unsigned char* vb, const f32x16& p0, const f32x16& p1, f32x16& o0, f32x16& o1, int lane) {
    const LAS unsigned char* v0 = vb + ((lane & 31) * VSTR + 4 * (lane >> 5)) * 2;
#pragma unroll
    for (int ks = 0; ks < 4; ++ks) {
        const bf16x8 pb = (ks < 2) ? pack8(p0, (ks & 1) * 8) : pack8(p1, (ks & 1) * 8);
#pragma unroll
        for (int dt = 0; dt < 2; ++dt) {
            const s16x4 lo = *(const LAS s16x4*)(v0 + (dt * 32 * VSTR + 16 * ks) * 2), hi = *(const LAS s16x4*)(v0 + (dt * 32 * VSTR + 16 * ks + 8) * 2);
            const bf16x8 a = __builtin_shufflevector(lo, hi, 0, 1, 2, 3, 4, 5, 6, 7);
            if (dt == 0) o0 = MFMA32(a, pb, o0); else o1 = MFMA32(a, pb, o1);
        }
    }
}
DI void softmax_step(f32x16& s0, f32x16& s1, float& m, float& l, f32x16& o0, f32x16& o1) {
    float mt = NEGBIG;
#pragma unroll
    for (int r = 0; r < 16; ++r) mt = fmaxf(mt, fmaxf(s0[r], s1[r]));
    mt = fmaxf(mt, __shfl_xor(mt, 32));
    const float mn = fmaxf(m, mt), alpha = __builtin_amdgcn_exp2f(m - mn);
    float sum = 0.f;
#pragma unroll
    for (int r = 0; r < 16; ++r) { s0[r] = __builtin_amdgcn_exp2f(s0[r] - mn); s1[r] = __builtin_amdgcn_exp2f(s1[r] - mn); sum += s0[r] + s1[r]; }
    l = l * alpha + sum; m = mn;
#pragma unroll
    for (int r = 0; r < 16; ++r) { o0[r] *= alpha; o1[r] *= alpha; }
}

#define ATT_TBUF(i) (lds + (i) * TILE_BYTES)
#define ATT_STREAM_BEGIN(NT, KP, VP, VTS) { u32x4 kr_, vr_; const int nt_ = (NT); \
    { const int i_ = 0; ld_tile((KP), (VP), (VTS), kr_, vr_, tid); } st_tile(ATT_TBUF(0), kr_, vr_, tid); __syncthreads(); \
    for (int it_ = 0; it_ < nt_; ++it_) { \
        if (it_ + 1 < nt_) { const int i_ = it_ + 1; ld_tile((KP), (VP), (VTS), kr_, vr_, tid); } \
        { const LAS unsigned char* tb = ATT_TBUF(it_ & 1); const int i_ = it_;
#define ATT_STREAM_END() } \
        if (it_ + 1 < nt_) st_tile(ATT_TBUF((it_ + 1) & 1), kr_, vr_, tid); \
        __syncthreads(); } }

DI void unit(const Params& p, LAS unsigned char* lds, int b, int g, int tt) {
    int tid_ = threadIdx.x; asm volatile("" : "+v"(tid_)); const int tid = tid_, lane = tid & 63, wave = __builtin_amdgcn_readfirstlane(tid >> 6), hi = lane >> 5, col = lane & 31, tokl = col & 7, r = col >> 3;
    const int t = tt * 64 + wave * 8 + tokl;
    const size_t row = (size_t)b * TP + t;
    const unsigned char* ws = p.ws;
    const size_t slab = (size_t)(b * 2 + g);
    bf16x8 qf[4];
    { const bf16_t* q = (const bf16_t*)(ws + WS_QB) + row * 512 + (g * 4 + r) * 64 + hi * 8;
#pragma unroll
      for (int kd = 0; kd < 4; ++kd) qf[kd] = *(const bf16x8*)(q + kd * 16); }
    const float* gt = (const float*)(ws + WS_GT) + row * 32 + (g * 4 + r) * 3;
    const float gate0 = gt[0], gate1 = gt[1], gate2 = gt[2];
    LAS float* imp = (LAS float*)(lds + OFF_IMP) + wave * 8 * IMP_STR;
    for (int i = lane; i < 8 * IMP_STR; i += 64) imp[i] = 0.f;
    f32x16 of0, of1; for (int i = 0; i < 16; ++i) { of0[i] = 0.f; of1[i] = 0.f; }

    const int nv = t >= 31 ? ((t - 31) >> 4) + 1 : 0;
    {
        const int ntile = (4 * tt + 3 + 63) >> 6;
        const bf16_t* ck = (const bf16_t*)(ws + WS_CKP) + slab * 512 * 64;
        const bf16_t* cvt = (const bf16_t*)(ws + WS_CVTP) + slab * 64 * 512;
        float m = NEGBIG, l = 0.f;
        ATT_STREAM_BEGIN(ntile, ck + (size_t)i_ * 64 * 64, cvt + i_ * 64, 512)
            f32x16 s0, s1; qk_tile(tb, qf, s0, s1, lane);
            float mt = NEGBIG;
#pragma unroll
            for (int rr = 0; rr < 16; ++rr) { const int n0 = i_ * 64 + crow(rr, hi); s0[rr] = n0 < nv ? s0[rr] : NEGBIG; s1[rr] = n0 + 32 < nv ? s1[rr] : NEGBIG; mt = fmaxf(mt, fmaxf(s0[rr], s1[rr])); }
            const float mn = fmaxf(m, mt); float sum = 0.f;
#pragma unroll
            for (int rr = 0; rr < 16; ++rr) sum += __builtin_amdgcn_exp2f(s0[rr] - mn) + __builtin_amdgcn_exp2f(s1[rr] - mn);
            l = l * __builtin_amdgcn_exp2f(m - mn) + sum; m = mn;
        ATT_STREAM_END()
        const float mo = __shfl_xor(m, 32), lo = __shfl_xor(l, 32);
        const float M = fmaxf(m, mo), L = l * __builtin_amdgcn_exp2f(m - M) + lo * __builtin_amdgcn_exp2f(mo - M);
        const float invL = M > -1e29f ? 1.f / L : 0.f;
        f32x16 o0, o1; for (int i = 0; i < 16; ++i) { o0[i] = 0.f; o1[i] = 0.f; }
        LAS float* myimp = imp + tokl * IMP_STR;
        ATT_STREAM_BEGIN(ntile, ck + (size_t)i_ * 64 * 64, cvt + i_ * 64, 512)
            f32x16 s0, s1; qk_tile(tb, qf, s0, s1, lane);
#pragma unroll
            for (int rr = 0; rr < 16; ++rr) { const int n0 = i_ * 64 + crow(rr, hi);
                s0[rr] = n0 < nv ? __builtin_amdgcn_exp2f(s0[rr] - M) * invL : 0.f; s1[rr] = n0 + 32 < nv ? __builtin_amdgcn_exp2f(s1[rr] - M) * invL : 0.f; }
#pragma unroll
            for (int a = 0; a < 4; ++a) {
                const int sb0 = i_ * 16 + 2 * a + hi, sb1 = sb0 + 8;
                LDS_FADD(myimp + sb0, (s0[4 * a] + s0[4 * a + 1]) + (s0[4 * a + 2] + s0[4 * a + 3])); LDS_FADD(myimp + sb0 + 1, s0[4 * a + 3]);
                LDS_FADD(myimp + sb1, (s1[4 * a] + s1[4 * a + 1]) + (s1[4 * a + 2] + s1[4 * a + 3])); LDS_FADD(myimp + sb1 + 1, s1[4 * a + 3]);
            }
            pv_tile(tb + KT_BYTES, s0, s1, o0, o1, lane);
        ATT_STREAM_END()
#pragma unroll
        for (int i = 0; i < 16; ++i) { of0[i] = gate0 * o0[i]; of1[i] = gate0 * o1[i]; }
    }
    unsigned long long sel_lo = 0ull, sel_hi = 0ull;
    {
        const unsigned long long lt = (1ull << lane) - 1ull;
#pragma unroll 1
        for (int j = 0; j < 8; ++j) {
            const float i0 = imp[j * IMP_STR + lane], i1 = imp[j * IMP_STR + 64 + lane];
            const int sA = lane, sB = lane + 64;
            const bool vA = sA <= tt, vB = sB <= tt;
            const bool fA = sA == 0 || sA == tt || sA == tt - 1, fB = sB == tt || sB == tt - 1;
            const int xA = vA ? __float_as_int(i0 + (fA ? 1e4f : 0.f)) : -1, xB = vB ? __float_as_int(i1 + (fB ? 1e4f : 0.f)) : -1;
            int T = 0;
#pragma unroll 1
            for (int bit = 30; bit >= 0; --bit) { const int T2 = T | (1 << bit);
                const int c = __popcll(__ballot(xA >= T2)) + __popcll(__ballot(xB >= T2)); T = __builtin_amdgcn_readfirstlane(c >= 16 ? T2 : T); }
            const bool gA = xA > T, gB = xB > T, eA = xA == T, eB = xB == T;
            const int need = 16 - (__popcll(__ballot(gA)) + __popcll(__ballot(gB)));
            const unsigned long long beA = __ballot(eA), beB = __ballot(eB);
            const int preA = __popcll(beA & lt), preB = __popcll(beA) + __popcll(beB & lt);
            const unsigned long long mA = __ballot(gA || (eA && preA < need)), mB = __ballot(gB || (eB && preB < need));
            if (tokl == j) { sel_lo = mA; sel_hi = mB; }
        }
    }
    {
        const bf16_t* kb = (const bf16_t*)(ws + WS_KSEL) + slab * TP * 64;
        const bf16_t* vt = (const bf16_t*)(ws + WS_VSELT) + slab * 64 * TP;
        float m = NEGBIG, l = 0.f; f32x16 o0, o1; for (int i = 0; i < 16; ++i) { o0[i] = 0.f; o1[i] = 0.f; }
        ATT_STREAM_BEGIN(tt + 1, kb + (size_t)(i_ == 0 ? tt : i_ - 1) * 64 * 64, vt + (size_t)(i_ == 0 ? tt : i_ - 1) * 64, TP)
            const int s = i_ == 0 ? tt : i_ - 1;
            const bool on = ((s < 64 ? (sel_lo >> s) : (sel_hi >> (s - 64))) & 1ull) != 0ull;
            f32x16 s0, s1; qk_tile(tb, qf, s0, s1, lane);
            const int lim = on ? (s == tt ? t - s * 64 : 64) : -1;
#pragma unroll
            for (int rr = 0; rr < 16; ++rr) { const int kk = crow(rr, hi); s0[rr] = kk <= lim ? s0[rr] : NEGBIG; s1[rr] = kk + 32 <= lim ? s1[rr] : NEGBIG; }
            softmax_step(s0, s1, m, l, o0, o1);
            pv_tile(tb + KT_BYTES, s0, s1, o0, o1, lane);
        ATT_STREAM_END()
        const float sc = gate1 / (l + __shfl_xor(l, 32));
#pragma unroll
        for (int i = 0; i < 16; ++i) { of0[i] += sc * o0[i]; of1[i] += sc * o1[i]; }
    }
    {
        const bf16_t* kb = (const bf16_t*)(ws + WS_KWIN) + slab * TP * 64;
        const bf16_t* vt = (const bf16_t*)(ws + WS_VWINT) + slab * 64 * TP;
        const int ntile = (tt < 8 ? tt : 8) + 1;
        float m = NEGBIG, l = 0.f; f32x16 o0, o1; for (int i = 0; i < 16; ++i) { o0[i] = 0.f; o1[i] = 0.f; }
        ATT_STREAM_BEGIN(ntile, kb + (size_t)(tt - i_) * 64 * 64, vt + (size_t)(tt - i_) * 64, TP)
            const int k0 = (tt - i_) * 64;
            f32x16 s0, s1; qk_tile(tb, qf, s0, s1, lane);
#pragma unroll
            for (int rr = 0; rr < 16; ++rr) { const int kp = k0 + crow(rr, hi);
                s0[rr] = (kp <= t && kp >= t - 512) ? s0[rr] : NEGBIG; s1[rr] = (kp + 32 <= t && kp + 32 >= t - 512) ? s1[rr] : NEGBIG; }
            softmax_step(s0, s1, m, l, o0, o1);
            pv_tile(tb + KT_BYTES, s0, s1, o0, o1, lane);
        ATT_STREAM_END()
        const float sc = gate2 / (l + __shfl_xor(l, 32));
#pragma unroll
        for (int i = 0; i < 16; ++i) { of0[i] += sc * o0[i]; of1[i] += sc * o1[i]; }
    }
    { bf16_t* o = (bf16_t*)(p.ws + WS_MIX) + row * DM + (g * 4 + r) * 64 + 4 * hi;
#pragma unroll
      for (int i = 0; i < 4; ++i) { epi::st_bf16x4(o + 8 * i, of0[4 * i], of0[4 * i + 1], of0[4 * i + 2], of0[4 * i + 3]);
                                    epi::st_bf16x4(o + 32 + 8 * i, of1[4 * i], of1[4 * i + 1], of1[4 * i + 2], of1[4 * i + 3]); } }
}
}
namespace gdn {
template <int I> struct SolveRow {
    static DI void run(float (&x)[64], const LAS float* LM, const LAS float* VF, const LAS float* KF, const LAS float* GC, bool isu, int col) {
        SolveRow<I - 1>::run(x, LM, VF, KF, GC, isu, col);
        float acc = isu ? VF[I * 128 + col] * GC[64 + I] : KF[I * 128 + col] * GC[64 + I] * GC[128 + I];
#pragma unroll
        for (int j = 0; j < I; ++j) acc -= LM[I * 64 + j] * x[j];
        x[I] = acc;
        asm volatile("" : "+v"(x[I]) :: "memory");
    }
};
template <> struct SolveRow<-1> { static DI void run(float (&)[64], const LAS float*, const LAS float*, const LAS float*, const LAS float*, bool, int) {} };
constexpr int P_KF = 0, P_VF = 32768, P_QB = 65536, P_KB = 82944, P_LM = 100352, P_GC = 116736, PSTR = 136;
DI void prep_unit(const Params& p, LAS unsigned char* lds, int b, int h, int n) {
    int tid_ = threadIdx.x; asm volatile("" : "+v"(tid_)); const int tid = tid_, lane = tid & 63, wave = __builtin_amdgcn_readfirstlane(tid >> 6);
    const unsigned char* ws = p.ws;
    LAS float* KF = (LAS float*)(lds + P_KF); LAS float* VF = (LAS float*)(lds + P_VF);
    LAS bf16_t* QB = (LAS bf16_t*)(lds + P_QB); LAS bf16_t* KB = (LAS bf16_t*)(lds + P_KB);
    LAS float* LM = (LAS float*)(lds + P_LM); LAS float* GC = (LAS float*)(lds + P_GC);
    const int chunk = (b * GH + h) * NCHUNK + n;
    const size_t row0 = (size_t)b * TP + (size_t)n * 64;
    __syncthreads();
    if (wave == 0) {
        const float* gt = (const float*)(ws + WS_GT) + (row0 + lane) * 32;
        float g = gt[24 + h]; const float be = gt[28 + h];
#pragma unroll
        for (int o = 1; o < 64; o <<= 1) { const float x = __shfl_up(g, o); if (lane >= o) g += x; }
        GC[lane] = g; GC[64 + lane] = be; GC[128 + lane] = __expf(g);
    }
    __syncthreads();
    {
        const int dd = (tid & 15) * 8;
        const float* cw = p.conv_w;
        const bf16_t* ci = (const bf16_t*)(ws + WS_CI);
#pragma unroll 1
        for (int cc = 0; cc < 2; ++cc) {
            const int c = (tid >> 4) + cc * 32; const int t = n * 64 + c;
            float val[3][8];
#pragma unroll
            for (int part = 0; part < 3; ++part) {
                const int ch = part * 512 + h * 128 + dd;
                float a[8]; for (int i = 0; i < 8; ++i) a[i] = 0.f;
#pragma unroll
                for (int j = 0; j < 4; ++j) {
                    const int tj = t - 3 + j;
                    if (tj >= 0) {
                        const u32x4 xv = *(const u32x4*)(ci + ((size_t)b * TP + tj) * CCH + ch);
                        const f32x4 w0 = *(const f32x4*)(cw + j * CCH + ch), w1 = *(const f32x4*)(cw + j * CCH + ch + 4);
                        const unsigned xs[4] = {xv.x, xv.y, xv.z, xv.w};
#pragma unroll
                        for (int i = 0; i < 4; ++i) { a[2 * i] += __uint_as_float(xs[i] << 16) * (i < 2 ? w0[2 * i] : w1[2 * i - 4]); a[2 * i + 1] += __uint_as_float(xs[i] & 0xffff0000u) * (i < 2 ? w0[2 * i + 1] : w1[2 * i - 3]); }
                    }
                }
#pragma unroll
                for (int i = 0; i < 8; ++i) val[part][i] = siluf_(a[i]);
            }
            float sq = 0.f, sk = 0.f;
#pragma unroll
            for (int i = 0; i < 8; ++i) { sq += val[0][i] * val[0][i]; sk += val[1][i] * val[1][i]; }
#pragma unroll
            for (int o = 1; o < 16; o <<= 1) { sq += __shfl_xor(sq, o); sk += __shfl_xor(sk, o); }
            const float rq = rsqrtf(sq + EPS) * 0.08838834764831845f, rk = rsqrtf(sk + EPS), eg = GC[128 + c];
            float qn[8], qg[8], kn[8];
#pragma unroll
            for (int i = 0; i < 8; ++i) { qn[i] = val[0][i] * rq; qg[i] = qn[i] * eg; kn[i] = val[1][i] * rk; }
            epi::st_bf16x8((bf16_t*)(ws + WS_GQG) + ((size_t)chunk * 64 + c) * 128 + dd, qg);
            { u32x4 w; w.x = pk2(qn[0], qn[1]); w.y = pk2(qn[2], qn[3]); w.z = pk2(qn[4], qn[5]); w.w = pk2(qn[6], qn[7]); *(LAS u32x4*)(QB + c * PSTR + dd) = w; }
            { u32x4 w; w.x = pk2(kn[0], kn[1]); w.y = pk2(kn[2], kn[3]); w.z = pk2(kn[4], kn[5]); w.w = pk2(kn[6], kn[7]); *(LAS u32x4*)(KB + c * PSTR + dd) = w; }
            *(LAS f32x4*)(KF + c * 128 + dd) = (f32x4){kn[0], kn[1], kn[2], kn[3]}; *(LAS f32x4*)(KF + c * 128 + dd + 4) = (f32x4){kn[4], kn[5], kn[6], kn[7]};
            *(LAS f32x4*)(VF + c * 128 + dd) = (f32x4){val[2][0], val[2][1], val[2][2], val[2][3]}; *(LAS f32x4*)(VF + c * 128 + dd + 4) = (f32x4){val[2][4], val[2][5], val[2][6], val[2][7]};
        }
    }
    __syncthreads();
    {
        const int mat = wave >> 2, ti = (wave >> 1) & 1, tj = wave & 1, hi = lane >> 5, cl = lane & 31;
        const LAS bf16_t* A = (mat == 0 ? KB : QB) + (ti * 32 + cl) * PSTR + hi * 8;
        const LAS bf16_t* B = KB + (tj * 32 + cl) * PSTR + hi * 8;
        f32x16 acc; for (int i = 0; i < 16; ++i) acc[i] = 0.f;
#pragma unroll
        for (int ks = 0; ks < 8; ++ks) acc = MFMA32(*(const LAS bf16x8*)(A + ks * 16), *(const LAS bf16x8*)(B + ks * 16), acc);
        const int j = tj * 32 + cl; const float gj = GC[j];
#pragma unroll
        for (int r = 0; r < 16; ++r) {
            const int i = ti * 32 + crow(r, hi);
            const float dec = __expf(fminf(GC[i] - gj, 0.f));
            if (mat == 0) LM[i * 64 + j] = i > j ? GC[64 + i] * acc[r] * dec : 0.f;
            else ((bf16_t*)(ws + WS_GAQK))[((size_t)chunk * 64 + i) * 64 + j] = f2bf(i >= j ? acc[r] * dec : 0.f);
        }
    }
    __syncthreads();
    if (wave < 4) {
        const int cc = tid; const bool isu = cc < 128; const int col = cc & 127;
        float x[64];
        int zoff = 0; asm volatile("" : "+v"(zoff));
        SolveRow<63>::run(x, LM + zoff, VF, KF, GC + zoff, isu, col);
        if (isu) {
            float* gu = (float*)(ws + WS_GU) + (size_t)chunk * 8192 + (size_t)(col >> 5) * 2048;
#pragma unroll
            for (int ct = 0; ct < 2; ++ct)
#pragma unroll
                for (int i4 = 0; i4 < 4; ++i4)
#pragma unroll
                    for (int hh = 0; hh < 2; ++hh) { const int c0 = 32 * ct + 8 * i4 + 4 * hh;
                        *(f32x4*)(gu + ((ct * 4 + i4) * 64 + (col & 31) + 32 * hh) * 4) = (f32x4){x[c0], x[c0 + 1], x[c0 + 2], x[c0 + 3]}; }
        } else {
            bf16_t* gw = (bf16_t*)(ws + WS_GW) + (size_t)chunk * 8192 + col;
#pragma unroll
            for (int i = 0; i < 64; ++i) gw[i * 128] = f2bf(-x[i]);
        }
    } else {
        const int t2 = tid - 256, dk = t2 & 127, c0 = (t2 >> 7) * 32; const float glast = GC[63];
        bf16_t* kg = (bf16_t*)(ws + WS_GKGT) + ((size_t)chunk * 128 + dk) * 64 + c0;
#pragma unroll
        for (int q = 0; q < 4; ++q) { float v[8];
#pragma unroll
            for (int e = 0; e < 8; ++e) { const int c = c0 + q * 8 + e; v[e] = KF[c * 128 + dk] * __expf(glast - GC[c]); }
            epi::st_bf16x8(kg + q * 8, v); }
        if (t2 == 0) ((float*)(ws + WS_GGL))[chunk] = __expf(glast);
    }
}

constexpr int S_W = 0, S_QG = 16896, S_KGT = 33792, S_AQK = 51200, S_BUF = 59904, WSTR = 132, CSTR = 68;
DI void scan_unit(const Params& p, LAS unsigned char* lds, int b, int h) {
    int tid_ = threadIdx.x; asm volatile("" : "+v"(tid_)); const int tid = tid_, lane = tid & 63, wave = __builtin_amdgcn_readfirstlane(tid >> 6), hi = lane >> 5, cl = lane & 31;
    const unsigned char* ws = p.ws;
    const int chunk0 = (b * GH + h) * NCHUNK;
    f32x16 S[4]; for (int k = 0; k < 4; ++k) for (int i = 0; i < 16; ++i) S[k][i] = 0.f;
    f32x16 un[2];
    __syncthreads();
#define SCAN_MOVE(chunk, bufi) do { const int t2_ = tid - 256; LAS unsigned char* bb_ = lds + (bufi) * S_BUF; u32x4 stg_[14]; \
        _Pragma("unroll") for (int q = 0; q < 14; ++q) { const int pc = q * 256 + t2_; \
            const unsigned char* src = q < 4 ? ws + WS_GW + (size_t)(chunk) * 16384 + (size_t)pc * 16 : q < 8 ? ws + WS_GQG + (size_t)(chunk) * 16384 + (size_t)(pc - 1024) * 16 \
                : q < 12 ? ws + WS_GKGT + (size_t)(chunk) * 16384 + (size_t)(pc - 2048) * 16 : ws + WS_GAQK + (size_t)(chunk) * 8192 + (size_t)(pc - 3072) * 16; \
            stg_[q] = *(const u32x4*)src; } \
        _Pragma("unroll") for (int q = 0; q < 14; ++q) { const int pc = q * 256 + t2_; \
            LAS unsigned char* dst = q < 4 ? bb_ + S_W + ((pc >> 4) * WSTR + (pc & 15) * 8) * 2 : q < 8 ? bb_ + S_QG + (((pc - 1024) >> 4) * WSTR + (pc & 15) * 8) * 2 \
                : q < 12 ? bb_ + S_KGT + (((pc - 2048) >> 3) * CSTR + (pc & 7) * 8) * 2 : bb_ + S_AQK + (((pc - 3072) >> 3) * CSTR + (pc & 7) * 8) * 2; \
            LAS u32x2* d2 = (LAS u32x2*)dst; d2[0] = (u32x2){stg_[q].x, stg_[q].y}; d2[1] = (u32x2){stg_[q].z, stg_[q].w}; } } while (0)
#define SCAN_LOAD_U(chunk) do { const float* gu_ = (const float*)(ws + WS_GU) + (size_t)(chunk) * 8192 + (size_t)wave * 2048 + lane * 4; \
        _Pragma("unroll") for (int ct = 0; ct < 2; ++ct) _Pragma("unroll") for (int i4 = 0; i4 < 4; ++i4) { const f32x4 v_ = *(const f32x4*)(gu_ + (ct * 4 + i4) * 256); \
            un[ct][4 * i4] = v_[0]; un[ct][4 * i4 + 1] = v_[1]; un[ct][4 * i4 + 2] = v_[2]; un[ct][4 * i4 + 3] = v_[3]; } } while (0)
    if (wave >= 4) { SCAN_MOVE(chunk0, 0); }
    __syncthreads();
    for (int n = 0; n < NCHUNK; ++n) {
        if (wave >= 4) {
            if (n + 1 < NCHUNK) { SCAN_MOVE(chunk0 + n + 1, (n + 1) & 1); }
        } else {
            const LAS unsigned char* bb = lds + (n & 1) * S_BUF;
            const float gl = ((const float*)(ws + WS_GGL))[chunk0 + n];
            SCAN_LOAD_U(chunk0 + n);
            bf16x8 Sb[8];
#pragma unroll
            for (int ks = 0; ks < 8; ++ks) Sb[ks] = attn::pack8(S[ks >> 1], (ks & 1) * 8);
#define GDN_FRAG(base, stride, rowv, k) ({ const LAS bf16_t* f_ = (const LAS bf16_t*)(bb + (base)) + (rowv) * (stride) + 16 * (k) + 4 * hi; \
            const s16x4 lo_ = *(const LAS s16x4*)f_, hi_ = *(const LAS s16x4*)(f_ + 8); (bf16x8)__builtin_shufflevector(lo_, hi_, 0, 1, 2, 3, 4, 5, 6, 7); })
            bf16x8 vb[4];
#pragma unroll
            for (int ct = 0; ct < 2; ++ct) { f32x16 vn = un[ct];
#pragma unroll
                for (int ks = 0; ks < 8; ++ks) vn = MFMA32(GDN_FRAG(S_W, WSTR, ct * 32 + cl, ks), Sb[ks], vn);
                vb[2 * ct] = attn::pack8(vn, 0); vb[2 * ct + 1] = attn::pack8(vn, 8); asm volatile("" ::: "memory"); }
            float* og = (float*)(p.ws + WS_OG) + ((size_t)(b * GH + h) * TP + (size_t)n * 64) * 128 + wave * 32 + cl;
#pragma unroll
            for (int ct = 0; ct < 2; ++ct) { f32x16 o; for (int i = 0; i < 16; ++i) o[i] = 0.f;
#pragma unroll
                for (int ks = 0; ks < 8; ++ks) o = MFMA32(GDN_FRAG(S_QG, WSTR, ct * 32 + cl, ks), Sb[ks], o);
#pragma unroll
                for (int kc = 0; kc < 4; ++kc) o = MFMA32(GDN_FRAG(S_AQK, CSTR, ct * 32 + cl, kc), vb[kc], o);
#pragma unroll
                for (int r = 0; r < 16; ++r) og[(size_t)(ct * 32 + crow(r, hi)) * 128] = o[r];
                asm volatile("" ::: "memory"); }
#pragma unroll
            for (int dkt = 0; dkt < 4; ++dkt) {
#pragma unroll
                for (int i = 0; i < 16; ++i) S[dkt][i] *= gl;
#pragma unroll
                for (int kc = 0; kc < 4; ++kc) S[dkt] = MFMA32(GDN_FRAG(S_KGT, CSTR, dkt * 32 + cl, kc), vb[kc], S[dkt]);
                asm volatile("" ::: "memory"); }
        }
        __syncthreads();
    }
    if (wave < 4) {
        float* so = p.out + O_SP + (size_t)(b * GH + h) * 16384 + wave * 32 + cl;
#pragma unroll
        for (int dkt = 0; dkt < 4; ++dkt)
#pragma unroll
            for (int r = 0; r < 16; ++r) so[(size_t)(dkt * 32 + crow(r, hi)) * 128] = S[dkt][r];
    }
}

DI void post(const Params& p) {
    int tid_ = threadIdx.x; asm volatile("" : "+v"(tid_)); const int tid = tid_, lane = tid & 63;
    const int gh = (blockIdx.x * 512 + tid) >> 5, NGH = (gridDim.x * 512) >> 5, l32 = lane & 31;
    const f32x4 nw = *(const f32x4*)(p.gdn_norm + l32 * 4);
    for (int it = gh; it < MP * GH; it += NGH) {
        const int row = it >> 2, h = it & 3, b = row >> 13, t = row & (TP - 1);
        const f32x4 o = *(const f32x4*)((const float*)(p.ws + WS_OG) + ((size_t)(b * GH + h) * TP + t) * 128 + l32 * 4);
        float s = o[0] * o[0] + o[1] * o[1] + o[2] * o[2] + o[3] * o[3];
#pragma unroll
        for (int x = 1; x < 32; x <<= 1) s += __shfl_xor(s, x);
        const float rs = rsqrtf(s * (1.f / 128.f) + EPS);
        const u32x2 zz = *(const u32x2*)((const bf16_t*)(p.ws + WS_Z) + (size_t)row * 512 + h * 128 + l32 * 4);
        const float z0 = __uint_as_float(zz.x << 16), z1 = __uint_as_float(zz.x & 0xffff0000u), z2 = __uint_as_float(zz.y << 16), z3 = __uint_as_float(zz.y & 0xffff0000u);
        epi::st_bf16x4((bf16_t*)(p.ws + WS_MIX) + (size_t)row * DM + 512 + h * 128 + l32 * 4, o[0] * rs * nw[0] * siluf_(z0), o[1] * rs * nw[1] * siluf_(z1), o[2] * rs * nw[2] * siluf_(z2), o[3] * rs * nw[3] * siluf_(z3));
    }
}
}
namespace cmp {
constexpr int TSTR = 72, C_TOK = 0, C_PART = 76032, C_LDS = C_PART + 8 * 32 * 64 * 4;
constexpr int NSLAB = 8 + 128, NUNIT = NSLAB * 16;
DI void unit(const Params& p, LAS unsigned char* lds, int u) {
    int tid_ = threadIdx.x; asm volatile("" : "+v"(tid_)); const int tid = tid_, lane = tid & 63, wave = __builtin_amdgcn_readfirstlane(tid >> 6), hi = lane >> 5, cl = lane & 31;
    const unsigned char* ws = p.ws;
    const int sl = u >> 4, n0 = (u & 15) * 32;
    const bool samp = sl >= 8;
    int kv, bb, g;
    if (!samp) { kv = sl >> 2; bb = (sl >> 1) & 1; g = sl & 1; } else { const int s2 = sl - 8; kv = s2 >> 6; bb = (s2 >> 1) & 31; g = s2 & 1; }
    LAS bf16_t* TOK = (LAS bf16_t*)(lds + C_TOK); LAS float* PART = (LAS float*)(lds + C_PART);
    __syncthreads();
    for (int i = tid; i < 528 * 8; i += 512) {
        const int tok = i >> 3, ch = i & 7, tk = n0 * 16 + tok;
        u32x4 w = {0u, 0u, 0u, 0u};
        if (tk < TP) {
            if (!samp) w = *(const u32x4*)((const bf16_t*)(ws + (kv ? WS_VC : WS_KC)) + ((size_t)(bb * 2 + g) * TP + tk) * 64 + ch * 8);
            else { const int page = p.page_table[bb * NPAGES + (tk >> 7)];
                const float* src = p.cache_kv + (((size_t)page * PAGE + (tk & 127)) * 4 + kv) * 128 + g * 64 + ch * 8;
                const f32x4 a = *(const f32x4*)src, c = *(const f32x4*)(src + 4);
                w.x = pk2(a[0], a[1]); w.y = pk2(a[2], a[3]); w.z = pk2(c[0], c[1]); w.w = pk2(c[2], c[3]); }
        }
        *(LAS u32x4*)(TOK + ((tok & 15) * 33 + (tok >> 4)) * TSTR + ch * 8) = w;
    }
    __syncthreads();
    f32x16 acc[2]; for (int i = 0; i < 16; ++i) { acc[0][i] = 0.f; acc[1][i] = 0.f; }
    const bf16_t* wt = (const bf16_t*)(ws + WS_WCMP) + (size_t)kv * 64 * 2048;
#pragma unroll 4
    for (int k = 0; k < 16; ++k) {
        const int ks = wave * 16 + k, l = ks >> 2, d0 = (ks & 3) * 16;
        const bf16x8 a = *(const LAS bf16x8*)(TOK + ((l & 15) * 33 + cl + (l >> 4)) * TSTR + d0 + hi * 8);
        const bf16x8 b0 = *(const bf16x8*)(wt + (size_t)cl * 2048 + ks * 16 + hi * 8), b1 = *(const bf16x8*)(wt + (size_t)(32 + cl) * 2048 + ks * 16 + hi * 8);
        acc[0] = MFMA32(a, b0, acc[0]); acc[1] = MFMA32(a, b1, acc[1]);
    }
#pragma unroll
    for (int et = 0; et < 2; ++et)
#pragma unroll
        for (int r = 0; r < 16; ++r) PART[(wave * 32 + crow(r, hi)) * 64 + et * 32 + cl] = acc[et][r];
    __syncthreads();
    const float* cst = (const float*)(ws + WS_CST) + kv * 64;
    for (int i = tid; i < 32 * 64; i += 512) {
        const int n = i >> 6, e = i & 63;
        float s = cst[e];
#pragma unroll
        for (int w = 0; w < 8; ++w) s += PART[(w * 32 + n) * 64 + e];
        const int ng = n0 + n;
        if (ng >= NCMP) s = 0.f;
        if (!samp) { if (kv == 0) ((bf16_t*)(p.ws + WS_CKP))[((size_t)(bb * 2 + g) * 512 + ng) * 64 + e] = f2bf(s);
                     else ((bf16_t*)(p.ws + WS_CVTP))[((size_t)(bb * 2 + g) * 64 + e) * 512 + ng] = f2bf(s); }
        else ((float*)(p.ws + (kv == 0 ? WS_CKS : WS_CVS)))[((size_t)(bb * 2 + g) * 512 + ng) * 64 + e] = s;
    }
}
}
namespace samp {
constexpr int L_KP = 0, L_VP = 8192, L_SC = 16384, L_RED = 32768, L_QS = 34816, L_IMP = 35840, L_SELB = 36400, L_STAT = 36480;
DI float attend(LAS unsigned char* lds, int nk) {
    int tid_ = threadIdx.x; asm volatile("" : "+v"(tid_)); const int tid = tid_, lane = tid & 63, wave = tid >> 6;
    const float* const LAS* KP = (const float* const LAS*)(lds + L_KP); const float* const LAS* VP = (const float* const LAS*)(lds + L_VP);
    LAS float* SC = (LAS float*)(lds + L_SC); LAS float* RED = (LAS float*)(lds + L_RED); const LAS float* QS = (const LAS float*)(lds + L_QS);
    __syncthreads();
    { const int r = tid & 3; float q[64];
#pragma unroll
      for (int d = 0; d < 64; ++d) q[d] = QS[r * 64 + d];
      for (int j = tid >> 2; j < nk; j += 128) {
        const f32x4* k = (const f32x4*)KP[j];
        float s0 = 0.f, s1 = 0.f;
#pragma unroll
        for (int d4 = 0; d4 < 16; ++d4) { const f32x4 kv = k[d4]; s0 += kv[0] * q[d4 * 4] + kv[2] * q[d4 * 4 + 2]; s1 += kv[1] * q[d4 * 4 + 1] + kv[3] * q[d4 * 4 + 3]; }
        SC[r * 1024 + j] = s0 + s1;
      } }
    __syncthreads();
    if (wave < 4) {
        LAS float* sc = SC + wave * 1024;
        float m = NEGBIG; for (int j = lane; j < nk; j += 64) m = fmaxf(m, sc[j]);
#pragma unroll
        for (int o = 1; o < 64; o <<= 1) m = fmaxf(m, __shfl_xor(m, o));
        float l = 0.f; for (int j = lane; j < nk; j += 64) { const float e = __builtin_amdgcn_exp2f(sc[j] - m); sc[j] = e; l += e; }
        l = wave_sum(l); const float inv = 1.f / l;
        for (int j = lane; j < nk; j += 64) sc[j] *= inv;
    }
    __syncthreads();
    {
        const int kh = tid >> 8, r = (tid >> 6) & 3, d = tid & 63;
        const int half = (nk + 1) >> 1, j0 = kh * half, j1 = (j0 + half < nk) ? j0 + half : nk;
        const LAS float* sc = SC + r * 1024;
        float a0 = 0.f, a1 = 0.f, a2 = 0.f, a3 = 0.f; int j = j0;
        for (; j + 4 <= j1; j += 4) { const float v0 = VP[j][d], v1 = VP[j + 1][d], v2 = VP[j + 2][d], v3 = VP[j + 3][d];
            a0 += sc[j] * v0; a1 += sc[j + 1] * v1; a2 += sc[j + 2] * v2; a3 += sc[j + 3] * v3; }
        for (; j < j1; ++j) a0 += sc[j] * VP[j][d];
        RED[tid] = (a0 + a1) + (a2 + a3);
    }
    __syncthreads();
    return tid < 256 ? RED[tid] + RED[256 + tid] : 0.f;
}

DI void attn_unit(const Params& p, LAS unsigned char* lds, int bs, int g) {
    int tid_ = threadIdx.x; asm volatile("" : "+v"(tid_)); const int tid = tid_, lane = tid & 63, wave = tid >> 6;
    const unsigned char* ws = p.ws;
    const float* LAS* KP = (const float* LAS*)(lds + L_KP); const float* LAS* VP = (const float* LAS*)(lds + L_VP);
    LAS float* SC = (LAS float*)(lds + L_SC); LAS float* QS = (LAS float*)(lds + L_QS); LAS float* IMP = (LAS float*)(lds + L_IMP); LAS int* SELB = (LAS int*)(lds + L_SELB);
    const size_t row = (size_t)MP + bs;
    __syncthreads();
    if (tid < 256) QS[tid] = bf2f(((const bf16_t*)(ws + WS_QB))[row * 512 + g * 256 + tid]);
    float gate[3] = {0.f, 0.f, 0.f};
    if (tid < 256) { const float* gt = (const float*)(ws + WS_GT) + row * 32 + (g * 4 + (tid >> 6)) * 3; gate[0] = gt[0]; gate[1] = gt[1]; gate[2] = gt[2]; }
    { const float* ck = (const float*)(ws + WS_CKS) + (size_t)(bs * 2 + g) * 512 * 64; const float* cv = (const float*)(ws + WS_CVS) + (size_t)(bs * 2 + g) * 512 * 64;
      for (int j = tid; j < NCMP; j += 512) { KP[j] = ck + j * 64; VP[j] = cv + j * 64; } }
    float ofin = gate[0] * attend(lds, NCMP);
    if (tid < 128) { const int s = tid; float a = 0.f;
        for (int n = 4 * s - 1; n <= 4 * s + 3; ++n) if (n >= 0 && n < NCMP) a += (SC[n] + SC[1024 + n]) + (SC[2048 + n] + SC[3072 + n]);
        IMP[s] = a; }
    __syncthreads();
    if (wave == 0) {
        const unsigned long long lt = (1ull << lane) - 1ull;
        const int xA = __float_as_int(IMP[lane] + (lane == 0 ? 1e4f : 0.f)), xB = __float_as_int(IMP[64 + lane] + (lane == 63 ? 1e4f : 0.f));
        int T = 0;
        for (int bit = 30; bit >= 0; --bit) { const int T2 = T | (1 << bit); const int c = __popcll(__ballot(xA >= T2)) + __popcll(__ballot(xB >= T2)); if (c >= 15) T = T2; }
        const bool gA = xA > T, gB = xB > T, eA = xA == T, eB = xB == T;
        const int need = 15 - (__popcll(__ballot(gA)) + __popcll(__ballot(gB)));
        const unsigned long long beA = __ballot(eA), beB = __ballot(eB);
        const bool sA = gA || (eA && __popcll(beA & lt) < need), sB = gB || (eB && __popcll(beA) + __popcll(beB & lt) < need);
        const unsigned long long mA = __ballot(sA), mB = __ballot(sB);
        if (sA) SELB[__popcll(mA & lt)] = lane;
        if (sB) SELB[__popcll(mA) + __popcll(mB & lt)] = 64 + lane;
    }
    __syncthreads();
    for (int j = tid; j < 961; j += 512) {
        if (j < 960) { const int tp = SELB[j >> 6] * 64 + (j & 63); const int page = p.page_table[bs * NPAGES + (tp >> 7)];
            const float* rb = p.cache_kv + ((size_t)page * PAGE + (tp & 127)) * 512 + g * 64; KP[j] = rb + 256; VP[j] = rb + 384; }
        else { const float* rb = p.out + O_KVS + (size_t)bs * 512 + g * 64; KP[j] = rb + 256; VP[j] = rb + 384; }
    }
    ofin += gate[1] * attend(lds, 961);
    for (int j = tid; j < 513; j += 512) {
        const float* rb = j < 512 ? p.cache_win + ((size_t)bs * 512 + j) * 256 + g * 64 : p.out + O_WINS + ((size_t)bs * 512 + 511) * 256 + g * 64;
        KP[j] = rb; VP[j] = rb + 128; }
    ofin += gate[2] * attend(lds, 513);
    if (tid < 256) ((bf16_t*)(p.ws + WS_MIX))[row * DM + g * 256 + tid] = f2bf(ofin);
}

DI void gdn_unit(const Params& p, LAS unsigned char* lds, int bs, int h) {
    int tid_ = threadIdx.x; asm volatile("" : "+v"(tid_)); const int tid = tid_, lane = tid & 63;
    const unsigned char* ws = p.ws;
    LAS float* QKV = (LAS float*)lds;
    LAS float* RED = QKV + 384;
    LAS float* VN = RED + 1024;
    LAS float* ST = VN + 128;
    const size_t row = (size_t)MP + bs;
    __syncthreads();
    if (tid < 384) {
        const int part = tid >> 7, dd = tid & 127, ch = part * 512 + h * 128 + dd;
        const float* st = p.state_conv + (size_t)bs * 3 * CCH + ch;
        const float xn = p.out[O_CONVS + (size_t)(bs * 3 + 2) * CCH + ch];
        const float a = st[0] * p.conv_w[ch] + st[CCH] * p.conv_w[CCH + ch] + st[2 * CCH] * p.conv_w[2 * CCH + ch] + xn * p.conv_w[3 * CCH + ch];
        const float c = siluf_(a);
        QKV[tid] = c;
        float s = wave_sum(c * c);
        if (lane == 0) ST[tid >> 6] = s;
    }
    __syncthreads();
    const float rq = rsqrtf(ST[0] + ST[1] + EPS) * 0.08838834764831845f, rk = rsqrtf(ST[2] + ST[3] + EPS);
    const float* gt = (const float*)(ws + WS_GT) + row * 32;
    const float eg = __expf(gt[24 + h]), beta = gt[28 + h];
    const int dv = tid & 127, qd = tid >> 7;
    const float* S0 = p.state_S + (size_t)(bs * GH + h) * 16384;
    float sreg[32], ks = 0.f, qs = 0.f, qk = 0.f;
#pragma unroll
    for (int i = 0; i < 32; ++i) { const int dk = qd * 32 + i; const float s = S0[dk * 128 + dv]; sreg[i] = s; const float kk = QKV[128 + dk] * rk, qq = QKV[dk] * rq; ks += kk * s; qs += qq * s; qk += kk * qq; }
    RED[(qd * 2 + 0) * 128 + dv] = ks; RED[(qd * 2 + 1) * 128 + dv] = qs;
    if (dv == 0) ST[8 + qd] = qk;
    __syncthreads();
    const float kS = (RED[dv] + RED[256 + dv]) + (RED[512 + dv] + RED[768 + dv]);
    const float qS = (RED[128 + dv] + RED[384 + dv]) + (RED[640 + dv] + RED[896 + dv]);
    const float qkd = (ST[8] + ST[9]) + (ST[10] + ST[11]);
    const float vn = beta * (QKV[256 + dv] - eg * kS);
    const float o = eg * qS + qkd * vn;
    float* Sn = p.out + O_SS + (size_t)(bs * GH + h) * 16384;
#pragma unroll
    for (int i = 0; i < 32; ++i) { const int dk = qd * 32 + i; Sn[dk * 128 + dv] = eg * sreg[i] + QKV[128 + dk] * rk * vn; }
    if (tid < 128) {
        float s = wave_sum(o * o); if (lane == 0) ST[16 + (tid >> 6)] = s;
    }
    __syncthreads();
    if (tid < 128) {
        const float rs = rsqrtf((ST[16] + ST[17]) * (1.f / 128.f) + EPS);
        const float z = bf2f(((const bf16_t*)(ws + WS_Z))[row * 512 + h * 128 + tid]);
        ((bf16_t*)(p.ws + WS_MIX))[row * DM + 512 + h * 128 + tid] = f2bf(o * rs * p.gdn_norm[tid] * siluf_(z));
    }
}
}
constexpr int NTHREADS = 512;
constexpr int LDS_BYTES = 147456;
constexpr int LDS_SLOT = LDS_BYTES - 16;

DI int next_unit(unsigned* ctr, LAS unsigned char* lds) {
    LAS int* slot = (LAS int*)(lds + LDS_SLOT);
    __syncthreads();
    if (threadIdx.x == 0) *slot = (int)atomicAdd(ctr, 1u);
    __syncthreads();
    return *slot;
}

DI void phase_proj(const Params& p, LAS unsigned char* lds) {
    pg8::Gemm g{(const bf16_t*)(p.ws + WS_XN), (const bf16_t*)(p.ws + WS_WIN), MROWS, INW_PAD, DM};
    pg8::StaticOrder S; S.init(MROWS, INW_PAD, gridDim.x, blockIdx.x);
    epi::EpiProj E{p.out, p.ws, p.a_log, p.dt_bias};
    pg8::gemm_phase<epi::EpiProj, pg8::StaticOrder, true, true>(lds, g, S, E);
}
DI void phase_prep(const Params& p, LAS unsigned char* lds) {
    unsigned* ctr = (unsigned*)(p.ws + WS_CTL) + 64;
    constexpr int NU = cmp::NUNIT + NBP * GH * NCHUNK;
    for (;;) {
        const int u = next_unit(ctr, lds); if (u >= NU) break;
        Params q = p; asm volatile("" : "+s"(q.ws), "+s"(q.out));
        if (u < cmp::NUNIT) { const int v = cmp::NUNIT - 1 - u; cmp::unit(q, lds, v); }
        else { const int v = u - cmp::NUNIT; gdn::prep_unit(q, lds, v >> 9, (v >> 7) & 3, v & 127); }
    }
}
DI void phase_mix(const Params& p, LAS unsigned char* lds) {
    unsigned* ctr = (unsigned*)(p.ws + WS_CTL) + 128;
    constexpr int NU = 8 + 64 + 128 + 512;
    for (;;) {
        const int u = next_unit(ctr, lds); if (u >= NU) break;
        Params q = p; asm volatile("" : "+s"(q.ws), "+s"(q.out));
        if (u < 8) gdn::scan_unit(q, lds, u >> 2, u & 3);
        else if (u < 72) { const int v = u - 8; samp::attn_unit(q, lds, v >> 1, v & 1); }
        else if (u < 200) { const int v = u - 72; samp::gdn_unit(q, lds, v >> 2, v & 3); }
        else { const int v = u - 200; attn::unit(q, lds, (v >> 1) & 1, v & 1, 127 - (v >> 2)); }
    }
}
DI void phase_out(const Params& p, LAS unsigned char* lds) {
    pg8::Gemm g{(const bf16_t*)(p.ws + WS_MIX), (const bf16_t*)(p.ws + WS_WOUT), MROWS, DM, DM};
    pg8::StaticOrder S; S.init(MROWS, DM, gridDim.x, blockIdx.x);
    epi::EpiOut E{p.x_prompt, p.x_sample, p.ws};
    pg8::gemm_phase<epi::EpiOut, pg8::StaticOrder, true, true>(lds, g, S, E);
}
DI void phase_up(const Params& p, LAS unsigned char* lds) {
    pg8::Gemm g{(const bf16_t*)(p.ws + WS_HPB), (const bf16_t*)(p.ws + WS_WGU), MROWS, 2 * DFF, DM};
    pg8::StaticOrder S; S.init(MROWS, 2 * DFF, gridDim.x, blockIdx.x);
    epi::EpiUp E{p.ws};
    pg8::gemm_phase<epi::EpiUp, pg8::StaticOrder, true, true>(lds, g, S, E);
}
DI void phase_down(const Params& p, LAS unsigned char* lds) {
    pg8::Gemm g{(const bf16_t*)(p.ws + WS_HID), (const bf16_t*)(p.ws + WS_WDN), MROWS, DM, DFF};
    pg8::StaticOrder S; S.init(MROWS, DM, gridDim.x, blockIdx.x);
    epi::EpiDown E{p.ws};
    pg8::gemm_phase<epi::EpiDown, pg8::StaticOrder, true, true>(lds, g, S, E);
}
DI void phase_final(const Params& p) {
    int tid_ = threadIdx.x; asm volatile("" : "+v"(tid_)); const int tid = tid_, lane = tid & 63, gw = blockIdx.x * 8 + (tid >> 6), NGW = gridDim.x * 8;
    for (int row = gw; row < MP + NBS; row += NGW) {
        const float* hr = (const float*)(p.ws + WS_HP) + (size_t)row * DM;
        float* o = row < MP ? p.out + O_YP + (size_t)row * DM : p.out + O_YS + (size_t)(row - MP) * DM;
        f32x4 v[4]; float s = 0.f;
#pragma unroll
        for (int j = 0; j < 4; ++j) { v[j] = *(const f32x4*)(hr + (j * 64 + lane) * 4); s += v[j][0] * v[j][0] + v[j][1] * v[j][1] + v[j][2] * v[j][2] + v[j][3] * v[j][3]; }
        const float rs = rsqrtf(wave_sum(s) * (1.f / DM) + EPS);
#pragma unroll
        for (int j = 0; j < 4; ++j) { const f32x4 g = *(const f32x4*)(p.norm_final + (j * 64 + lane) * 4); *(f32x4*)(o + (j * 64 + lane) * 4) = (f32x4){v[j][0] * rs * g[0], v[j][1] * rs * g[1], v[j][2] * rs * g[2], v[j][3] * rs * g[3]}; }
    }
}

#define LDS_DECL extern __shared__ __attribute__((aligned(16))) unsigned char lds_raw[]; LAS unsigned char* lds = (LAS unsigned char*)lds_raw
#ifndef MK_MULTI
#define MK_MULTI 0
#endif
#if MK_MULTI
__global__ void __launch_bounds__(NTHREADS, 2) k_p0(Params p) { p0::run(p); }
__global__ void __launch_bounds__(NTHREADS, 2) k_p1(Params p) { LDS_DECL; phase_proj(p, lds); }
__global__ void __launch_bounds__(NTHREADS, 2) k_p2(Params p) { LDS_DECL; phase_prep(p, lds); }
__global__ void __launch_bounds__(NTHREADS, 2) k_p3(Params p) { LDS_DECL; phase_mix(p, lds); }
__global__ void __launch_bounds__(NTHREADS, 2) k_p4(Params p) { gdn::post(p); }
__global__ void __launch_bounds__(NTHREADS, 2) k_p5(Params p) { LDS_DECL; phase_out(p, lds); }
__global__ void __launch_bounds__(NTHREADS, 2) k_p6(Params p) { LDS_DECL; phase_up(p, lds); }
__global__ void __launch_bounds__(NTHREADS, 2) k_p7(Params p) { LDS_DECL; phase_down(p, lds); }
__global__ void __launch_bounds__(NTHREADS, 2) k_p8(Params p) { phase_final(p); }
#else
__global__ void __launch_bounds__(NTHREADS, 2) k_mega(Params p) {
    LDS_DECL;
    cg::grid_group grid = cg::this_grid();
#define PHASE(call) do { Params q = p; asm volatile("" : "+s"(q.ws), "+s"(q.out)); call; } while (0)
    PHASE(p0::run(q));            grid.sync();
    PHASE(phase_proj(q, lds));    grid.sync();
    PHASE(phase_prep(q, lds));    grid.sync();
    PHASE(phase_mix(q, lds));     grid.sync();
    PHASE(gdn::post(q));          grid.sync();
    PHASE(phase_out(q, lds));     grid.sync();
    PHASE(phase_up(q, lds));      grid.sync();
    PHASE(phase_down(q, lds));    grid.sync();
    PHASE(phase_final(q));
}
#endif

extern "C" void kernel_launch(void* const* d_in, const int* in_sizes, int n_in, void* d_out, int out_size, void* d_ws, size_t ws_size, hipStream_t stream) {
    static int grid = 0;
    if (grid == 0) {
        if (n_in != 20 || out_size != (int)O_END || ws_size < WS_END) { fprintf(stderr, "kernel_launch: unexpected shapes n_in %d out %d ws %zu\n", n_in, out_size, ws_size); grid = -1; return; }
        int dev = 0, cus = 0;
        (void)hipGetDevice(&dev); (void)hipDeviceGetAttribute(&cus, hipDeviceAttributeMultiprocessorCount, dev);
#if MK_MULTI
        const void* ks[] = {(const void*)k_p1, (const void*)k_p2, (const void*)k_p3, (const void*)k_p5, (const void*)k_p6, (const void*)k_p7};
        for (auto k : ks) (void)hipFuncSetAttribute(k, hipFuncAttributeMaxDynamicSharedMemorySize, LDS_BYTES);
        grid = cus > 0 ? cus : 256;
#else
        (void)hipFuncSetAttribute((const void*)k_mega, hipFuncAttributeMaxDynamicSharedMemorySize, LDS_BYTES);
        int per_cu = 0;
        if (hipOccupancyMaxActiveBlocksPerMultiprocessor(&per_cu, (const void*)k_mega, NTHREADS, LDS_BYTES) != hipSuccess || per_cu < 1) { fprintf(stderr, "kernel_launch: occupancy query failed (%d)\n", per_cu); (void)hipGetLastError(); per_cu = 1; }
        if (per_cu > 1) per_cu = 1;
        grid = (cus > 0 ? cus : 256) * per_cu;
#endif
    }
    if (grid < 0) return;
    Params p{};
    p.x_prompt = (const float*)d_in[0]; p.x_sample = (const float*)d_in[1]; p.cache_kv = (const float*)d_in[2]; p.cache_win = (const float*)d_in[3];
    p.state_S = (const float*)d_in[4]; p.state_conv = (const float*)d_in[5]; p.page_table = (const int*)d_in[6]; p.norm_mix = (const float*)d_in[7];
    p.w_in = (const float*)d_in[8]; p.cmp_pe = (const float*)d_in[9]; p.cmp_w = (const float*)d_in[10]; p.conv_w = (const float*)d_in[11];
    p.a_log = (const float*)d_in[12]; p.dt_bias = (const float*)d_in[13]; p.gdn_norm = (const float*)d_in[14]; p.w_out = (const float*)d_in[15];
    p.norm_ffn = (const float*)d_in[16]; p.w_gate_up = (const float*)d_in[17]; p.w_down = (const float*)d_in[18]; p.norm_final = (const float*)d_in[19];
    p.out = (float*)d_out; p.ws = (unsigned char*)d_ws;
    (void)hipMemsetAsync((char*)d_ws + WS_CTL, 0, WS_ZERO_BYTES, stream);
#if MK_MULTI
    hipLaunchKernelGGL(k_p0, dim3(grid), dim3(NTHREADS), 0, stream, p);
    hipLaunchKernelGGL(k_p1, dim3(grid), dim3(NTHREADS), LDS_BYTES, stream, p);
    hipLaunchKernelGGL(k_p2, dim3(grid), dim3(NTHREADS), LDS_BYTES, stream, p);
    hipLaunchKernelGGL(k_p3, dim3(grid), dim3(NTHREADS), LDS_BYTES, stream, p);
    hipLaunchKernelGGL(k_p4, dim3(grid), dim3(NTHREADS), 0, stream, p);
    hipLaunchKernelGGL(k_p5, dim3(grid), dim3(NTHREADS), LDS_BYTES, stream, p);
    hipLaunchKernelGGL(k_p6, dim3(grid), dim3(NTHREADS), LDS_BYTES, stream, p);
    hipLaunchKernelGGL(k_p7, dim3(grid), dim3(NTHREADS), LDS_BYTES, stream, p);
    hipLaunchKernelGGL(k_p8, dim3(grid), dim3(NTHREADS), 0, stream, p);
#else
    void* args[] = {&p};
    hipError_t e = hipLaunchCooperativeKernel((const void*)k_mega, dim3(grid), dim3(NTHREADS), args, LDS_BYTES, stream);
    if (e != hipSuccess) fprintf(stderr, "kernel_launch: cooperative launch failed: %s (grid %d)\n", hipGetErrorString(e), grid);
#endif
}
```

```cpp
#include <hip/hip_runtime.h>
#include <hip/hip_cooperative_groups.h>
#include <cstdio>
#include <cstdint>
namespace cg = cooperative_groups;

#define DI __device__ __forceinline__
#define LAS __attribute__((address_space(3)))
typedef unsigned short bf16_t;
typedef short bf16x8 __attribute__((ext_vector_type(8)));
typedef short s16x4 __attribute__((ext_vector_type(4)));
typedef float f32x4 __attribute__((ext_vector_type(4)));
typedef float f32x2 __attribute__((ext_vector_type(2)));
typedef float f32x16 __attribute__((ext_vector_type(16)));
typedef unsigned u32x4 __attribute__((ext_vector_type(4)));
typedef unsigned u32x2 __attribute__((ext_vector_type(2)));
typedef __bf16 bf16x2_t __attribute__((ext_vector_type(2)));

constexpr int DM = 1024, TP = 8192, NBP = 2, MP = NBP * TP, NBS = 32, MROWS = 16640  ;
constexpr int HD = 64, NQH = 8, NG = 2, NREP = 4;
constexpr int NPAGES = 64, PAGE = 128, NPOOL = 2560;
constexpr int GH = 4, GDK = 128, GDV = 128, CCH = 1536, NCHUNK = 128;
constexpr int INW = 3360, INW_PAD = 3584, DFF = 2816;
constexpr int NCMP = 511;
constexpr float EPS = 1e-6f, LOG2E = 1.4426950408889634f, QSCALE = 0.125f * LOG2E, NEGBIG = -1e30f;

constexpr size_t O_YP = 0, O_YS = 16777216, O_KVP = 16809984, O_WINP = 25198592, O_SP = 25460736, O_CONVP = 25591808,
                 O_KVS = 25601024, O_WINS = 25617408, O_SS = 29811712, O_CONVS = 31908864, O_END = 32056320;

constexpr size_t MiB = 1u << 20;
constexpr size_t WS_CTL = 0;
constexpr size_t WS_SSQ1 = 1 * MiB, WS_SSQ2 = WS_SSQ1 + 128 * 1024;
constexpr size_t WS_ZERO_BYTES = 2 * MiB;
constexpr size_t WS_WIN = 2 * MiB;
constexpr size_t WS_WOUT = 10 * MiB;
constexpr size_t WS_WGU = 12 * MiB;
constexpr size_t WS_WDN = 24 * MiB;
constexpr size_t WS_WCMP = 30 * MiB;
constexpr size_t WS_CST = 31 * MiB;
constexpr size_t WS_ROPE = 32 * MiB;
constexpr size_t WS_XN = 36 * MiB;
constexpr size_t WS_QB = 70 * MiB;
constexpr size_t WS_KC = 88 * MiB, WS_VC = 93 * MiB;
constexpr size_t WS_KSEL = 98 * MiB, WS_VSELT = 103 * MiB;
constexpr size_t WS_KWIN = 108 * MiB, WS_VWINT = 113 * MiB;
constexpr size_t WS_CI = 118 * MiB;
constexpr size_t WS_Z = 168 * MiB;
constexpr size_t WS_GT = 186 * MiB;
constexpr size_t WS_CKP = 190 * MiB, WS_CVTP = 191 * MiB;
constexpr size_t WS_CKS = 192 * MiB, WS_CVS = 200 * MiB;
constexpr size_t WS_MIX = 208 * MiB;
constexpr size_t WS_HP = 242 * MiB;
constexpr size_t WS_HPB = 308 * MiB;
constexpr size_t WS_HID = 342 * MiB;
constexpr size_t WS_GW = 432 * MiB;
constexpr size_t WS_GQG = 448 * MiB;
constexpr size_t WS_GKGT = 464 * MiB;
constexpr size_t WS_GAQK = 480 * MiB;
constexpr size_t WS_GU = 488 * MiB;
constexpr size_t WS_GGL = 520 * MiB;
constexpr size_t WS_OG = 521 * MiB;
constexpr size_t WS_END = 560 * MiB;
constexpr int CW_Q3 = 64;

struct Params {
    const float *x_prompt, *x_sample, *cache_kv, *cache_win, *state_S, *state_conv;
    const int* page_table;
    const float *norm_mix, *w_in, *cmp_pe, *cmp_w, *conv_w, *a_log, *dt_bias, *gdn_norm, *w_out, *norm_ffn, *w_gate_up, *w_down, *norm_final;
    float* out;
    unsigned char* ws;
};

DI unsigned pk2(float lo, float hi) { f32x2 v = {lo, hi}; bf16x2_t b = __builtin_convertvector(v, bf16x2_t); return __builtin_bit_cast(unsigned, b); }
DI bf16_t f2bf(float f) { return (bf16_t)(pk2(f, 0.f) & 0xffffu); }
DI float bf2f(bf16_t h) { return __uint_as_float(((unsigned)h) << 16); }
DI float sigmoidf_(float x) { return 1.f / (1.f + __expf(-x)); }
DI float siluf_(float x) { return x / (1.f + __expf(-x)); }
DI float wave_sum(float v) {
#pragma unroll
    for (int o = 1; o < 64; o <<= 1) v += __shfl_xor(v, o);
    return v;
}
#define MFMA32(a, b, c) __builtin_amdgcn_mfma_f32_32x32x16_bf16((a), (b), (c), 0, 0, 0)
DI int crow(int r, int hi) { return (r & 3) + 8 * (r >> 2) + 4 * hi; }
#define LDS_FADD(ptr, v) (void)__hip_atomic_fetch_add((ptr), (v), __ATOMIC_RELAXED, __HIP_MEMORY_SCOPE_WORKGROUP)
namespace pg8 {
#define PG8_LAS __attribute__((address_space(3)))
typedef ::bf16_t bf16_t;
typedef ::bf16x8 bf16x8;
typedef ::f32x4 f32x4;
typedef ::u32x4 u32x4;
constexpr int BM = 256, BK = 64, HALF = 128, HTB = HALF * BK * 2  , STAGE_BYTES = 8 * HTB, NXCD = 8, WGM = 8;

__host__ __device__ __forceinline__ int lds_byte(int r, int c) { const int st = (r >> 4) * 2 + (c >> 5), rr = r & 15, cc = c & 31, ob = rr * 64 + cc * 2; return st * 1024 + (ob ^ (((ob >> 9) & 1) << 5)); }
__host__ __device__ __forceinline__ void stage_rc(int b, int& R, int& C) { const int st = b / 1024, sb = b % 1024, swz = sb ^ (((sb >> 9) & 1) << 5); R = (st >> 1) * 16 + swz / 64; C = (st & 1) * 32 + (swz % 64) / 2; }
__host__ __device__ __forceinline__ int perm32(int rho) { const int n = rho >> 4, i = rho & 15; return 8 * (i >> 2) + 4 * n + (i & 3); }

struct Unit { int pm, pn; };
struct Gemm { const bf16_t* A; const bf16_t* Bt; int M, N, K; };

struct StaticOrder {
    int nM, nN, nwg, G, c;
    __host__ __device__ void init(int M, int N, int G_, int c_) { nM = M / BM; nN = N / BM; nwg = nM * nN; G = G_; c = c_; }
    __host__ __device__ bool next(int i, Unit& u) const {
        const long L = (long)i * G + c; if (L >= nwg) return false;
        int wgid = (int)L; { const int q = nwg / NXCD, r = nwg % NXCD, xcd = wgid % NXCD, off = wgid / NXCD; wgid = (xcd < r ? xcd * (q + 1) : r * (q + 1) + (xcd - r) * q) + off; }
        const int nig = WGM * nN, gid = wgid / nig, fm = gid * WGM, gsz = (nM - fm) < WGM ? (nM - fm) : WGM;
        u.pm = fm + ((wgid % nig) % gsz); u.pn = (wgid % nig) / gsz; return true;
    }
    __device__ __forceinline__ void a_ready(const Unit&) const {}
    __device__ __forceinline__ void done(const Unit&) const {}
};


template <class Epi, class Sched, bool ALIGN_EPI = false, bool SP2 = false>
__device__ __forceinline__ void gemm_phase(PG8_LAS unsigned char* lds, const Gemm g, const Sched& S, const Epi& E) {
    int tid_ = threadIdx.x; asm volatile("" : "+v"(tid_)); const int tid = tid_, wid = __builtin_amdgcn_readfirstlane(tid >> 6), lane = tid & 63, wr = wid >> 2, wc = wid & 3, fr = lane & 15, fq = lane >> 4;
    const int K = g.K, nt = K / BK;
    unsigned voffA[2], voffB[2];
#pragma unroll
    for (int i = 0; i < 2; ++i) { int R, C; stage_rc(tid * 16 + i * 8192, R, C); const int Rb = Epi::PERM ? ((R & ~31) + perm32(R & 31)) : R;
        voffA[i] = (unsigned)(R * K + C) * 2u; voffB[i] = (unsigned)(Rb * K + C) * 2u; }
    const size_t kstep = (size_t)(BK * 2);
    const size_t hstep = (size_t)HALF * K * 2;
    const size_t tstep = 2 * hstep;
    const unsigned ldsw = (unsigned)wid * 1024u;
    const int aoff = lds_byte(wr * 64 + fr, fq * 8), boff = lds_byte(wc * 32 + fr, fq * 8);
#define PG8_SA(b, h) (((b) * 2 + (h)) * HTB)
#define PG8_SB(b, h) ((4 + (b) * 2 + (h)) * HTB)
#define PG8_STAGE(bufoff, gbase, voff) do { _Pragma("unroll") for (int _i = 0; _i < 2; ++_i) \
        __builtin_amdgcn_global_load_lds((const unsigned*)((const char*)(gbase) + (voff)[_i]), (PG8_LAS unsigned*)(lds + (bufoff) + ldsw + _i * 8192), 16, 0, 0); } while (0)
#define PG8_LDA(dst, b, h) do { _Pragma("unroll") for (int m = 0; m < 4; ++m) _Pragma("unroll") for (int k = 0; k < 2; ++k) dst[m][k] = *(const PG8_LAS bf16x8*)(lds + PG8_SA(b, h) + aoff + m * 2048 + k * 1024); } while (0)
#define PG8_LDB(dst, b, h) do { _Pragma("unroll") for (int n = 0; n < 2; ++n) _Pragma("unroll") for (int k = 0; k < 2; ++k) dst[n][k] = *(const PG8_LAS bf16x8*)(lds + PG8_SB(b, h) + boff + n * 2048 + k * 1024); } while (0)
#define PG8_MMA(ai, bj, At, Bt) do { __builtin_amdgcn_s_setprio(1); _Pragma("unroll") for (int m = 0; m < 4; ++m) _Pragma("unroll") for (int n = 0; n < 2; ++n) _Pragma("unroll") for (int k = 0; k < 2; ++k) \
        acc[ai][bj][m][n] = __builtin_amdgcn_mfma_f32_16x16x32_bf16(Bt[n][k], At[m][k], acc[ai][bj][m][n], 0, 0, 0); __builtin_amdgcn_s_setprio(0); } while (0)
#define PG8_WAIT_V(n) asm volatile("s_waitcnt vmcnt(" #n ")" ::: "memory")
#define PG8_WAIT_L(n) asm volatile("s_waitcnt lgkmcnt(" #n ")" ::: "memory")
#define PG8_BAR __builtin_amdgcn_s_barrier()
#define PG8_SCHED __builtin_amdgcn_sched_barrier(0)
    Unit cur, nxt; int ui = 0;
    if (!S.next(0, cur)) return;
    f32x4 acc[2][2][4][2];
#pragma unroll
    for (int a = 0; a < 2; ++a)
#pragma unroll
        for (int b = 0; b < 2; ++b)
#pragma unroll
            for (int m = 0; m < 4; ++m)
#pragma unroll
                for (int n = 0; n < 2; ++n) acc[a][b][m][n] = (f32x4){0.f, 0.f, 0.f, 0.f};
    bf16x8 At[4][2], B0[2][2], B1[2][2];
    const char* cA = (const char*)g.A + (size_t)cur.pm * tstep; const char* cB = (const char*)g.Bt + (size_t)cur.pn * tstep;
    S.a_ready(cur);
    if constexpr (SP2) {
        PG8_STAGE(PG8_SB(0, 0), cB, voffB); PG8_STAGE(PG8_SB(0, 1), cB + hstep, voffB); PG8_STAGE(PG8_SA(0, 0), cA, voffA); PG8_STAGE(PG8_SA(0, 1), cA + hstep, voffA);
        if (wr == 1) PG8_BAR;
        PG8_WAIT_V(2); PG8_BAR;
        PG8_STAGE(PG8_SB(1, 0), cB + kstep, voffB); PG8_STAGE(PG8_SA(1, 0), cA + kstep, voffA); PG8_STAGE(PG8_SB(1, 1), cB + hstep + kstep, voffB);
        PG8_WAIT_V(6); PG8_BAR;
    } else {
        PG8_STAGE(PG8_SB(0, 0), cB, voffB); PG8_STAGE(PG8_SA(0, 0), cA, voffA); PG8_STAGE(PG8_SB(0, 1), cB + hstep, voffB); PG8_STAGE(PG8_SA(0, 1), cA + hstep, voffA);
        if (wr == 1) PG8_BAR;
        PG8_WAIT_V(4); PG8_BAR;
        PG8_STAGE(PG8_SB(1, 0), cB + kstep, voffB); PG8_STAGE(PG8_SA(1, 0), cA + kstep, voffA); PG8_STAGE(PG8_SB(1, 1), cB + hstep + kstep, voffB);
        PG8_WAIT_V(6); PG8_BAR;
    }
    for (;;) {
        const bool has_next = S.next(ui + 1, nxt);
        const char* nA = has_next ? (const char*)g.A + (size_t)nxt.pm * tstep : cA; const char* nB = has_next ? (const char*)g.Bt + (size_t)nxt.pn * tstep : cB;
        for (int t = 0; t < nt; t += 2) {
            const bool last = (t == nt - 2);
            const char* a1 = cA + (size_t)(t + 1) * kstep;
            const char* a2 = last ? nA : cA + (size_t)(t + 2) * kstep; const char* b2 = last ? nB : cB + (size_t)(t + 2) * kstep;
            const char* a3 = a2 + kstep; const char* b3 = b2 + kstep;
            if (last && has_next) S.a_ready(nxt);
            if constexpr (SP2) {
            PG8_LDB(B0, 0, 0); PG8_LDB(B1, 0, 1); PG8_SCHED; PG8_LDA(At, 0, 0); PG8_STAGE(PG8_SA(1, 1), a1 + hstep, voffA);
            PG8_WAIT_V(8); PG8_WAIT_L(0); PG8_BAR; PG8_MMA(0, 0, At, B0); PG8_MMA(0, 1, At, B1); PG8_BAR; PG8_SCHED;
            PG8_LDA(At, 0, 1); PG8_STAGE(PG8_SB(0, 0), b2, voffB); PG8_STAGE(PG8_SB(0, 1), b2 + hstep, voffB); PG8_STAGE(PG8_SA(0, 0), a2, voffA);
            PG8_WAIT_V(8); PG8_WAIT_L(0); PG8_BAR; PG8_MMA(1, 0, At, B0); PG8_MMA(1, 1, At, B1); PG8_BAR; PG8_SCHED;
            PG8_LDB(B0, 1, 0); PG8_LDB(B1, 1, 1); PG8_SCHED; PG8_LDA(At, 1, 0); PG8_STAGE(PG8_SA(0, 1), a2 + hstep, voffA);
            PG8_WAIT_V(8); PG8_WAIT_L(0); PG8_BAR; PG8_MMA(0, 0, At, B0); PG8_MMA(0, 1, At, B1); PG8_BAR; PG8_SCHED;
            PG8_LDA(At, 1, 1); PG8_STAGE(PG8_SB(1, 0), b3, voffB); PG8_STAGE(PG8_SB(1, 1), b3 + hstep, voffB); PG8_STAGE(PG8_SA(1, 0), a3, voffA);
            PG8_WAIT_V(8); PG8_WAIT_L(0); PG8_BAR; PG8_MMA(1, 0, At, B0); PG8_MMA(1, 1, At, B1); PG8_BAR; PG8_SCHED;
            } else {
            PG8_LDB(B0, 0, 0); PG8_SCHED; PG8_LDA(At, 0, 0); PG8_STAGE(PG8_SA(1, 1), a1 + hstep, voffA);
            PG8_WAIT_L(8); PG8_BAR; PG8_WAIT_L(0); PG8_MMA(0, 0, At, B0); PG8_BAR; PG8_SCHED;
            PG8_LDB(B1, 0, 1); PG8_STAGE(PG8_SB(0, 0), b2, voffB);
            PG8_BAR; PG8_WAIT_L(0); PG8_MMA(0, 1, At, B1); PG8_BAR;
            PG8_LDA(At, 0, 1); PG8_STAGE(PG8_SA(0, 0), a2, voffA);
            PG8_BAR; PG8_WAIT_L(0); PG8_MMA(1, 0, At, B0); PG8_BAR; PG8_SCHED;
            PG8_STAGE(PG8_SB(0, 1), b2 + hstep, voffB);
            PG8_WAIT_V(6); PG8_BAR; PG8_MMA(1, 1, At, B1); PG8_BAR;
            PG8_LDB(B0, 1, 0); PG8_SCHED; PG8_LDA(At, 1, 0); PG8_STAGE(PG8_SA(0, 1), a2 + hstep, voffA);
            PG8_WAIT_L(8); PG8_BAR; PG8_WAIT_L(0); PG8_MMA(0, 0, At, B0); PG8_BAR; PG8_SCHED;
            PG8_LDB(B1, 1, 1); PG8_STAGE(PG8_SB(1, 0), b3, voffB);
            PG8_BAR; PG8_WAIT_L(0); PG8_MMA(0, 1, At, B1); PG8_BAR;
            PG8_LDA(At, 1, 1); PG8_STAGE(PG8_SA(1, 0), a3, voffA);
            PG8_BAR; PG8_WAIT_L(0); PG8_MMA(1, 0, At, B0); PG8_BAR; PG8_SCHED;
            PG8_STAGE(PG8_SB(1, 1), b3 + hstep, voffB);
            PG8_WAIT_V(6); PG8_BAR; PG8_MMA(1, 1, At, B1); PG8_BAR;
            }
        }
        if constexpr (ALIGN_EPI) { if (wr == 0) PG8_BAR; }
        if constexpr (!Epi::AFTER_DRAIN) { E(acc, cur, wr, wc, fr, fq); S.done(cur); }
        if (!has_next) break;
#pragma unroll
        for (int a = 0; a < 2; ++a)
#pragma unroll
            for (int b = 0; b < 2; ++b)
#pragma unroll
                for (int m = 0; m < 4; ++m)
#pragma unroll
                    for (int n = 0; n < 2; ++n) acc[a][b][m][n] = (f32x4){0.f, 0.f, 0.f, 0.f};
        cur = nxt; cA = nA; cB = nB; ++ui;
        if constexpr (ALIGN_EPI) { if (wr == 1) PG8_BAR; }
    }
    PG8_WAIT_V(0);
    if constexpr (!ALIGN_EPI) { if (wr == 0) PG8_BAR; }
    PG8_BAR;
    if constexpr (Epi::AFTER_DRAIN) { E.fused(acc, cur, wr, wc, fr, fq, lds, wid, lane); S.done(cur); }
#undef PG8_SA
#undef PG8_SB
#undef PG8_STAGE
#undef PG8_LDA
#undef PG8_LDB
#undef PG8_MMA
#undef PG8_WAIT_V
#undef PG8_WAIT_L
#undef PG8_BAR
#undef PG8_SCHED
}
}
namespace epi {
using pg8::Unit;
#define EPI_V8(ai, bj, m) const float v[8] = {acc[ai][bj][m][0][0], acc[ai][bj][m][0][1], acc[ai][bj][m][0][2], acc[ai][bj][m][0][3], acc[ai][bj][m][1][0], acc[ai][bj][m][1][1], acc[ai][bj][m][1][2], acc[ai][bj][m][1][3]}
DI void st_bf16x8(bf16_t* p, const float* v) { u32x4 w; w.x = pk2(v[0], v[1]); w.y = pk2(v[2], v[3]); w.z = pk2(v[4], v[5]); w.w = pk2(v[6], v[7]); *(u32x4*)p = w; }
DI void st_bf16x4(bf16_t* p, float a, float b, float c, float d) { u32x2 w; w.x = pk2(a, b); w.y = pk2(c, d); *(u32x2*)p = w; }
DI void st_f32x4(float* p, float a, float b, float c, float d) { *(f32x4*)p = (f32x4){a, b, c, d}; }

struct EpiProj {
    static constexpr bool PERM = true, AFTER_DRAIN = false;
    float* out; unsigned char* ws; const float* a_log; const float* dt_bias;
    DI void operator()(const f32x4 (&acc)[2][2][4][2], const Unit& u, int wr, int wc, int fr, int fq) const {
        const int pn = u.pn;
        const float* cosT = (const float*)(ws + WS_ROPE); const float* sinT = cosT + 8193 * 32;
#pragma unroll
        for (int ai = 0; ai < 2; ++ai)
#pragma unroll
            for (int m = 0; m < 4; ++m) {
                const int row = u.pm * 256 + ai * 128 + wr * 64 + m * 16 + fr;
                if (row >= MP + NBS) continue;
                const bool samp = row >= MP; const int b = row >> 13, t = row & (TP - 1), bs = row - MP;
                const int pos = samp ? TP : t;
#pragma unroll
                for (int bj = 0; bj < 2; ++bj) {
                    EPI_V8(ai, bj, m);
                    const int cw = bj * 128 + wc * 32 + fq * 8;
                    if (pn < 2) {
                        const int head = (pn * 256 + cw) >> 6, i0 = (cw & 63) >> 1;
                        const f32x4 c4 = *(const f32x4*)(cosT + pos * 32 + i0), s4 = *(const f32x4*)(sinT + pos * 32 + i0);
                        float o1[4], o2[4];
#pragma unroll
                        for (int q = 0; q < 4; ++q) { const float x1 = v[2 * q], x2 = v[2 * q + 1]; o1[q] = (x1 * c4[q] - x2 * s4[q]) * QSCALE; o2[q] = (x2 * c4[q] + x1 * s4[q]) * QSCALE; }
                        bf16_t* qb = (bf16_t*)(ws + WS_QB) + (size_t)row * 512 + head * 64 + i0;
                        st_bf16x4(qb, o1[0], o1[1], o1[2], o1[3]); st_bf16x4(qb + 32, o2[0], o2[1], o2[2], o2[3]);
                    } else if (pn < 5) {
                        const int br = pn - 2, g = wc >> 1, cc = (wc & 1) * 32 + fq * 8;
                        float* dst;
                        if (!samp) dst = (br < 2) ? out + O_KVP + ((size_t)(b * TP + t) * 4 + 2 * br + bj) * 128 + g * 64
                                                  : (t >= TP - 512 ? out + O_WINP + ((size_t)(b * 512 + t - (TP - 512)) * 2 + bj) * 128 + g * 64 : nullptr);
                        else dst = (br < 2) ? out + O_KVS + ((size_t)bs * 4 + 2 * br + bj) * 128 + g * 64 : out + O_WINS + ((size_t)(bs * 512 + 511) * 2 + bj) * 128 + g * 64;
                        const size_t hb = ((size_t)(b * 2 + g) * TP + t) * 64;
                        if (bj == 0) {
                            const int i0 = cc >> 1;
                            const f32x4 c4 = *(const f32x4*)(cosT + pos * 32 + i0), s4 = *(const f32x4*)(sinT + pos * 32 + i0);
                            float o1[4], o2[4];
#pragma unroll
                            for (int q = 0; q < 4; ++q) { const float x1 = v[2 * q], x2 = v[2 * q + 1]; o1[q] = x1 * c4[q] - x2 * s4[q]; o2[q] = x2 * c4[q] + x1 * s4[q]; }
                            if (dst) { st_f32x4(dst + i0, o1[0], o1[1], o1[2], o1[3]); st_f32x4(dst + 32 + i0, o2[0], o2[1], o2[2], o2[3]); }
                            if (!samp) { bf16_t* kb = (bf16_t*)(ws + (br == 0 ? WS_KC : br == 1 ? WS_KSEL : WS_KWIN)) + hb + i0;
                                st_bf16x4(kb, o1[0], o1[1], o1[2], o1[3]); st_bf16x4(kb + 32, o2[0], o2[1], o2[2], o2[3]); }
                        } else {
                            if (dst) { st_f32x4(dst + cc, v[0], v[1], v[2], v[3]); st_f32x4(dst + cc + 4, v[4], v[5], v[6], v[7]); }
                            if (!samp) {
                                if (br == 0) st_bf16x8((bf16_t*)(ws + WS_VC) + hb + cc, v);
                                else { bf16_t* vt = (bf16_t*)(ws + (br == 1 ? WS_VSELT : WS_VWINT)) + ((size_t)(b * 2 + g) * 64 + cc) * TP + t;
#pragma unroll
                                    for (int j = 0; j < 8; ++j) vt[(size_t)j * TP] = f2bf(v[j]); }
                            }
                        }
                    } else if (pn < 11) {
                        const int ch0 = (pn - 5) * 256 + cw;
                        st_bf16x8((bf16_t*)(ws + WS_CI) + (size_t)row * CCH + ch0, v);
                        float* dst = nullptr;
                        if (!samp) { if (t >= TP - 3) dst = out + O_CONVP + (size_t)(b * 3 + t - (TP - 3)) * CCH + ch0; }
                        else dst = out + O_CONVS + (size_t)(bs * 3 + 2) * CCH + ch0;
                        if (dst) { st_f32x4(dst, v[0], v[1], v[2], v[3]); st_f32x4(dst + 4, v[4], v[5], v[6], v[7]); }
                    } else if (pn < 13) {
                        st_bf16x8((bf16_t*)(ws + WS_Z) + (size_t)row * 512 + (pn - 11) * 256 + cw, v);
                    } else {
                        if (bj == 0 && wc == 0) {
                            float o[8];
                            if (fq < 3) {
#pragma unroll
                                for (int j = 0; j < 8; ++j) o[j] = sigmoidf_(v[j]);
                            } else {
#pragma unroll
                                for (int j = 0; j < 4; ++j) { const float xx = v[j] + dt_bias[j]; const float sp = fmaxf(xx, 0.f) + log1pf(__expf(-fabsf(xx))); o[j] = -__expf(a_log[j]) * sp; }
#pragma unroll
                                for (int j = 4; j < 8; ++j) o[j] = sigmoidf_(v[j]);
                            }
                            float* gt = (float*)(ws + WS_GT) + (size_t)row * 32 + fq * 8;
                            st_f32x4(gt, o[0], o[1], o[2], o[3]); st_f32x4(gt + 4, o[4], o[5], o[6], o[7]);
                        }
                    }
                }
            }
    }
};

struct EpiOut {
    static constexpr bool PERM = true, AFTER_DRAIN = false;
    const float* xp; const float* xs; unsigned char* ws;
    DI void operator()(const f32x4 (&acc)[2][2][4][2], const Unit& u, int wr, int wc, int fr, int fq) const {
        float* hp = (float*)(ws + WS_HP); bf16_t* hpb = (bf16_t*)(ws + WS_HPB); float* ssq = (float*)(ws + WS_SSQ1);
#pragma unroll
        for (int ai = 0; ai < 2; ++ai)
#pragma unroll
            for (int m = 0; m < 4; ++m) {
                const int row = u.pm * 256 + ai * 128 + wr * 64 + m * 16 + fr;
                const float* xr = row < MP ? xp + (size_t)row * DM : (row < MP + NBS ? xs + (size_t)(row - MP) * DM : nullptr);
                float sq = 0.f;
#pragma unroll
                for (int bj = 0; bj < 2; ++bj) {
                    EPI_V8(ai, bj, m);
                    const int col = u.pn * 256 + bj * 128 + wc * 32 + fq * 8;
                    float h[8];
                    if (xr) { const f32x4 x0 = *(const f32x4*)(xr + col), x1 = *(const f32x4*)(xr + col + 4);
#pragma unroll
                        for (int j = 0; j < 4; ++j) { h[j] = x0[j] + v[j]; h[4 + j] = x1[j] + v[4 + j]; } }
                    else {
#pragma unroll
                        for (int j = 0; j < 8; ++j) h[j] = 0.f; }
#pragma unroll
                    for (int j = 0; j < 8; ++j) sq += h[j] * h[j];
                    st_f32x4(hp + (size_t)row * DM + col, h[0], h[1], h[2], h[3]); st_f32x4(hp + (size_t)row * DM + col + 4, h[4], h[5], h[6], h[7]);
                    st_bf16x8(hpb + (size_t)row * DM + col, h);
                }
                sq += __shfl_xor(sq, 16); sq += __shfl_xor(sq, 32);
                if (fq == 0) atomicAdd(ssq + row, sq);
            }
    }
};

struct EpiUp {
    static constexpr bool PERM = true, AFTER_DRAIN = false;
    unsigned char* ws;
    DI void operator()(const f32x4 (&acc)[2][2][4][2], const Unit& u, int wr, int wc, int fr, int fq) const {
        const float* ssq = (const float*)(ws + WS_SSQ1); bf16_t* hid = (bf16_t*)(ws + WS_HID);
#pragma unroll
        for (int ai = 0; ai < 2; ++ai)
#pragma unroll
            for (int m = 0; m < 4; ++m) {
                const int row = u.pm * 256 + ai * 128 + wr * 64 + m * 16 + fr;
                const float rs = rsqrtf(ssq[row] * (1.f / DM) + EPS);
#pragma unroll
                for (int bj = 0; bj < 2; ++bj) {
                    EPI_V8(ai, bj, m);
                    const int j0 = (u.pn * 256 + bj * 128 + wc * 32 + fq * 8) >> 1;
                    float h[4];
#pragma unroll
                    for (int q = 0; q < 4; ++q) { const float gte = v[2 * q] * rs, up = v[2 * q + 1] * rs; h[q] = siluf_(gte) * up; }
                    st_bf16x4(hid + (size_t)row * DFF + j0, h[0], h[1], h[2], h[3]);
                }
            }
    }
};

struct EpiDown {
    static constexpr bool PERM = true, AFTER_DRAIN = false;
    unsigned char* ws;
    DI void operator()(const f32x4 (&acc)[2][2][4][2], const Unit& u, int wr, int wc, int fr, int fq) const {
        float* hp = (float*)(ws + WS_HP); float* ssq = (float*)(ws + WS_SSQ2);
#pragma unroll
        for (int ai = 0; ai < 2; ++ai)
#pragma unroll
            for (int m = 0; m < 4; ++m) {
                const int row = u.pm * 256 + ai * 128 + wr * 64 + m * 16 + fr;
                float sq = 0.f;
#pragma unroll
                for (int bj = 0; bj < 2; ++bj) {
                    EPI_V8(ai, bj, m);
                    float* hr = hp + (size_t)row * DM + u.pn * 256 + bj * 128 + wc * 32 + fq * 8;
                    const f32x4 x0 = *(const f32x4*)hr, x1 = *(const f32x4*)(hr + 4);
                    float h[8];
#pragma unroll
                    for (int j = 0; j < 4; ++j) { h[j] = x0[j] + v[j]; h[4 + j] = x1[j] + v[4 + j]; }
#pragma unroll
                    for (int j = 0; j < 8; ++j) sq += h[j] * h[j];
                    st_f32x4(hr, h[0], h[1], h[2], h[3]); st_f32x4(hr + 4, h[4], h[5], h[6], h[7]);
                }
                (void)sq; (void)ssq;
            }
    }
};
}
namespace p0 {
DI int perm_in(int n) {
    if (n < 512) { const int cc = n & 63; return (n & ~63) + ((cc & 1) ? (cc >> 1) + 32 : (cc >> 1)); }
    if (n < 1280) { const int m = n - 512, grp = m >> 6, cc = m & 63, br = grp >> 2, kvi = (grp >> 1) & 1, g = grp & 1;
        const int d = kvi == 0 ? ((cc & 1) ? (cc >> 1) + 32 : (cc >> 1)) : cc; return 512 + br * 256 + kvi * 128 + g * 64 + d; }
    if (n < 2816) return 1304 + (n - 1280);
    if (n < 3328) return 2840 + (n - 2816);
    if (n < 3352) return 1280 + (n - 3328);
    if (n < 3360) return n;
    return -1;
}
template <int MODE> DI void wt_item(const float* W, int Nsrc, bf16_t* WT, int Kdst, int n0, int k0, const float* kscale, int lane) {
    const int n = n0 + lane;
    int src;
    if (MODE == 0) src = perm_in(n);
    else if (MODE == 1) src = n;
    else src = (n & 1) ? DFF + (n >> 1) : (n >> 1);
#pragma unroll 2
    for (int kk = 0; kk < 64; kk += 8) {
        float v[8];
#pragma unroll
        for (int i = 0; i < 8; ++i) { const int k = k0 + kk + i; float x = src >= 0 ? W[(size_t)k * Nsrc + src] : 0.f; if (kscale) x *= kscale[k]; v[i] = x; }
        epi::st_bf16x8(WT + (size_t)n * Kdst + k0 + kk, v);
    }
}
DI void run(const Params& p) {
    int tid_ = threadIdx.x; asm volatile("" : "+v"(tid_)); const int tid = tid_, lane = tid & 63, wave = tid >> 6;
    const int gw = blockIdx.x * 8 + wave, NGW = gridDim.x * 8;
    const int gt = blockIdx.x * 512 + tid, NGT = gridDim.x * 512;
    unsigned char* ws = p.ws;
    constexpr int I_IN = (INW_PAD / 64) * (DM / 64), I_OUT = (DM / 64) * (DM / 64), I_GU = (2 * DFF / 64) * (DM / 64), I_DN = (DM / 64) * (DFF / 64);
    constexpr int NIT = I_IN + I_OUT + I_GU + I_DN;
    for (int it = gw; it < NIT; it += NGW) {
        int r = it;
        if (r < I_IN) { wt_item<0>(p.w_in, INW, (bf16_t*)(ws + WS_WIN), DM, (r / 16) * 64, (r % 16) * 64, nullptr, lane); continue; } r -= I_IN;
        if (r < I_OUT) { wt_item<1>(p.w_out, DM, (bf16_t*)(ws + WS_WOUT), DM, (r / 16) * 64, (r % 16) * 64, nullptr, lane); continue; } r -= I_OUT;
        if (r < I_GU) { wt_item<2>(p.w_gate_up, 2 * DFF, (bf16_t*)(ws + WS_WGU), DM, (r / 16) * 64, (r % 16) * 64, p.norm_ffn, lane); continue; } r -= I_GU;
        wt_item<1>(p.w_down, DM, (bf16_t*)(ws + WS_WDN), DFF, (r / 44) * 64, (r % 44) * 64, nullptr, lane);
    }
    for (int i = gt; i < 2 * 128 * 2 * 64; i += NGT) {
        const int ln = i & 63, et = (i >> 6) & 1, ks = (i >> 7) & 127, kv = i >> 14;
        const float* w = p.cmp_w + ((size_t)kv * 2048 + ks * 16 + (ln >> 5) * 8) * 64 + et * 32 + (ln & 31);
        float v[8];
#pragma unroll
        for (int j = 0; j < 8; ++j) v[j] = w[j * 64];
        epi::st_bf16x8((bf16_t*)(ws + WS_WCMP) + (size_t)i * 8, v);
    }
    for (int o = gw; o < 128; o += NGW) {
        const int kv = o >> 6, e = o & 63; float s = 0.f;
        for (int k = lane; k < 2048; k += 64) s += p.cmp_pe[kv * 2048 + k] * p.cmp_w[((size_t)kv * 2048 + k) * 64 + e];
        s = wave_sum(s);
        if (lane == 0) ((float*)(ws + WS_CST))[o] = s;
    }
    { float* cosT = (float*)(ws + WS_ROPE); float* sinT = cosT + 8193 * 32;
      for (int i = gt; i < 8193 * 32; i += NGT) { const int pos = i >> 5, j = i & 31;
          const double a = (double)pos * pow(10000.0, -(double)j / 32.0); cosT[i] = (float)cos(a); sinT[i] = (float)sin(a); } }
    for (int row = gw; row < MROWS; row += NGW) {
        bf16_t* o = (bf16_t*)(ws + WS_XN) + (size_t)row * DM;
        if (row >= MP + NBS) { for (int j = 0; j < 4; ++j) *(u32x2*)(o + (j * 64 + lane) * 4) = (u32x2){0u, 0u}; continue; }
        const float* xr = row < MP ? p.x_prompt + (size_t)row * DM : p.x_sample + (size_t)(row - MP) * DM;
        f32x4 v[4]; float s = 0.f;
#pragma unroll
        for (int j = 0; j < 4; ++j) { v[j] = *(const f32x4*)(xr + (j * 64 + lane) * 4); s += v[j][0] * v[j][0] + v[j][1] * v[j][1] + v[j][2] * v[j][2] + v[j][3] * v[j][3]; }
        const float rs = rsqrtf(wave_sum(s) * (1.f / DM) + EPS);
#pragma unroll
        for (int j = 0; j < 4; ++j) { const f32x4 g = *(const f32x4*)(p.norm_mix + (j * 64 + lane) * 4);
            epi::st_bf16x4(o + (j * 64 + lane) * 4, v[j][0] * rs * g[0], v[j][1] * rs * g[1], v[j][2] * rs * g[2], v[j][3] * rs * g[3]); }
    }
    { const f32x4* src = (const f32x4*)p.cache_win; f32x4* dst = (f32x4*)(p.out + O_WINS);
      for (int i = gt; i < NBS * 511 * 64; i += NGT) { const int bs = i / (511 * 64), r = i % (511 * 64); dst[(size_t)bs * 512 * 64 + r] = src[(size_t)bs * 512 * 64 + 64 + r]; } }
    { const f32x4* src = (const f32x4*)p.state_conv; f32x4* dst = (f32x4*)(p.out + O_CONVS);
      for (int i = gt; i < NBS * 2 * (CCH / 4); i += NGT) { const int bs = i / (2 * (CCH / 4)), r = i % (2 * (CCH / 4)); dst[(size_t)bs * 3 * (CCH / 4) + r] = src[(size_t)bs * 3 * (CCH / 4) + (CCH / 4) + r]; } }
}
}
namespace attn {
constexpr int KSTR = 72, VSTR = 68;
constexpr int KT_BYTES = 64 * KSTR * 2, VT_BYTES = 64 * VSTR * 2, TILE_BYTES = KT_BYTES + VT_BYTES;
constexpr int OFF_IMP = 36864, IMP_STR = 132;
constexpr int LDS_NEED = OFF_IMP + 8 * 8 * IMP_STR * 4;

DI void ld_tile(const bf16_t* kbase, const bf16_t* vtbase, size_t vts, u32x4& kr, u32x4& vr, int tid) {
    kr = *(const u32x4*)(kbase + (tid >> 3) * 64 + (tid & 7) * 8);
    vr = *(const u32x4*)(vtbase + (size_t)(tid >> 3) * vts + (tid & 7) * 8);
}
DI void st_tile(LAS unsigned char* buf, const u32x4& kr, const u32x4& vr, int tid) {
    *(LAS u32x4*)(buf + ((tid >> 3) * KSTR + (tid & 7) * 8) * 2) = kr;
    LAS u32x2* vp = (LAS u32x2*)(buf + KT_BYTES + ((tid >> 3) * VSTR + (tid & 7) * 8) * 2);
    vp[0] = (u32x2){vr.x, vr.y}; vp[1] = (u32x2){vr.z, vr.w};
}
DI void qk_tile(const LAS unsigned char* kb, const bf16x8 (&qf)[4], f32x16& s0, f32x16& s1, int lane) {
    const LAS unsigned char* p0 = kb + ((lane & 31) * KSTR + (lane >> 5) * 8) * 2;
    f32x16 z; for (int i = 0; i < 16; ++i) z[i] = 0.f;
    s0 = z; s1 = z;
#pragma unroll
    for (int kd = 0; kd < 4; ++kd) {
        const bf16x8 a0 = *(const LAS bf16x8*)(p0 + kd * 32), a1 = *(const LAS bf16x8*)(p0 + 32 * KSTR * 2 + kd * 32);
        s0 = MFMA32(a0, qf[kd], s0); s1 = MFMA32(a1, qf[kd], s1);
    }
}
DI bf16x8 pack8(const f32x16& p, int base) {
    u32x4 w; w.x = pk2(p[base], p[base + 1]); w.y = pk2(p[base + 2], p[base + 3]); w.z = pk2(p[base + 4], p[base + 5]); w.w = pk2(p[base + 6], p[base + 7]);
    return __builtin_bit_cast(bf16x8, w);
}
DI void pv_tile(const LAS unsigned char* vb, const f32x16& p0, const f32x16& p1, f32x16& o0, f32x16& o1, int lane) {
    const LAS unsigned char* v0 = vb + ((lane & 31) * VSTR + 4 * (lane >> 5)) * 2;
#pragma unroll
    for (int ks = 0; ks < 4; ++ks) {
        const bf16x8 pb = (ks < 2) ? pack8(p0, (ks & 1) * 8) : pack8(p1, (ks & 1) * 8);
#pragma unroll
        for (int dt = 0; dt < 2; ++dt) {
            const s16x4 lo = *(const LAS s16x4*)(v0 + (dt * 32 * VSTR + 16 * ks) * 2), hi = *(const LAS s16x4*)(v0 + (dt * 32 * VSTR + 16 * ks + 8) * 2);
            const bf16x8 a = __builtin_shufflevector(lo, hi, 0, 1, 2, 3, 4, 5, 6, 7);
            if (dt == 0) o0 = MFMA32(a, pb, o0); else o1 = MFMA32(a, pb, o1);
        }
    }
}
DI void softmax_step(f32x16& s0, f32x16& s1, float& m, float& l, f32x16& o0, f32x16& o1) {
    float mt = NEGBIG;
#pragma unroll
    for (int r = 0; r < 16; ++r) mt = fmaxf(mt, fmaxf(s0[r], s1[r]));
    mt = fmaxf(mt, __shfl_xor(mt, 32));
    const float mn = fmaxf(m, mt), alpha = __builtin_amdgcn_exp2f(m - mn);
    float sum = 0.f;
#pragma unroll
    for (int r = 0; r < 16; ++r) { s0[r] = __builtin_amdgcn_exp2f(s0[r] - mn); s1[r] = __builtin_amdgcn_exp2f(s1[r] - mn); sum += s0[r] + s1[r]; }
    l = l * alpha + sum; m = mn;
#pragma unroll
    for (int r = 0; r < 16; ++r) { o0[r] *= alpha; o1[r] *= alpha; }
}

#define ATT_TBUF(i) (lds + (i) * TILE_BYTES)
#define ATT_STREAM_BEGIN(NT, KP, VP, VTS) { u32x4 kr_, vr_; const int nt_ = (NT); \
    { const int i_ = 0; ld_tile((KP), (VP), (VTS), kr_, vr_, tid); } st_tile(ATT_TBUF(0), kr_, vr_, tid); __syncthreads(); \
    for (int it_ = 0; it_ < nt_; ++it_) { \
        if (it_ + 1 < nt_) { const int i_ = it_ + 1; ld_tile((KP), (VP), (VTS), kr_, vr_, tid); } \
        { const LAS unsigned char* tb = ATT_TBUF(it_ & 1); const int i_ = it_;
#define ATT_STREAM_END() } \
        if (it_ + 1 < nt_) st_tile(ATT_TBUF((it_ + 1) & 1), kr_, vr_, tid); \
        __syncthreads(); } }

DI void unit(const Params& p, LAS unsigned char* lds, int b, int g, int tt) {
    int tid_ = threadIdx.x; asm volatile("" : "+v"(tid_)); const int tid = tid_, lane = tid & 63, wave = __builtin_amdgcn_readfirstlane(tid >> 6), hi = lane >> 5, col = lane & 31, tokl = col & 7, r = col >> 3;
    const int t = tt * 64 + wave * 8 + tokl;
    const size_t row = (size_t)b * TP + t;
    const unsigned char* ws = p.ws;
    const size_t slab = (size_t)(b * 2 + g);
    bf16x8 qf[4];
    { const bf16_t* q = (const bf16_t*)(ws + WS_QB) + row * 512 + (g * 4 + r) * 64 + hi * 8;
#pragma unroll
      for (int kd = 0; kd < 4; ++kd) qf[kd] = *(const bf16x8*)(q + kd * 16); }
    const float* gt = (const float*)(ws + WS_GT) + row * 32 + (g * 4 + r) * 3;
    const float gate0 = gt[0], gate1 = gt[1], gate2 = gt[2];
    LAS float* imp = (LAS float*)(lds + OFF_IMP) + wave * 8 * IMP_STR;
    for (int i = lane; i < 8 * IMP_STR; i += 64) imp[i] = 0.f;
    f32x16 of0, of1; for (int i = 0; i < 16; ++i) { of0[i] = 0.f; of1[i] = 0.f; }

    const int nv = t >= 31 ? ((t - 31) >> 4) + 1 : 0;
    {
        const int ntile = (4 * tt + 3 + 63) >> 6;
        const bf16_t* ck = (const bf16_t*)(ws + WS_CKP) + slab * 512 * 64;
        const bf16_t* cvt = (const bf16_t*)(ws + WS_CVTP) + slab * 64 * 512;
        float m = NEGBIG, l = 0.f;
        ATT_STREAM_BEGIN(ntile, ck + (size_t)i_ * 64 * 64, cvt + i_ * 64, 512)
            f32x16 s0, s1; qk_tile(tb, qf, s0, s1, lane);
            float mt = NEGBIG;
#pragma unroll
            for (int rr = 0; rr < 16; ++rr) { const int n0 = i_ * 64 + crow(rr, hi); s0[rr] = n0 < nv ? s0[rr] : NEGBIG; s1[rr] = n0 + 32 < nv ? s1[rr] : NEGBIG; mt = fmaxf(mt, fmaxf(s0[rr], s1[rr])); }
            const float mn = fmaxf(m, mt); float sum = 0.f;
#pragma unroll
            for (int rr = 0; rr < 16; ++rr) sum += __builtin_amdgcn_exp2f(s0[rr] - mn) + __builtin_amdgcn_exp2f(s1[rr] - mn);
            l = l * __builtin_amdgcn_exp2f(m - mn) + sum; m = mn;
        ATT_STREAM_END()
        const float mo = __shfl_xor(m, 32), lo = __shfl_xor(l, 32);
        const float M = fmaxf(m, mo), L = l * __builtin_amdgcn_exp2f(m - M) + lo * __builtin_amdgcn_exp2f(mo - M);
        const float invL = M > -1e29f ? 1.f / L : 0.f;
        f32x16 o0, o1; for (int i = 0; i < 16; ++i) { o0[i] = 0.f; o1[i] = 0.f; }
        LAS float* myimp = imp + tokl * IMP_STR;
        ATT_STREAM_BEGIN(ntile, ck + (size_t)i_ * 64 * 64, cvt + i_ * 64, 512)
            f32x16 s0, s1; qk_tile(tb, qf, s0, s1, lane);
#pragma unroll
            for (int rr = 0; rr < 16; ++rr) { const int n0 = i_ * 64 + crow(rr, hi);
                s0[rr] = n0 < nv ? __builtin_amdgcn_exp2f(s0[rr] - M) * invL : 0.f; s1[rr] = n0 + 32 < nv ? __builtin_amdgcn_exp2f(s1[rr] - M) * invL : 0.f; }
#pragma unroll
            for (int a = 0; a < 4; ++a) {
                const int sb0 = i_ * 16 + 2 * a + hi, sb1 = sb0 + 8;
                LDS_FADD(myimp + sb0, (s0[4 * a] + s0[4 * a + 1]) + (s0[4 * a + 2] + s0[4 * a + 3])); LDS_FADD(myimp + sb0 + 1, s0[4 * a + 3]);
                LDS_FADD(myimp + sb1, (s1[4 * a] + s1[4 * a + 1]) + (s1[4 * a + 2] + s1[4 * a + 3])); LDS_FADD(myimp + sb1 + 1, s1[4 * a + 3]);
            }
            pv_tile(tb + KT_BYTES, s0, s1, o0, o1, lane);
        ATT_STREAM_END()
#pragma unroll
        for (int i = 0; i < 16; ++i) { of0[i] = gate0 * o0[i]; of1[i] = gate0 * o1[i]; }
    }
    unsigned long long sel_lo = 0ull, sel_hi = 0ull;
    {
        const unsigned long long lt = (1ull << lane) - 1ull;
#pragma unroll 1
        for (int j = 0; j < 8; ++j) {
            const float i0 = imp[j * IMP_STR + lane], i1 = imp[j * IMP_STR + 64 + lane];
            const int sA = lane, sB = lane + 64;
            const bool vA = sA <= tt, vB = sB <= tt;
            const bool fA = sA == 0 || sA == tt || sA == tt - 1, fB = sB == tt || sB == tt - 1;
            const int xA = vA ? __float_as_int(i0 + (fA ? 1e4f : 0.f)) : -1, xB = vB ? __float_as_int(i1 + (fB ? 1e4f : 0.f)) : -1;
            int T = 0;
#pragma unroll 1
            for (int bit = 30; bit >= 0; --bit) { const int T2 = T | (1 << bit);
                const int c = __popcll(__ballot(xA >= T2)) + __popcll(__ballot(xB >= T2)); T = __builtin_amdgcn_readfirstlane(c >= 16 ? T2 : T); }
            const bool gA = xA > T, gB = xB > T, eA = xA == T, eB = xB == T;
            const int need = 16 - (__popcll(__ballot(gA)) + __popcll(__ballot(gB)));
            const unsigned long long beA = __ballot(eA), beB = __ballot(eB);
            const int preA = __popcll(beA & lt), preB = __popcll(beA) + __popcll(beB & lt);
            const unsigned long long mA = __ballot(gA || (eA && preA < need)), mB = __ballot(gB || (eB && preB < need));
            if (tokl == j) { sel_lo = mA; sel_hi = mB; }
        }
    }
    {
        const bf16_t* kb = (const bf16_t*)(ws + WS_KSEL) + slab * TP * 64;
        const bf16_t* vt = (const bf16_t*)(ws + WS_VSELT) + slab * 64 * TP;
        float m = NEGBIG, l = 0.f; f32x16 o0, o1; for (int i = 0; i < 16; ++i) { o0[i] = 0.f; o1[i] = 0.f; }
        ATT_STREAM_BEGIN(tt + 1, kb + (size_t)(i_ == 0 ? tt : i_ - 1) * 64 * 64, vt + (size_t)(i_ == 0 ? tt : i_ - 1) * 64, TP)
            const int s = i_ == 0 ? tt : i_ - 1;
            const bool on = ((s < 64 ? (sel_lo >> s) : (sel_hi >> (s - 64))) & 1ull) != 0ull;
            f32x16 s0, s1; qk_tile(tb, qf, s0, s1, lane);
            const int lim = on ? (s == tt ? t - s * 64 : 64) : -1;
#pragma unroll
            for (int rr = 0; rr < 16; ++rr) { const int kk = crow(rr, hi); s0[rr] = kk <= lim ? s0[rr] : NEGBIG; s1[rr] = kk + 32 <= lim ? s1[rr] : NEGBIG; }
            softmax_step(s0, s1, m, l, o0, o1);
            pv_tile(tb + KT_BYTES, s0, s1, o0, o1, lane);
        ATT_STREAM_END()
        const float sc = gate1 / (l + __shfl_xor(l, 32));
#pragma unroll
        for (int i = 0; i < 16; ++i) { of0[i] += sc * o0[i]; of1[i] += sc * o1[i]; }
    }
    {
        const bf16_t* kb = (const bf16_t*)(ws + WS_KWIN) + slab * TP * 64;
        const bf16_t* vt = (const bf16_t*)(ws + WS_VWINT) + slab * 64 * TP;
        const int ntile = (tt < 8 ? tt : 8) + 1;
        float m = NEGBIG, l = 0.f; f32x16 o0, o1; for (int i = 0; i < 16; ++i) { o0[i] = 0.f; o1[i] = 0.f; }
        ATT_STREAM_BEGIN(ntile, kb + (size_t)(tt - i_) * 64 * 64, vt + (size_t)(tt - i_) * 64, TP)
            const int k0 = (tt - i_) * 64;
            f32x16 s0, s1; qk_tile(tb, qf, s0, s1, lane);
#pragma unroll
            for (int rr = 0; rr < 16; ++rr) { const int kp = k0 + crow(rr, hi);
                s0[rr] = (kp <= t && kp >= t - 512) ? s0[rr] : NEGBIG; s1[rr] = (kp + 32 <= t && kp + 32 >= t - 512) ? s1[rr] : NEGBIG; }
            softmax_step(s0, s1, m, l, o0, o1);
            pv_tile(tb + KT_BYTES, s0, s1, o0, o1, lane);
        ATT_STREAM_END()
        const float sc = gate2 / (l + __shfl_xor(l, 32));
#pragma unroll
        for (int i = 0; i < 16; ++i) { of0[i] += sc * o0[i]; of1[i] += sc * o1[i]; }
    }
    { bf16_t* o = (bf16_t*)(p.ws + WS_MIX) + row * DM + (g * 4 + r) * 64 + 4 * hi;
#pragma unroll
      for (int i = 0; i < 4; ++i) { epi::st_bf16x4(o + 8 * i, of0[4 * i], of0[4 * i + 1], of0[4 * i + 2], of0[4 * i + 3]);
                                    epi::st_bf16x4(o + 32 + 8 * i, of1[4 * i], of1[4 * i + 1], of1[4 * i + 2], of1[4 * i + 3]); } }
}
}
namespace gdn {
template <int I> struct SolveRow {
    static DI void run(float (&x)[64], const LAS float* LM, const LAS float* VF, const LAS float* KF, const LAS float* GC, bool isu, int col) {
        SolveRow<I - 1>::run(x, LM, VF, KF, GC, isu, col);
        float acc = isu ? VF[I * 128 + col] * GC[64 + I] : KF[I * 128 + col] * GC[64 + I] * GC[128 + I];
#pragma unroll
        for (int j = 0; j < I; ++j) acc -= LM[I * 64 + j] * x[j];
        x[I] = acc;
        asm volatile("" : "+v"(x[I]) :: "memory");
    }
};
template <> struct SolveRow<-1> { static DI void run(float (&)[64], const LAS float*, const LAS float*, const LAS float*, const LAS float*, bool, int) {} };
constexpr int P_KF = 0, P_VF = 32768, P_QB = 65536, P_KB = 82944, P_LM = 100352, P_GC = 116736, PSTR = 136;
DI void prep_unit(const Params& p, LAS unsigned char* lds, int b, int h, int n) {
    int tid_ = threadIdx.x; asm volatile("" : "+v"(tid_)); const int tid = tid_, lane = tid & 63, wave = __builtin_amdgcn_readfirstlane(tid >> 6);
    const unsigned char* ws = p.ws;
    LAS float* KF = (LAS float*)(lds + P_KF); LAS float* VF = (LAS float*)(lds + P_VF);
    LAS bf16_t* QB = (LAS bf16_t*)(lds + P_QB); LAS bf16_t* KB = (LAS bf16_t*)(lds + P_KB);
    LAS float* LM = (LAS float*)(lds + P_LM); LAS float* GC = (LAS float*)(lds + P_GC);
    const int chunk = (b * GH + h) * NCHUNK + n;
    const size_t row0 = (size_t)b * TP + (size_t)n * 64;
    __syncthreads();
    if (wave == 0) {
        const float* gt = (const float*)(ws + WS_GT) + (row0 + lane) * 32;
        float g = gt[24 + h]; const float be = gt[28 + h];
#pragma unroll
        for (int o = 1; o < 64; o <<= 1) { const float x = __shfl_up(g, o); if (lane >= o) g += x; }
        GC[lane] = g; GC[64 + lane] = be; GC[128 + lane] = __expf(g);
    }
    __syncthreads();
    {
        const int dd = (tid & 15) * 8;
        const float* cw = p.conv_w;
        const bf16_t* ci = (const bf16_t*)(ws + WS_CI);
#pragma unroll 1
        for (int cc = 0; cc < 2; ++cc) {
            const int c = (tid >> 4) + cc * 32; const int t = n * 64 + c;
            float val[3][8];
#pragma unroll
            for (int part = 0; part < 3; ++part) {
                const int ch = part * 512 + h * 128 + dd;
                float a[8]; for (int i = 0; i < 8; ++i) a[i] = 0.f;
#pragma unroll
                for (int j = 0; j < 4; ++j) {
                    const int tj = t - 3 + j;
                    if (tj >= 0) {
                        const u32x4 xv = *(const u32x4*)(ci + ((size_t)b * TP + tj) * CCH + ch);
                        const f32x4 w0 = *(const f32x4*)(cw + j * CCH + ch), w1 = *(const f32x4*)(cw + j * CCH + ch + 4);
                        const unsigned xs[4] = {xv.x, xv.y, xv.z, xv.w};
#pragma unroll
                        for (int i = 0; i < 4; ++i) { a[2 * i] += __uint_as_float(xs[i] << 16) * (i < 2 ? w0[2 * i] : w1[2 * i - 4]); a[2 * i + 1] += __uint_as_float(xs[i] & 0xffff0000u) * (i < 2 ? w0[2 * i + 1] : w1[2 * i - 3]); }
                    }
                }
#pragma unroll
                for (int i = 0; i < 8; ++i) val[part][i] = siluf_(a[i]);
            }
            float sq = 0.f, sk = 0.f;
#pragma unroll
            for (int i = 0; i < 8; ++i) { sq += val[0][i] * val[0][i]; sk += val[1][i] * val[1][i]; }
#pragma unroll
            for (int o = 1; o < 16; o <<= 1) { sq += __shfl_xor(sq, o); sk += __shfl_xor(sk, o); }
            const float rq = rsqrtf(sq + EPS) * 0.08838834764831845f, rk = rsqrtf(sk + EPS), eg = GC[128 + c];
            float qn[8], qg[8], kn[8];
#pragma unroll
            for (int i = 0; i < 8; ++i) { qn[i] = val[0][i] * rq; qg[i] = qn[i] * eg; kn[i] = val[1][i] * rk; }
            epi::st_bf16x8((bf16_t*)(ws + WS_GQG) + ((size_t)chunk * 64 + c) * 128 + dd, qg);
            { u32x4 w; w.x = pk2(qn[0], qn[1]); w.y = pk2(qn[2], qn[3]); w.z = pk2(qn[4], qn[5]); w.w = pk2(qn[6], qn[7]); *(LAS u32x4*)(QB + c * PSTR + dd) = w; }
            { u32x4 w; w.x = pk2(kn[0], kn[1]); w.y = pk2(kn[2], kn[3]); w.z = pk2(kn[4], kn[5]); w.w = pk2(kn[6], kn[7]); *(LAS u32x4*)(KB + c * PSTR + dd) = w; }
            *(LAS f32x4*)(KF + c * 128 + dd) = (f32x4){kn[0], kn[1], kn[2], kn[3]}; *(LAS f32x4*)(KF + c * 128 + dd + 4) = (f32x4){kn[4], kn[5], kn[6], kn[7]};
            *(LAS f32x4*)(VF + c * 128 + dd) = (f32x4){val[2][0], val[2][1], val[2][2], val[2][3]}; *(LAS f32x4*)(VF + c * 128 + dd + 4) = (f32x4){val[2][4], val[2][5], val[2][6], val[2][7]};
        }
    }
    __syncthreads();
    {
        const int mat = wave >> 2, ti = (wave >> 1) & 1, tj = wave & 1, hi = lane >> 5, cl = lane & 31;
        const LAS bf16_t* A = (mat == 0 ? KB : QB) + (ti * 32 + cl) * PSTR + hi * 8;
        const LAS bf16_t* B = KB + (tj * 32 + cl) * PSTR + hi * 8;
        f32x16 acc; for (int i = 0; i < 16; ++i) acc[i] = 0.f;
#pragma unroll
        for (int ks = 0; ks < 8; ++ks) acc = MFMA32(*(const LAS bf16x8*)(A + ks * 16), *(const LAS bf16x8*)(B + ks * 16), acc);
        const int j = tj * 32 + cl; const float gj = GC[j];
#pragma unroll
        for (int r = 0; r < 16; ++r) {
            const int i = ti * 32 + crow(r, hi);
            const float dec = __expf(fminf(GC[i] - gj, 0.f));
            if (mat == 0) LM[i * 64 + j] = i > j ? GC[64 + i] * acc[r] * dec : 0.f;
            else ((bf16_t*)(ws + WS_GAQK))[((size_t)chunk * 64 + i) * 64 + j] = f2bf(i >= j ? acc[r] * dec : 0.f);
        }
    }
    __syncthreads();
    if (wave < 4) {
        const int cc = tid; const bool isu = cc < 128; const int col = cc & 127;
        float x[64];
        int zoff = 0; asm volatile("" : "+v"(zoff));
        SolveRow<63>::run(x, LM + zoff, VF, KF, GC + zoff, isu, col);
        if (isu) {
            float* gu = (float*)(ws + WS_GU) + (size_t)chunk * 8192 + (size_t)(col >> 5) * 2048;
#pragma unroll
            for (int ct = 0; ct < 2; ++ct)
#pragma unroll
                for (int i4 = 0; i4 < 4; ++i4)
#pragma unroll
                    for (int hh = 0; hh < 2; ++hh) { const int c0 = 32 * ct + 8 * i4 + 4 * hh;
                        *(f32x4*)(gu + ((ct * 4 + i4) * 64 + (col & 31) + 32 * hh) * 4) = (f32x4){x[c0], x[c0 + 1], x[c0 + 2], x[c0 + 3]}; }
        } else {
            bf16_t* gw = (bf16_t*)(ws + WS_GW) + (size_t)chunk * 8192 + col;
#pragma unroll
            for (int i = 0; i < 64; ++i) gw[i * 128] = f2bf(-x[i]);
        }
    } else {
        const int t2 = tid - 256, dk = t2 & 127, c0 = (t2 >> 7) * 32; const float glast = GC[63];
        bf16_t* kg = (bf16_t*)(ws + WS_GKGT) + ((size_t)chunk * 128 + dk) * 64 + c0;
#pragma unroll
        for (int q = 0; q < 4; ++q) { float v[8];
#pragma unroll
            for (int e = 0; e < 8; ++e) { const int c = c0 + q * 8 + e; v[e] = KF[c * 128 + dk] * __expf(glast - GC[c]); }
            epi::st_bf16x8(kg + q * 8, v); }
        if (t2 == 0) ((float*)(ws + WS_GGL))[chunk] = __expf(glast);
    }
}

constexpr int S_W = 0, S_QG = 16896, S_KGT = 33792, S_AQK = 51200, S_BUF = 59904, WSTR = 132, CSTR = 68;
DI void scan_unit(const Params& p, LAS unsigned char* lds, int b, int h) {
    int tid_ = threadIdx.x; asm volatile("" : "+v"(tid_)); const int tid = tid_, lane = tid & 63, wave = __builtin_amdgcn_readfirstlane(tid >> 6), hi = lane >> 5, cl = lane & 31;
    const unsigned char* ws = p.ws;
    const int chunk0 = (b * GH + h) * NCHUNK;
    f32x16 S[4]; for (int k = 0; k < 4; ++k) for (int i = 0; i < 16; ++i) S[k][i] = 0.f;
    f32x16 un[2];
    __syncthreads();
#define SCAN_MOVE(chunk, bufi) do { const int t2_ = tid - 256; LAS unsigned char* bb_ = lds + (bufi) * S_BUF; u32x4 stg_[14]; \
        _Pragma("unroll") for (int q = 0; q < 14; ++q) { const int pc = q * 256 + t2_; \
            const unsigned char* src = q < 4 ? ws + WS_GW + (size_t)(chunk) * 16384 + (size_t)pc * 16 : q < 8 ? ws + WS_GQG + (size_t)(chunk) * 16384 + (size_t)(pc - 1024) * 16 \
                : q < 12 ? ws + WS_GKGT + (size_t)(chunk) * 16384 + (size_t)(pc - 2048) * 16 : ws + WS_GAQK + (size_t)(chunk) * 8192 + (size_t)(pc - 3072) * 16; \
            stg_[q] = *(const u32x4*)src; } \
        _Pragma("unroll") for (int q = 0; q < 14; ++q) { const int pc = q * 256 + t2_; \
            LAS unsigned char* dst = q < 4 ? bb_ + S_W + ((pc >> 4) * WSTR + (pc & 15) * 8) * 2 : q < 8 ? bb_ + S_QG + (((pc - 1024) >> 4) * WSTR + (pc & 15) * 8) * 2 \
                : q < 12 ? bb_ + S_KGT + (((pc - 2048) >> 3) * CSTR + (pc & 7) * 8) * 2 : bb_ + S_AQK + (((pc - 3072) >> 3) * CSTR + (pc & 7) * 8) * 2; \
            LAS u32x2* d2 = (LAS u32x2*)dst; d2[0] = (u32x2){stg_[q].x, stg_[q].y}; d2[1] = (u32x2){stg_[q].z, stg_[q].w}; } } while (0)
#define SCAN_LOAD_U(chunk) do { const float* gu_ = (const float*)(ws + WS_GU) + (size_t)(chunk) * 8192 + (size_t)wave * 2048 + lane * 4; \
        _Pragma("unroll") for (int ct = 0; ct < 2; ++ct) _Pragma("unroll") for (int i4 = 0; i4 < 4; ++i4) { const f32x4 v_ = *(const f32x4*)(gu_ + (ct * 4 + i4) * 256); \
            un[ct][4 * i4] = v_[0]; un[ct][4 * i4 + 1] = v_[1]; un[ct][4 * i4 + 2] = v_[2]; un[ct][4 * i4 + 3] = v_[3]; } } while (0)
    if (wave >= 4) { SCAN_MOVE(chunk0, 0); }
    __syncthreads();
    for (int n = 0; n < NCHUNK; ++n) {
        if (wave >= 4) {
            if (n + 1 < NCHUNK) { SCAN_MOVE(chunk0 + n + 1, (n + 1) & 1); }
        } else {
            const LAS unsigned char* bb = lds + (n & 1) * S_BUF;
            const float gl = ((const float*)(ws + WS_GGL))[chunk0 + n];
            SCAN_LOAD_U(chunk0 + n);
            bf16x8 Sb[8];
#pragma unroll
            for (int ks = 0; ks < 8; ++ks) Sb[ks] = attn::pack8(S[ks >> 1], (ks & 1) * 8);
#define GDN_FRAG(base, stride, rowv, k) ({ const LAS bf16_t* f_ = (const LAS bf16_t*)(bb + (base)) + (rowv) * (stride) + 16 * (k) + 4 * hi; \
            const s16x4 lo_ = *(const LAS s16x4*)f_, hi_ = *(const LAS s16x4*)(f_ + 8); (bf16x8)__builtin_shufflevector(lo_, hi_, 0, 1, 2, 3, 4, 5, 6, 7); })
            bf16x8 vb[4];
#pragma unroll
            for (int ct = 0; ct < 2; ++ct) { f32x16 vn = un[ct];
#pragma unroll
                for (int ks = 0; ks < 8; ++ks) vn = MFMA32(GDN_FRAG(S_W, WSTR, ct * 32 + cl, ks), Sb[ks], vn);
                vb[2 * ct] = attn::pack8(vn, 0); vb[2 * ct + 1] = attn::pack8(vn, 8); asm volatile("" ::: "memory"); }
            float* og = (float*)(p.ws + WS_OG) + ((size_t)(b * GH + h) * TP + (size_t)n * 64) * 128 + wave * 32 + cl;
#pragma unroll
            for (int ct = 0; ct < 2; ++ct) { f32x16 o; for (int i = 0; i < 16; ++i) o[i] = 0.f;
#pragma unroll
                for (int ks = 0; ks < 8; ++ks) o = MFMA32(GDN_FRAG(S_QG, WSTR, ct * 32 + cl, ks), Sb[ks], o);
#pragma unroll
                for (int kc = 0; kc < 4; ++kc) o = MFMA32(GDN_FRAG(S_AQK, CSTR, ct * 32 + cl, kc), vb[kc], o);
#pragma unroll
                for (int r = 0; r < 16; ++r) og[(size_t)(ct * 32 + crow(r, hi)) * 128] = o[r];
                asm volatile("" ::: "memory"); }
#pragma unroll
            for (int dkt = 0; dkt < 4; ++dkt) {
#pragma unroll
                for (int i = 0; i < 16; ++i) S[dkt][i] *= gl;
#pragma unroll
                for (int kc = 0; kc < 4; ++kc) S[dkt] = MFMA32(GDN_FRAG(S_KGT, CSTR, dkt * 32 + cl, kc), vb[kc], S[dkt]);
                asm volatile("" ::: "memory"); }
        }
        __syncthreads();
    }
    if (wave < 4) {
        float* so = p.out + O_SP + (size_t)(b * GH + h) * 16384 + wave * 32 + cl;
#pragma unroll
        for (int dkt = 0; dkt < 4; ++dkt)
#pragma unroll
            for (int r = 0; r < 16; ++r) so[(size_t)(dkt * 32 + crow(r, hi)) * 128] = S[dkt][r];
    }
}

DI void post(const Params& p) {
    int tid_ = threadIdx.x; asm volatile("" : "+v"(tid_)); const int tid = tid_, lane = tid & 63;
    const int gh = (blockIdx.x * 512 + tid) >> 5, NGH = (gridDim.x * 512) >> 5, l32 = lane & 31;
    const f32x4 nw = *(const f32x4*)(p.gdn_norm + l32 * 4);
    for (int it = gh; it < MP * GH; it += NGH) {
        const int row = it >> 2, h = it & 3, b = row >> 13, t = row & (TP - 1);
        const f32x4 o = *(const f32x4*)((const float*)(p.ws + WS_OG) + ((size_t)(b * GH + h) * TP + t) * 128 + l32 * 4);
        float s = o[0] * o[0] + o[1] * o[1] + o[2] * o[2] + o[3] * o[3];
#pragma unroll
        for (int x = 1; x < 32; x <<= 1) s += __shfl_xor(s, x);
        const float rs = rsqrtf(s * (1.f / 128.f) + EPS);
        const u32x2 zz = *(const u32x2*)((const bf16_t*)(p.ws + WS_Z) + (size_t)row * 512 + h * 128 + l32 * 4);
        const float z0 = __uint_as_float(zz.x << 16), z1 = __uint_as_float(zz.x & 0xffff0000u), z2 = __uint_as_float(zz.y << 16), z3 = __uint_as_float(zz.y & 0xffff0000u);
        epi::st_bf16x4((bf16_t*)(p.ws + WS_MIX) + (size_t)row * DM + 512 + h * 128 + l32 * 4, o[0] * rs * nw[0] * siluf_(z0), o[1] * rs * nw[1] * siluf_(z1), o[2] * rs * nw[2] * siluf_(z2), o[3] * rs * nw[3] * siluf_(z3));
    }
}
}
namespace cmp {
constexpr int TSTR = 72, C_TOK = 0, C_PART = 76032, C_LDS = C_PART + 8 * 32 * 64 * 4;
constexpr int NSLAB = 8 + 128, NUNIT = NSLAB * 16;
DI void unit(const Params& p, LAS unsigned char* lds, int u) {
    int tid_ = threadIdx.x; asm volatile("" : "+v"(tid_)); const int tid = tid_, lane = tid & 63, wave = __builtin_amdgcn_readfirstlane(tid >> 6), hi = lane >> 5, cl = lane & 31;
    const unsigned char* ws = p.ws;
    const int sl = u >> 4, n0 = (u & 15) * 32;
    const bool samp = sl >= 8;
    int kv, bb, g;
    if (!samp) { kv = sl >> 2; bb = (sl >> 1) & 1; g = sl & 1; } else { const int s2 = sl - 8; kv = s2 >> 6; bb = (s2 >> 1) & 31; g = s2 & 1; }
    LAS bf16_t* TOK = (LAS bf16_t*)(lds + C_TOK); LAS float* PART = (LAS float*)(lds + C_PART);
    __syncthreads();
    for (int i = tid; i < 528 * 8; i += 512) {
        const int tok = i >> 3, ch = i & 7, tk = n0 * 16 + tok;
        u32x4 w = {0u, 0u, 0u, 0u};
        if (tk < TP) {
            if (!samp) w = *(const u32x4*)((const bf16_t*)(ws + (kv ? WS_VC : WS_KC)) + ((size_t)(bb * 2 + g) * TP + tk) * 64 + ch * 8);
            else { const int page = p.page_table[bb * NPAGES + (tk >> 7)];
                const float* src = p.cache_kv + (((size_t)page * PAGE + (tk & 127)) * 4 + kv) * 128 + g * 64 + ch * 8;
                const f32x4 a = *(const f32x4*)src, c = *(const f32x4*)(src + 4);
                w.x = pk2(a[0], a[1]); w.y = pk2(a[2], a[3]); w.z = pk2(c[0], c[1]); w.w = pk2(c[2], c[3]); }
        }
        *(LAS u32x4*)(TOK + ((tok & 15) * 33 + (tok >> 4)) * TSTR + ch * 8) = w;
    }
    __syncthreads();
    f32x16 acc[2]; for (int i = 0; i < 16; ++i) { acc[0][i] = 0.f; acc[1][i] = 0.f; }
    const bf16_t* wt = (const bf16_t*)(ws + WS_WCMP) + (size_t)kv * 64 * 2048 + lane * 8;
#pragma unroll 4
    for (int k = 0; k < 16; ++k) {
        const int ks = wave * 16 + k, l = ks >> 2, d0 = (ks & 3) * 16;
        const bf16x8 a = *(const LAS bf16x8*)(TOK + ((l & 15) * 33 + cl + (l >> 4)) * TSTR + d0 + hi * 8);
        const bf16x8 b0 = *(const bf16x8*)(wt + (size_t)ks * 1024), b1 = *(const bf16x8*)(wt + (size_t)ks * 1024 + 512);
        acc[0] = MFMA32(a, b0, acc[0]); acc[1] = MFMA32(a, b1, acc[1]);
    }
#pragma unroll
    for (int et = 0; et < 2; ++et)
#pragma unroll
        for (int r = 0; r < 16; ++r) PART[(wave * 32 + crow(r, hi)) * 64 + et * 32 + cl] = acc[et][r];
    __syncthreads();
    const float* cst = (const float*)(ws + WS_CST) + kv * 64;
    for (int i = tid; i < 32 * 64; i += 512) {
        const int n = i >> 6, e = i & 63;
        float s = cst[e];
#pragma unroll
        for (int w = 0; w < 8; ++w) s += PART[(w * 32 + n) * 64 + e];
        const int ng = n0 + n;
        if (ng >= NCMP) s = 0.f;
        if (!samp) { if (kv == 0) ((bf16_t*)(p.ws + WS_CKP))[((size_t)(bb * 2 + g) * 512 + ng) * 64 + e] = f2bf(s);
                     else ((bf16_t*)(p.ws + WS_CVTP))[((size_t)(bb * 2 + g) * 64 + e) * 512 + ng] = f2bf(s); }
        else ((float*)(p.ws + (kv == 0 ? WS_CKS : WS_CVS)))[((size_t)(bb * 2 + g) * 512 + ng) * 64 + e] = s;
    }
}
}
namespace samp {
constexpr int L_KP = 0, L_VP = 8192, L_SC = 16384, L_RED = 32768, L_QS = 34816, L_IMP = 35840, L_SELB = 36400, L_STAT = 36480;
DI float attend(LAS unsigned char* lds, int nk) {
    int tid_ = threadIdx.x; asm volatile("" : "+v"(tid_)); const int tid = tid_, lane = tid & 63, wave = tid >> 6;
    const float* const LAS* KP = (const float* const LAS*)(lds + L_KP); const float* const LAS* VP = (const float* const LAS*)(lds + L_VP);
    LAS float* SC = (LAS float*)(lds + L_SC); LAS float* RED = (LAS float*)(lds + L_RED); const LAS float* QS = (const LAS float*)(lds + L_QS);
    __syncthreads();
    { const int r = tid & 3; float q[64];
#pragma unroll
      for (int d = 0; d < 64; ++d) q[d] = QS[r * 64 + d];
      for (int j = tid >> 2; j < nk; j += 128) {
        const f32x4* k = (const f32x4*)KP[j];
        float s0 = 0.f, s1 = 0.f;
#pragma unroll
        for (int d4 = 0; d4 < 16; ++d4) { const f32x4 kv = k[d4]; s0 += kv[0] * q[d4 * 4] + kv[2] * q[d4 * 4 + 2]; s1 += kv[1] * q[d4 * 4 + 1] + kv[3] * q[d4 * 4 + 3]; }
        SC[r * 1024 + j] = s0 + s1;
      } }
    __syncthreads();
    if (wave < 4) {
        LAS float* sc = SC + wave * 1024;
        float m = NEGBIG; for (int j = lane; j < nk; j += 64) m = fmaxf(m, sc[j]);
#pragma unroll
        for (int o = 1; o < 64; o <<= 1) m = fmaxf(m, __shfl_xor(m, o));
        float l = 0.f; for (int j = lane; j < nk; j += 64) { const float e = __builtin_amdgcn_exp2f(sc[j] - m); sc[j] = e; l += e; }
        l = wave_sum(l); const float inv = 1.f / l;
        for (int j = lane; j < nk; j += 64) sc[j] *= inv;
    }
    __syncthreads();
    {
        const int kh = tid >> 8, r = (tid >> 6) & 3, d = tid & 63;
        const int half = (nk + 1) >> 1, j0 = kh * half, j1 = (j0 + half < nk) ? j0 + half : nk;
        const LAS float* sc = SC + r * 1024;
        float a0 = 0.f, a1 = 0.f, a2 = 0.f, a3 = 0.f; int j = j0;
        for (; j + 4 <= j1; j += 4) { const float v0 = VP[j][d], v1 = VP[j + 1][d], v2 = VP[j + 2][d], v3 = VP[j + 3][d];
            a0 += sc[j] * v0; a1 += sc[j + 1] * v1; a2 += sc[j + 2] * v2; a3 += sc[j + 3] * v3; }
        for (; j < j1; ++j) a0 += sc[j] * VP[j][d];
        RED[tid] = (a0 + a1) + (a2 + a3);
    }
    __syncthreads();
    return tid < 256 ? RED[tid] + RED[256 + tid] : 0.f;
}

DI void attn_unit(const Params& p, LAS unsigned char* lds, int bs, int g) {
    int tid_ = threadIdx.x; asm volatile("" : "+v"(tid_)); const int tid = tid_, lane = tid & 63, wave = tid >> 6;
    const unsigned char* ws = p.ws;
    const float* LAS* KP = (const float* LAS*)(lds + L_KP); const float* LAS* VP = (const float* LAS*)(lds + L_VP);
    LAS float* SC = (LAS float*)(lds + L_SC); LAS float* QS = (LAS float*)(lds + L_QS); LAS float* IMP = (LAS float*)(lds + L_IMP); LAS int* SELB = (LAS int*)(lds + L_SELB);
    const size_t row = (size_t)MP + bs;
    __syncthreads();
    if (tid < 256) QS[tid] = bf2f(((const bf16_t*)(ws + WS_QB))[row * 512 + g * 256 + tid]);
    float gate[3] = {0.f, 0.f, 0.f};
    if (tid < 256) { const float* gt = (const float*)(ws + WS_GT) + row * 32 + (g * 4 + (tid >> 6)) * 3; gate[0] = gt[0]; gate[1] = gt[1]; gate[2] = gt[2]; }
    { const float* ck = (const float*)(ws + WS_CKS) + (size_t)(bs * 2 + g) * 512 * 64; const float* cv = (const float*)(ws + WS_CVS) + (size_t)(bs * 2 + g) * 512 * 64;
      for (int j = tid; j < NCMP; j += 512) { KP[j] = ck + j * 64; VP[j] = cv + j * 64; } }
    float ofin = gate[0] * attend(lds, NCMP);
    if (tid < 128) { const int s = tid; float a = 0.f;
        for (int n = 4 * s - 1; n <= 4 * s + 3; ++n) if (n >= 0 && n < NCMP) a += (SC[n] + SC[1024 + n]) + (SC[2048 + n] + SC[3072 + n]);
        IMP[s] = a; }
    __syncthreads();
    if (wave == 0) {
        const unsigned long long lt = (1ull << lane) - 1ull;
        const int xA = __float_as_int(IMP[lane] + (lane == 0 ? 1e4f : 0.f)), xB = __float_as_int(IMP[64 + lane] + (lane == 63 ? 1e4f : 0.f));
        int T = 0;
        for (int bit = 30; bit >= 0; --bit) { const int T2 = T | (1 << bit); const int c = __popcll(__ballot(xA >= T2)) + __popcll(__ballot(xB >= T2)); if (c >= 15) T = T2; }
        const bool gA = xA > T, gB = xB > T, eA = xA == T, eB = xB == T;
        const int need = 15 - (__popcll(__ballot(gA)) + __popcll(__ballot(gB)));
        const unsigned long long beA = __ballot(eA), beB = __ballot(eB);
        const bool sA = gA || (eA && __popcll(beA & lt) < need), sB = gB || (eB && __popcll(beA) + __popcll(beB & lt) < need);
        const unsigned long long mA = __ballot(sA), mB = __ballot(sB);
        if (sA) SELB[__popcll(mA & lt)] = lane;
        if (sB) SELB[__popcll(mA) + __popcll(mB & lt)] = 64 + lane;
    }
    __syncthreads();
    for (int j = tid; j < 961; j += 512) {
        if (j < 960) { const int tp = SELB[j >> 6] * 64 + (j & 63); const int page = p.page_table[bs * NPAGES + (tp >> 7)];
            const float* rb = p.cache_kv + ((size_t)page * PAGE + (tp & 127)) * 512 + g * 64; KP[j] = rb + 256; VP[j] = rb + 384; }
        else { const float* rb = p.out + O_KVS + (size_t)bs * 512 + g * 64; KP[j] = rb + 256; VP[j] = rb + 384; }
    }
    ofin += gate[1] * attend(lds, 961);
    for (int j = tid; j < 513; j += 512) {
        const float* rb = j < 512 ? p.cache_win + ((size_t)bs * 512 + j) * 256 + g * 64 : p.out + O_WINS + ((size_t)bs * 512 + 511) * 256 + g * 64;
        KP[j] = rb; VP[j] = rb + 128; }
    ofin += gate[2] * attend(lds, 513);
    if (tid < 256) ((bf16_t*)(p.ws + WS_MIX))[row * DM + g * 256 + tid] = f2bf(ofin);
}

DI void gdn_unit(const Params& p, LAS unsigned char* lds, int bs, int h) {
    int tid_ = threadIdx.x; asm volatile("" : "+v"(tid_)); const int tid = tid_, lane = tid & 63;
    const unsigned char* ws = p.ws;
    LAS float* QKV = (LAS float*)lds;
    LAS float* RED = QKV + 384;
    LAS float* VN = RED + 1024;
    LAS float* ST = VN + 128;
    const size_t row = (size_t)MP + bs;
    __syncthreads();
    if (tid < 384) {
        const int part = tid >> 7, dd = tid & 127, ch = part * 512 + h * 128 + dd;
        const float* st = p.state_conv + (size_t)bs * 3 * CCH + ch;
        const float xn = p.out[O_CONVS + (size_t)(bs * 3 + 2) * CCH + ch];
        const float a = st[0] * p.conv_w[ch] + st[CCH] * p.conv_w[CCH + ch] + st[2 * CCH] * p.conv_w[2 * CCH + ch] + xn * p.conv_w[3 * CCH + ch];
        const float c = siluf_(a);
        QKV[tid] = c;
        float s = wave_sum(c * c);
        if (lane == 0) ST[tid >> 6] = s;
    }
    __syncthreads();
    const float rq = rsqrtf(ST[0] + ST[1] + EPS) * 0.08838834764831845f, rk = rsqrtf(ST[2] + ST[3] + EPS);
    const float* gt = (const float*)(ws + WS_GT) + row * 32;
    const float eg = __expf(gt[24 + h]), beta = gt[28 + h];
    const int dv = tid & 127, qd = tid >> 7;
    const float* S0 = p.state_S + (size_t)(bs * GH + h) * 16384;
    float sreg[32], ks = 0.f, qs = 0.f, qk = 0.f;
#pragma unroll
    for (int i = 0; i < 32; ++i) { const int dk = qd * 32 + i; const float s = S0[dk * 128 + dv]; sreg[i] = s; const float kk = QKV[128 + dk] * rk, qq = QKV[dk] * rq; ks += kk * s; qs += qq * s; qk += kk * qq; }
    RED[(qd * 2 + 0) * 128 + dv] = ks; RED[(qd * 2 + 1) * 128 + dv] = qs;
    if (dv == 0) ST[8 + qd] = qk;
    __syncthreads();
    const float kS = (RED[dv] + RED[256 + dv]) + (RED[512 + dv] + RED[768 + dv]);
    const float qS = (RED[128 + dv] + RED[384 + dv]) + (RED[640 + dv] + RED[896 + dv]);
    const float qkd = (ST[8] + ST[9]) + (ST[10] + ST[11]);
    const float vn = beta * (QKV[256 + dv] - eg * kS);
    const float o = eg * qS + qkd * vn;
    float* Sn = p.out + O_SS + (size_t)(bs * GH + h) * 16384;
#pragma unroll
    for (int i = 0; i < 32; ++i) { const int dk = qd * 32 + i; Sn[dk * 128 + dv] = eg * sreg[i] + QKV[128 + dk] * rk * vn; }
    if (tid < 128) {
        float s = wave_sum(o * o); if (lane == 0) ST[16 + (tid >> 6)] = s;
    }
    __syncthreads();
    if (tid < 128) {
        const float rs = rsqrtf((ST[16] + ST[17]) * (1.f / 128.f) + EPS);
        const float z = bf2f(((const bf16_t*)(ws + WS_Z))[row * 512 + h * 128 + tid]);
        ((bf16_t*)(p.ws + WS_MIX))[row * DM + 512 + h * 128 + tid] = f2bf(o * rs * p.gdn_norm[tid] * siluf_(z));
    }
}
}
#define RLX_AGENT __ATOMIC_RELAXED, __HIP_MEMORY_SCOPE_AGENT
#define XB_TMO      128
#define XB_XCNT(j)  (256  + 64 * (j))
#define XB_XSUB(j)  (1280 + 64 * (j))
#define XB_XGEN(j)  (2304 + 64 * (j))
#define XB_TOP      3328
#define XB_TOPGEN   3392
#define XCD_BAR_WORDS 3456
#define XB_SPIN_CAP (1u << 18)

__device__ __forceinline__ unsigned xb_ld(unsigned* p)              { return __hip_atomic_load(p, __ATOMIC_RELAXED, __HIP_MEMORY_SCOPE_AGENT); }
__device__ __forceinline__ unsigned xb_add(unsigned* p, unsigned v) { return __hip_atomic_fetch_add(p, v, __ATOMIC_RELAXED, __HIP_MEMORY_SCOPE_AGENT); }
__device__ __forceinline__ unsigned xb_xcc_id() { return (unsigned)__builtin_amdgcn_s_getreg((3 << 11) | 20) & 0xFu; }
#define XB_SPIN(cond, bar) do { unsigned _sp = 0; while (cond) { __builtin_amdgcn_s_sleep(1); \
    if ((++_sp & 255u) == 0u) { if (xb_ld(&(bar)[XB_TMO])) break; if (_sp > XB_SPIN_CAP) { atomicAdd(&(bar)[XB_TMO], 1u); break; } } } } while (0)

struct XcdBarrier {
    unsigned* bar; unsigned x;
    volatile LAS unsigned* st;
};

__device__ __forceinline__ XcdBarrier xcd_barrier_post(unsigned* bar, volatile LAS unsigned* st) {
    XcdBarrier b; b.bar = bar; b.x = xb_xcc_id(); b.st = st;
    if (threadIdx.x == 0) (void)xb_add(&bar[XB_XCNT(b.x)], 1u);
    return b;
}
__device__ __forceinline__ void xcd_barrier_complete(unsigned* bar, unsigned x, unsigned& nloc, unsigned& nx) {
    const unsigned G = gridDim.x * gridDim.y * gridDim.z;
    unsigned sum, cnt, mine, sp = 0u;
    for (;;) {
        sum = 0u; cnt = 0u; mine = 0u;
#pragma unroll
        for (unsigned j = 0; j < 16; ++j) { const unsigned c = xb_ld(&bar[XB_XCNT(j)]); sum += c; cnt += (c > 0u) ? 1u : 0u; mine = (j == x) ? c : mine; }
        if (sum == G) break;
        __builtin_amdgcn_s_sleep(1);
        if ((++sp & 255u) == 0u) { if (xb_ld(&bar[XB_TMO])) break; if (sp > XB_SPIN_CAP) { atomicAdd(&bar[XB_TMO], 1u); break; } }
    }
    nloc = mine > 0u ? mine : 1u; nx = cnt > 0u ? cnt : 1u;
}

__device__ __forceinline__ void xcd_barrier(const XcdBarrier& b) {
    asm volatile("s_waitcnt vmcnt(0)" ::: "memory");
    __syncthreads();
    if (threadIdx.x == 0) {
        unsigned* bar = b.bar;
        __builtin_amdgcn_s_waitcnt(0);
        unsigned nloc = b.st[0], nx = b.st[1];
        if (nloc == 0u) { xcd_barrier_complete(bar, b.x, nloc, nx); b.st[0] = nloc; b.st[1] = nx; }
        const unsigned old = xb_add(&bar[XB_XSUB(b.x)], 1u);
        const unsigned gen = old / nloc;
        if (old + 1u == (gen + 1u) * nloc) {
            __builtin_amdgcn_fence(__ATOMIC_RELEASE, "agent");
            asm volatile("s_waitcnt vmcnt(0)" ::: "memory");
            const unsigned og = xb_add(&bar[XB_TOP], 1u);
            const unsigned tg = og / nx;
            if (og + 1u == (tg + 1u) * nx) xb_add(&bar[XB_TOPGEN], 1u);
            else XB_SPIN(xb_ld(&bar[XB_TOPGEN]) == tg, bar);
            __builtin_amdgcn_fence(__ATOMIC_ACQUIRE, "agent");
            xb_add(&bar[XB_XGEN(b.x)], 1u);
            asm volatile("s_waitcnt vmcnt(0)" ::: "memory");
        } else {
            XB_SPIN(xb_ld(&bar[XB_XGEN(b.x)]) == gen, bar);
            __builtin_amdgcn_fence(__ATOMIC_ACQUIRE, "agent");
            asm volatile("s_waitcnt vmcnt(0)" ::: "memory");
        }
    }
    __syncthreads();
}
constexpr int NTHREADS = 512;
constexpr int LDS_BYTES = 147456;
constexpr int LDS_SLOT = LDS_BYTES - 16, LDS_BARW = LDS_BYTES - 32;
constexpr int CW_BAR = 4096;

DI int next_unit(unsigned* ctr, LAS unsigned char* lds) {
    LAS int* slot = (LAS int*)(lds + LDS_SLOT);
    __syncthreads();
    if (threadIdx.x == 0) *slot = (int)atomicAdd(ctr, 1u);
    __syncthreads();
    return *slot;
}

DI void phase_proj(const Params& p, LAS unsigned char* lds) {
    pg8::Gemm g{(const bf16_t*)(p.ws + WS_XN), (const bf16_t*)(p.ws + WS_WIN), MROWS, INW_PAD, DM};
    pg8::StaticOrder S; S.init(MROWS, INW_PAD, gridDim.x, blockIdx.x);
    epi::EpiProj E{p.out, p.ws, p.a_log, p.dt_bias};
    pg8::gemm_phase<epi::EpiProj, pg8::StaticOrder, true, true>(lds, g, S, E);
}
DI void phase_prep(const Params& p, LAS unsigned char* lds, int rep = 0) {
    unsigned* ctr = (unsigned*)(p.ws + WS_CTL) + 64 + 256 * rep;
    constexpr int NU = cmp::NUNIT + NBP * GH * NCHUNK;
    for (;;) {
        const int u = next_unit(ctr, lds); if (u >= NU) break;
        Params q = p; asm volatile("" : "+s"(q.ws), "+s"(q.out));
        if (u < cmp::NUNIT) { const int v = cmp::NUNIT - 1 - u; cmp::unit(q, lds, v); }
        else { const int v = u - cmp::NUNIT; gdn::prep_unit(q, lds, v >> 9, (v >> 7) & 3, v & 127); }
    }
}
DI void phase_mix(const Params& p, LAS unsigned char* lds, int rep = 0) {
    unsigned* ctr = (unsigned*)(p.ws + WS_CTL) + 128 + 256 * rep;
    constexpr int NU = 8 + 64 + 128 + 512;
    for (;;) {
        const int u = next_unit(ctr, lds); if (u >= NU) break;
        Params q = p; asm volatile("" : "+s"(q.ws), "+s"(q.out));
        if (u < 8) gdn::scan_unit(q, lds, u >> 2, u & 3);
        else if (u < 72) { const int v = u - 8; samp::attn_unit(q, lds, v >> 1, v & 1); }
        else if (u < 200) { const int v = u - 72; samp::gdn_unit(q, lds, v >> 2, v & 3); }
        else { const int v = u - 200; attn::unit(q, lds, (v >> 1) & 1, v & 1, 127 - (v >> 2)); }
    }
}
DI void phase_out(const Params& p, LAS unsigned char* lds) {
    pg8::Gemm g{(const bf16_t*)(p.ws + WS_MIX), (const bf16_t*)(p.ws + WS_WOUT), MROWS, DM, DM};
    pg8::StaticOrder S; S.init(MROWS, DM, gridDim.x, blockIdx.x);
    epi::EpiOut E{p.x_prompt, p.x_sample, p.ws};
    pg8::gemm_phase<epi::EpiOut, pg8::StaticOrder, true, true>(lds, g, S, E);
}
DI void phase_up(const Params& p, LAS unsigned char* lds) {
    pg8::Gemm g{(const bf16_t*)(p.ws + WS_HPB), (const bf16_t*)(p.ws + WS_WGU), MROWS, 2 * DFF, DM};
    pg8::StaticOrder S; S.init(MROWS, 2 * DFF, gridDim.x, blockIdx.x);
    epi::EpiUp E{p.ws};
    pg8::gemm_phase<epi::EpiUp, pg8::StaticOrder, true, true>(lds, g, S, E);
}
DI void phase_down(const Params& p, LAS unsigned char* lds) {
    pg8::Gemm g{(const bf16_t*)(p.ws + WS_HID), (const bf16_t*)(p.ws + WS_WDN), MROWS, DM, DFF};
    pg8::StaticOrder S; S.init(MROWS, DM, gridDim.x, blockIdx.x);
    epi::EpiDown E{p.ws};
    pg8::gemm_phase<epi::EpiDown, pg8::StaticOrder, true, true>(lds, g, S, E);
}
DI void phase_final(const Params& p) {
    int tid_ = threadIdx.x; asm volatile("" : "+v"(tid_)); const int tid = tid_, lane = tid & 63, gw = blockIdx.x * 8 + (tid >> 6), NGW = gridDim.x * 8;
    for (int row = gw; row < MP + NBS; row += NGW) {
        const float* hr = (const float*)(p.ws + WS_HP) + (size_t)row * DM;
        float* o = row < MP ? p.out + O_YP + (size_t)row * DM : p.out + O_YS + (size_t)(row - MP) * DM;
        f32x4 v[4]; float s = 0.f;
#pragma unroll
        for (int j = 0; j < 4; ++j) { v[j] = *(const f32x4*)(hr + (j * 64 + lane) * 4); s += v[j][0] * v[j][0] + v[j][1] * v[j][1] + v[j][2] * v[j][2] + v[j][3] * v[j][3]; }
        const float rs = rsqrtf(wave_sum(s) * (1.f / DM) + EPS);
#pragma unroll
        for (int j = 0; j < 4; ++j) { const f32x4 g = *(const f32x4*)(p.norm_final + (j * 64 + lane) * 4); *(f32x4*)(o + (j * 64 + lane) * 4) = (f32x4){v[j][0] * rs * g[0], v[j][1] * rs * g[1], v[j][2] * rs * g[2], v[j][3] * rs * g[3]}; }
    }
}

#define LDS_DECL extern __shared__ __attribute__((aligned(16))) unsigned char lds_raw[]; LAS unsigned char* lds = (LAS unsigned char*)lds_raw
#ifndef MK_MULTI
#define MK_MULTI 0
#endif
#ifndef MK_PROBE
#define MK_PROBE 0
#endif
#ifndef MK_DUP
#define MK_DUP 0
#endif
#if MK_MULTI
__global__ void __launch_bounds__(NTHREADS, 2) k_p0(Params p) { p0::run(p); }
__global__ void __launch_bounds__(NTHREADS, 2) k_p1(Params p) { LDS_DECL; phase_proj(p, lds); }
__global__ void __launch_bounds__(NTHREADS, 2) k_p2(Params p) { LDS_DECL; phase_prep(p, lds); }
__global__ void __launch_bounds__(NTHREADS, 2) k_p3(Params p) { LDS_DECL; phase_mix(p, lds); }
__global__ void __launch_bounds__(NTHREADS, 2) k_p4(Params p) { gdn::post(p); }
__global__ void __launch_bounds__(NTHREADS, 2) k_p5(Params p) { LDS_DECL; phase_out(p, lds); }
__global__ void __launch_bounds__(NTHREADS, 2) k_p6(Params p) { LDS_DECL; phase_up(p, lds); }
__global__ void __launch_bounds__(NTHREADS, 2) k_p7(Params p) { LDS_DECL; phase_down(p, lds); }
__global__ void __launch_bounds__(NTHREADS, 2) k_p8(Params p) { phase_final(p); }
#else
__global__ void __launch_bounds__(NTHREADS, 2) k_mega(Params p) {
    LDS_DECL;
    cg::grid_group grid = cg::this_grid();
    if (threadIdx.x < 2) ((LAS unsigned*)(lds + LDS_BARW))[threadIdx.x] = 0u;
    __syncthreads();
    const XcdBarrier xbar = xcd_barrier_post((unsigned*)(p.ws + WS_CTL) + CW_BAR, (volatile LAS unsigned*)(lds + LDS_BARW));
#define SEAM() xcd_barrier(xbar)
#define PHASE(call) do { Params q = p; asm volatile("" : "+s"(q.ws), "+s"(q.out)); call; } while (0)
#if MK_PROBE
    unsigned long long* ts = (unsigned long long*)(p.ws + WS_CTL) + 1024;
#define STAMP(k) do { if (blockIdx.x == 0 && threadIdx.x == 0) ts[k] = __builtin_amdgcn_s_memrealtime(); } while (0)
#else
#define STAMP(k) do { } while (0)
#endif
    STAMP(0);
    PHASE(p0::run(q));            grid.sync(); STAMP(1);
#if MK_DUP & 1
    PHASE(p0::run(q));            SEAM();
#endif
    PHASE(phase_proj(q, lds));    SEAM();      STAMP(2);
    PHASE(phase_prep(q, lds));    SEAM();      STAMP(3);
#if MK_DUP & 2
    PHASE(phase_prep(q, lds, 1)); SEAM();
#endif
    PHASE(phase_mix(q, lds));     SEAM();      STAMP(4);
#if MK_DUP & 4
    PHASE(phase_mix(q, lds, 1));  SEAM();
#endif
#if MK_DUP & 8
    SEAM(); SEAM(); SEAM(); SEAM(); SEAM(); SEAM(); SEAM(); SEAM();
#endif
    PHASE(gdn::post(q));          SEAM();      STAMP(5);
    PHASE(phase_out(q, lds));     SEAM();      STAMP(6);
    PHASE(phase_up(q, lds));      SEAM();      STAMP(7);
    PHASE(phase_down(q, lds));    SEAM();      STAMP(8);
    PHASE(phase_final(q));
#if MK_PROBE
    grid.sync(); STAMP(9);
    if (blockIdx.x == 0) {
        __syncthreads();
        const size_t offs[10] = {O_YP, O_YS, O_KVP, O_WINP, O_SP, O_CONVP, O_KVS, O_WINS, O_SS, O_CONVS};
        for (int k = 0; k < 10; ++k) {
            const unsigned long long t0 = k < 9 ? ts[k] : ts[0], t1 = k < 9 ? ts[k + 1] : ts[9];
            int n = (int)((t1 - t0) / 10ull); if (k == 9) n = (int)((t1 - t0) / 100ull);
            if (n > 9000) n = 9000; if (n < 1) n = 1;
            unsigned* o = (unsigned*)(p.out + offs[k]);
            for (int i = threadIdx.x; i < n; i += NTHREADS) o[i] = 0xAAAAAAAAu;
        }
    }
#endif
}
#endif

extern "C" void kernel_launch(void* const* d_in, const int* in_sizes, int n_in, void* d_out, int out_size, void* d_ws, size_t ws_size, hipStream_t stream) {
    static int grid = 0;
    if (grid == 0) {
        if (n_in != 20 || out_size != (int)O_END || ws_size < WS_END) { fprintf(stderr, "kernel_launch: unexpected shapes n_in %d out %d ws %zu\n", n_in, out_size, ws_size); grid = -1; return; }
        int dev = 0, cus = 0;
        (void)hipGetDevice(&dev); (void)hipDeviceGetAttribute(&cus, hipDeviceAttributeMultiprocessorCount, dev);
#if MK_MULTI
        const void* ks[] = {(const void*)k_p1, (const void*)k_p2, (const void*)k_p3, (const void*)k_p5, (const void*)k_p6, (const void*)k_p7};
        for (auto k : ks) (void)hipFuncSetAttribute(k, hipFuncAttributeMaxDynamicSharedMemorySize, LDS_BYTES);
        grid = cus > 0 ? cus : 256;
#else
        (void)hipFuncSetAttribute((const void*)k_mega, hipFuncAttributeMaxDynamicSharedMemorySize, LDS_BYTES);
        int per_cu = 0;
        if (hipOccupancyMaxActiveBlocksPerMultiprocessor(&per_cu, (const void*)k_mega, NTHREADS, LDS_BYTES) != hipSuccess || per_cu < 1) { fprintf(stderr, "kernel_launch: occupancy query failed (%d)\n", per_cu); (void)hipGetLastError(); per_cu = 1; }
        if (per_cu > 1) per_cu = 1;
        grid = (cus > 0 ? cus : 256) * per_cu;
#endif
    }
    if (grid < 0) return;
    Params p{};
    p.x_prompt = (const float*)d_in[0]; p.x_sample = (const float*)d_in[1]; p.cache_kv = (const float*)d_in[2]; p.cache_win = (const float*)d_in[3];
    p.state_S = (const float*)d_in[4]; p.state_conv = (const float*)d_in[5]; p.page_table = (const int*)d_in[6]; p.norm_mix = (const float*)d_in[7];
    p.w_in = (const float*)d_in[8]; p.cmp_pe = (const float*)d_in[9]; p.cmp_w = (const float*)d_in[10]; p.conv_w = (const float*)d_in[11];
    p.a_log = (const float*)d_in[12]; p.dt_bias = (const float*)d_in[13]; p.gdn_norm = (const float*)d_in[14]; p.w_out = (const float*)d_in[15];
    p.norm_ffn = (const float*)d_in[16]; p.w_gate_up = (const float*)d_in[17]; p.w_down = (const float*)d_in[18]; p.norm_final = (const float*)d_in[19];
    p.out = (float*)d_out; p.ws = (unsigned char*)d_ws;
    (void)hipMemsetAsync((char*)d_ws + WS_CTL, 0, WS_ZERO_BYTES, stream);
#if MK_MULTI
    hipLaunchKernelGGL(k_p0, dim3(grid), dim3(NTHREADS), 0, stream, p);
    hipLaunchKernelGGL(k_p1, dim3(grid), dim3(NTHREADS), LDS_BYTES, stream, p);
    hipLaunchKernelGGL(k_p2, dim3(grid), dim3(NTHREADS), LDS_BYTES, stream, p);
    hipLaunchKernelGGL(k_p3, dim3(grid), dim3(NTHREADS), LDS_BYTES, stream, p);
    hipLaunchKernelGGL(k_p4, dim3(grid), dim3(NTHREADS), 0, stream, p);
    hipLaunchKernelGGL(k_p5, dim3(grid), dim3(NTHREADS), LDS_BYTES, stream, p);
    hipLaunchKernelGGL(k_p6, dim3(grid), dim3(NTHREADS), LDS_BYTES, stream, p);
    hipLaunchKernelGGL(k_p7, dim3(grid), dim3(NTHREADS), LDS_BYTES, stream, p);
    hipLaunchKernelGGL(k_p8, dim3(grid), dim3(NTHREADS), 0, stream, p);
#else
    void* args[] = {&p};
    hipError_t e = hipLaunchCooperativeKernel((const void*)k_mega, dim3(grid), dim3(NTHREADS), args, LDS_BYTES, stream);
    if (e != hipSuccess) fprintf(stderr, "kernel_launch: cooperative launch failed: %s (grid %d)\n", hipGetErrorString(e), grid);
#endif
}
```

```cpp
#include <hip/hip_runtime.h>
#include <hip/hip_cooperative_groups.h>
#include <cstdio>
#include <cstdint>
namespace cg = cooperative_groups;

#define DI __device__ __forceinline__
#define LAS __attribute__((address_space(3)))
typedef unsigned short bf16_t;
typedef short bf16x8 __attribute__((ext_vector_type(8)));
typedef short s16x4 __attribute__((ext_vector_type(4)));
typedef float f32x4 __attribute__((ext_vector_type(4)));
typedef float f32x2 __attribute__((ext_vector_type(2)));
typedef float f32x16 __attribute__((ext_vector_type(16)));
typedef unsigned u32x4 __attribute__((ext_vector_type(4)));
typedef unsigned u32x2 __attribute__((ext_vector_type(2)));
typedef __bf16 bf16x2_t __attribute__((ext_vector_type(2)));

constexpr int DM = 1024, TP = 8192, NBP = 2, MP = NBP * TP, NBS = 32, MROWS = 16640  ;
constexpr int HD = 64, NQH = 8, NG = 2, NREP = 4;
constexpr int NPAGES = 64, PAGE = 128, NPOOL = 2560;
constexpr int GH = 4, GDK = 128, GDV = 128, CCH = 1536, NCHUNK = 128;
constexpr int INW = 3360, INW_PAD = 3584, DFF = 2816;
constexpr int NCMP = 511;
constexpr float EPS = 1e-6f, LOG2E = 1.4426950408889634f, QSCALE = 0.125f * LOG2E, NEGBIG = -1e30f;

constexpr size_t O_YP = 0, O_YS = 16777216, O_KVP = 16809984, O_WINP = 25198592, O_SP = 25460736, O_CONVP = 25591808,
                 O_KVS = 25601024, O_WINS = 25617408, O_SS = 29811712, O_CONVS = 31908864, O_END = 32056320;

constexpr size_t MiB = 1u << 20;
constexpr size_t WS_CTL = 0;
constexpr size_t WS_SSQ1 = 1 * MiB, WS_SSQ2 = WS_SSQ1 + 128 * 1024;
constexpr size_t WS_ZERO_BYTES = 2 * MiB;
constexpr size_t WS_WIN = 2 * MiB;
constexpr size_t WS_WOUT = 10 * MiB;
constexpr size_t WS_WGU = 12 * MiB;
constexpr size_t WS_WDN = 24 * MiB;
constexpr size_t WS_WCMP = 30 * MiB;
constexpr size_t WS_CST = 31 * MiB;
constexpr size_t WS_ROPE = 32 * MiB;
constexpr size_t WS_XN = 36 * MiB;
constexpr size_t WS_QB = 70 * MiB;
constexpr size_t WS_KC = 88 * MiB, WS_VC = 93 * MiB;
constexpr size_t WS_KSEL = 98 * MiB, WS_VSELT = 103 * MiB;
constexpr size_t WS_KWIN = 108 * MiB, WS_VWINT = 113 * MiB;
constexpr size_t WS_CI = 118 * MiB;
constexpr size_t WS_Z = 168 * MiB;
constexpr size_t WS_GT = 186 * MiB;
constexpr size_t WS_CKP = 190 * MiB, WS_CVTP = 191 * MiB;
constexpr size_t WS_CKS = 192 * MiB, WS_CVS = 200 * MiB;
constexpr size_t WS_MIX = 208 * MiB;
constexpr size_t WS_HP = 242 * MiB;
constexpr size_t WS_HPB = 308 * MiB;
constexpr size_t WS_HID = 342 * MiB;
constexpr size_t WS_GW = 432 * MiB;
constexpr size_t WS_GQG = 448 * MiB;
constexpr size_t WS_GKGT = 464 * MiB;
constexpr size_t WS_GAQK = 480 * MiB;
constexpr size_t WS_GU = 488 * MiB;
constexpr size_t WS_GGL = 520 * MiB;
constexpr size_t WS_OG = 521 * MiB;
constexpr size_t WS_END = 560 * MiB;
constexpr int CW_Q3 = 64;

struct Params {
    const float *x_prompt, *x_sample, *cache_kv, *cache_win, *state_S, *state_conv;
    const int* page_table;
    const float *norm_mix, *w_in, *cmp_pe, *cmp_w, *conv_w, *a_log, *dt_bias, *gdn_norm, *w_out, *norm_ffn, *w_gate_up, *w_down, *norm_final;
    float* out;
    unsigned char* ws;
};

DI unsigned pk2(float lo, float hi) { f32x2 v = {lo, hi}; bf16x2_t b = __builtin_convertvector(v, bf16x2_t); return __builtin_bit_cast(unsigned, b); }
DI bf16_t f2bf(float f) { return (bf16_t)(pk2(f, 0.f) & 0xffffu); }
DI float bf2f(bf16_t h) { return __uint_as_float(((unsigned)h) << 16); }
DI float sigmoidf_(float x) { return 1.f / (1.f + __expf(-x)); }
DI float siluf_(float x) { return x / (1.f + __expf(-x)); }
DI float wave_sum(float v) {
#pragma unroll
    for (int o = 1; o < 64; o <<= 1) v += __shfl_xor(v, o);
    return v;
}
#define MFMA32(a, b, c) __builtin_amdgcn_mfma_f32_32x32x16_bf16((a), (b), (c), 0, 0, 0)
DI int crow(int r, int hi) { return (r & 3) + 8 * (r >> 2) + 4 * hi; }
#define LDS_FADD(ptr, v) (void)__hip_atomic_fetch_add((ptr), (v), __ATOMIC_RELAXED, __HIP_MEMORY_SCOPE_WORKGROUP)
namespace pg8 {
#define PG8_LAS __attribute__((address_space(3)))
typedef ::bf16_t bf16_t;
typedef ::bf16x8 bf16x8;
typedef ::f32x4 f32x4;
typedef ::u32x4 u32x4;
constexpr int BM = 256, BK = 64, HALF = 128, HTB = HALF * BK * 2  , STAGE_BYTES = 8 * HTB, NXCD = 8, WGM = 8;

__host__ __device__ __forceinline__ int lds_byte(int r, int c) { const int st = (r >> 4) * 2 + (c >> 5), rr = r & 15, cc = c & 31, ob = rr * 64 + cc * 2; return st * 1024 + (ob ^ (((ob >> 9) & 1) << 5)); }
__host__ __device__ __forceinline__ void stage_rc(int b, int& R, int& C) { const int st = b / 1024, sb = b % 1024, swz = sb ^ (((sb >> 9) & 1) << 5); R = (st >> 1) * 16 + swz / 64; C = (st & 1) * 32 + (swz % 64) / 2; }
__host__ __device__ __forceinline__ int perm32(int rho) { const int n = rho >> 4, i = rho & 15; return 8 * (i >> 2) + 4 * n + (i & 3); }

struct Unit { int pm, pn; };
struct Gemm { const bf16_t* A; const bf16_t* Bt; int M, N, K; };

struct StaticOrder {
    int nM, nN, nwg, G, c;
    __host__ __device__ void init(int M, int N, int G_, int c_) { nM = M / BM; nN = N / BM; nwg = nM * nN; G = G_; c = c_; }
    __host__ __device__ bool next(int i, Unit& u) const {
        const long L = (long)i * G + c; if (L >= nwg) return false;
        int wgid = (int)L; { const int q = nwg / NXCD, r = nwg % NXCD, xcd = wgid % NXCD, off = wgid / NXCD; wgid = (xcd < r ? xcd * (q + 1) : r * (q + 1) + (xcd - r) * q) + off; }
        const int nig = WGM * nN, gid = wgid / nig, fm = gid * WGM, gsz = (nM - fm) < WGM ? (nM - fm) : WGM;
        u.pm = fm + ((wgid % nig) % gsz); u.pn = (wgid % nig) / gsz; return true;
    }
    __device__ __forceinline__ void a_ready(const Unit&) const {}
    __device__ __forceinline__ void done(const Unit&) const {}
};


template <class Epi, class Sched, bool ALIGN_EPI = false, bool SP2 = false>
__device__ __forceinline__ void gemm_phase(PG8_LAS unsigned char* lds, const Gemm g, const Sched& S, const Epi& E) {
    int tid_ = threadIdx.x; asm volatile("" : "+v"(tid_)); const int tid = tid_, wid = __builtin_amdgcn_readfirstlane(tid >> 6), lane = tid & 63, wr = wid >> 2, wc = wid & 3, fr = lane & 15, fq = lane >> 4;
    const int K = g.K, nt = K / BK;
    unsigned voffA[2], voffB[2];
#pragma unroll
    for (int i = 0; i < 2; ++i) { int R, C; stage_rc(tid * 16 + i * 8192, R, C); const int Rb = Epi::PERM ? ((R & ~31) + perm32(R & 31)) : R;
        voffA[i] = (unsigned)(R * K + C) * 2u; voffB[i] = (unsigned)(Rb * K + C) * 2u; }
    const size_t kstep = (size_t)(BK * 2);
    const size_t hstep = (size_t)HALF * K * 2;
    const size_t tstep = 2 * hstep;
    const unsigned ldsw = (unsigned)wid * 1024u;
    const int aoff = lds_byte(wr * 64 + fr, fq * 8), boff = lds_byte(wc * 32 + fr, fq * 8);
#define PG8_SA(b, h) (((b) * 2 + (h)) * HTB)
#define PG8_SB(b, h) ((4 + (b) * 2 + (h)) * HTB)
#define PG8_STAGE(bufoff, gbase, voff) do { _Pragma("unroll") for (int _i = 0; _i < 2; ++_i) \
        __builtin_amdgcn_global_load_lds((const unsigned*)((const char*)(gbase) + (voff)[_i]), (PG8_LAS unsigned*)(lds + (bufoff) + ldsw + _i * 8192), 16, 0, 0); } while (0)
#define PG8_LDA(dst, b, h) do { _Pragma("unroll") for (int m = 0; m < 4; ++m) _Pragma("unroll") for (int k = 0; k < 2; ++k) dst[m][k] = *(const PG8_LAS bf16x8*)(lds + PG8_SA(b, h) + aoff + m * 2048 + k * 1024); } while (0)
#define PG8_LDB(dst, b, h) do { _Pragma("unroll") for (int n = 0; n < 2; ++n) _Pragma("unroll") for (int k = 0; k < 2; ++k) dst[n][k] = *(const PG8_LAS bf16x8*)(lds + PG8_SB(b, h) + boff + n * 2048 + k * 1024); } while (0)
#define PG8_MMA(ai, bj, At, Bt) do { __builtin_amdgcn_s_setprio(1); _Pragma("unroll") for (int m = 0; m < 4; ++m) _Pragma("unroll") for (int n = 0; n < 2; ++n) _Pragma("unroll") for (int k = 0; k < 2; ++k) \
        acc[ai][bj][m][n] = __builtin_amdgcn_mfma_f32_16x16x32_bf16(Bt[n][k], At[m][k], acc[ai][bj][m][n], 0, 0, 0); __builtin_amdgcn_s_setprio(0); } while (0)
#define PG8_WAIT_V(n) asm volatile("s_waitcnt vmcnt(" #n ")" ::: "memory")
#define PG8_WAIT_L(n) asm volatile("s_waitcnt lgkmcnt(" #n ")" ::: "memory")
#define PG8_BAR __builtin_amdgcn_s_barrier()
#define PG8_SCHED __builtin_amdgcn_sched_barrier(0)
    Unit cur, nxt; int ui = 0;
    if (!S.next(0, cur)) return;
    f32x4 acc[2][2][4][2];
#pragma unroll
    for (int a = 0; a < 2; ++a)
#pragma unroll
        for (int b = 0; b < 2; ++b)
#pragma unroll
            for (int m = 0; m < 4; ++m)
#pragma unroll
                for (int n = 0; n < 2; ++n) acc[a][b][m][n] = (f32x4){0.f, 0.f, 0.f, 0.f};
    bf16x8 At[4][2], B0[2][2], B1[2][2];
    const char* cA = (const char*)g.A + (size_t)cur.pm * tstep; const char* cB = (const char*)g.Bt + (size_t)cur.pn * tstep;
    S.a_ready(cur);
    if constexpr (SP2) {
        PG8_STAGE(PG8_SB(0, 0), cB, voffB); PG8_STAGE(PG8_SB(0, 1), cB + hstep, voffB); PG8_STAGE(PG8_SA(0, 0), cA, voffA); PG8_STAGE(PG8_SA(0, 1), cA + hstep, voffA);
        if (wr == 1) PG8_BAR;
        PG8_WAIT_V(2); PG8_BAR;
        PG8_STAGE(PG8_SB(1, 0), cB + kstep, voffB); PG8_STAGE(PG8_SA(1, 0), cA + kstep, voffA); PG8_STAGE(PG8_SB(1, 1), cB + hstep + kstep, voffB);
        PG8_WAIT_V(6); PG8_BAR;
    } else {
        PG8_STAGE(PG8_SB(0, 0), cB, voffB); PG8_STAGE(PG8_SA(0, 0), cA, voffA); PG8_STAGE(PG8_SB(0, 1), cB + hstep, voffB); PG8_STAGE(PG8_SA(0, 1), cA + hstep, voffA);
        if (wr == 1) PG8_BAR;
        PG8_WAIT_V(4); PG8_BAR;
        PG8_STAGE(PG8_SB(1, 0), cB + kstep, voffB); PG8_STAGE(PG8_SA(1, 0), cA + kstep, voffA); PG8_STAGE(PG8_SB(1, 1), cB + hstep + kstep, voffB);
        PG8_WAIT_V(6); PG8_BAR;
    }
    for (;;) {
        const bool has_next = S.next(ui + 1, nxt);
        const char* nA = has_next ? (const char*)g.A + (size_t)nxt.pm * tstep : cA; const char* nB = has_next ? (const char*)g.Bt + (size_t)nxt.pn * tstep : cB;
        for (int t = 0; t < nt; t += 2) {
            const bool last = (t == nt - 2);
            const char* a1 = cA + (size_t)(t + 1) * kstep;
            const char* a2 = last ? nA : cA + (size_t)(t + 2) * kstep; const char* b2 = last ? nB : cB + (size_t)(t + 2) * kstep;
            const char* a3 = a2 + kstep; const char* b3 = b2 + kstep;
            if (last && has_next) S.a_ready(nxt);
            if constexpr (SP2) {
            PG8_LDB(B0, 0, 0); PG8_LDB(B1, 0, 1); PG8_SCHED; PG8_LDA(At, 0, 0); PG8_STAGE(PG8_SA(1, 1), a1 + hstep, voffA);
            PG8_WAIT_V(8); PG8_WAIT_L(0); PG8_BAR; PG8_MMA(0, 0, At, B0); PG8_MMA(0, 1, At, B1); PG8_BAR; PG8_SCHED;
            PG8_LDA(At, 0, 1); PG8_STAGE(PG8_SB(0, 0), b2, voffB); PG8_STAGE(PG8_SB(0, 1), b2 + hstep, voffB); PG8_STAGE(PG8_SA(0, 0), a2, voffA);
            PG8_WAIT_V(8); PG8_WAIT_L(0); PG8_BAR; PG8_MMA(1, 0, At, B0); PG8_MMA(1, 1, At, B1); PG8_BAR; PG8_SCHED;
            PG8_LDB(B0, 1, 0); PG8_LDB(B1, 1, 1); PG8_SCHED; PG8_LDA(At, 1, 0); PG8_STAGE(PG8_SA(0, 1), a2 + hstep, voffA);
            PG8_WAIT_V(8); PG8_WAIT_L(0); PG8_BAR; PG8_MMA(0, 0, At, B0); PG8_MMA(0, 1, At, B1); PG8_BAR; PG8_SCHED;
            PG8_LDA(At, 1, 1); PG8_STAGE(PG8_SB(1, 0), b3, voffB); PG8_STAGE(PG8_SB(1, 1), b3 + hstep, voffB); PG8_STAGE(PG8_SA(1, 0), a3, voffA);
            PG8_WAIT_V(8); PG8_WAIT_L(0); PG8_BAR; PG8_MMA(1, 0, At, B0); PG8_MMA(1, 1, At, B1); PG8_BAR; PG8_SCHED;
            } else {
            PG8_LDB(B0, 0, 0); PG8_SCHED; PG8_LDA(At, 0, 0); PG8_STAGE(PG8_SA(1, 1), a1 + hstep, voffA);
            PG8_WAIT_L(8); PG8_BAR; PG8_WAIT_L(0); PG8_MMA(0, 0, At, B0); PG8_BAR; PG8_SCHED;
            PG8_LDB(B1, 0, 1); PG8_STAGE(PG8_SB(0, 0), b2, voffB);
            PG8_BAR; PG8_WAIT_L(0); PG8_MMA(0, 1, At, B1); PG8_BAR;
            PG8_LDA(At, 0, 1); PG8_STAGE(PG8_SA(0, 0), a2, voffA);
            PG8_BAR; PG8_WAIT_L(0); PG8_MMA(1, 0, At, B0); PG8_BAR; PG8_SCHED;
            PG8_STAGE(PG8_SB(0, 1), b2 + hstep, voffB);
            PG8_WAIT_V(6); PG8_BAR; PG8_MMA(1, 1, At, B1); PG8_BAR;
            PG8_LDB(B0, 1, 0); PG8_SCHED; PG8_LDA(At, 1, 0); PG8_STAGE(PG8_SA(0, 1), a2 + hstep, voffA);
            PG8_WAIT_L(8); PG8_BAR; PG8_WAIT_L(0); PG8_MMA(0, 0, At, B0); PG8_BAR; PG8_SCHED;
            PG8_LDB(B1, 1, 1); PG8_STAGE(PG8_SB(1, 0), b3, voffB);
            PG8_BAR; PG8_WAIT_L(0); PG8_MMA(0, 1, At, B1); PG8_BAR;
            PG8_LDA(At, 1, 1); PG8_STAGE(PG8_SA(1, 0), a3, voffA);
            PG8_BAR; PG8_WAIT_L(0); PG8_MMA(1, 0, At, B0); PG8_BAR; PG8_SCHED;
            PG8_STAGE(PG8_SB(1, 1), b3 + hstep, voffB);
            PG8_WAIT_V(6); PG8_BAR; PG8_MMA(1, 1, At, B1); PG8_BAR;
            }
        }
        if constexpr (ALIGN_EPI) { if (wr == 0) PG8_BAR; }
        if constexpr (!Epi::AFTER_DRAIN) { E(acc, cur, wr, wc, fr, fq); S.done(cur); }
        if (!has_next) break;
#pragma unroll
        for (int a = 0; a < 2; ++a)
#pragma unroll
            for (int b = 0; b < 2; ++b)
#pragma unroll
                for (int m = 0; m < 4; ++m)
#pragma unroll
                    for (int n = 0; n < 2; ++n) acc[a][b][m][n] = (f32x4){0.f, 0.f, 0.f, 0.f};
        cur = nxt; cA = nA; cB = nB; ++ui;
        if constexpr (ALIGN_EPI) { if (wr == 1) PG8_BAR; }
    }
    PG8_WAIT_V(0);
    if constexpr (!ALIGN_EPI) { if (wr == 0) PG8_BAR; }
    PG8_BAR;
    if constexpr (Epi::AFTER_DRAIN) { E.fused(acc, cur, wr, wc, fr, fq, lds, wid, lane); S.done(cur); }
#undef PG8_SA
#undef PG8_SB
#undef PG8_STAGE
#undef PG8_LDA
#undef PG8_LDB
#undef PG8_MMA
#undef PG8_WAIT_V
#undef PG8_WAIT_L
#undef PG8_BAR
#undef PG8_SCHED
}
}
namespace epi {
using pg8::Unit;
#define EPI_V8(ai, bj, m) const float v[8] = {acc[ai][bj][m][0][0], acc[ai][bj][m][0][1], acc[ai][bj][m][0][2], acc[ai][bj][m][0][3], acc[ai][bj][m][1][0], acc[ai][bj][m][1][1], acc[ai][bj][m][1][2], acc[ai][bj][m][1][3]}
DI void st_bf16x8(bf16_t* p, const float* v) { u32x4 w; w.x = pk2(v[0], v[1]); w.y = pk2(v[2], v[3]); w.z = pk2(v[4], v[5]); w.w = pk2(v[6], v[7]); *(u32x4*)p = w; }
DI void st_bf16x4(bf16_t* p, float a, float b, float c, float d) { u32x2 w; w.x = pk2(a, b); w.y = pk2(c, d); *(u32x2*)p = w; }
DI void st_f32x4(float* p, float a, float b, float c, float d) { *(f32x4*)p = (f32x4){a, b, c, d}; }

struct EpiProj {
    static constexpr bool PERM = true, AFTER_DRAIN = false;
    float* out; unsigned char* ws; const float* a_log; const float* dt_bias;
    DI void operator()(const f32x4 (&acc)[2][2][4][2], const Unit& u, int wr, int wc, int fr, int fq) const {
        const int pn = u.pn;
        const float* cosT = (const float*)(ws + WS_ROPE); const float* sinT = cosT + 8193 * 32;
#pragma unroll
        for (int ai = 0; ai < 2; ++ai)
#pragma unroll
            for (int m = 0; m < 4; ++m) {
                const int row = u.pm * 256 + ai * 128 + wr * 64 + m * 16 + fr;
                if (row >= MP + NBS) continue;
                const bool samp = row >= MP; const int b = row >> 13, t = row & (TP - 1), bs = row - MP;
                const int pos = samp ? TP : t;
#pragma unroll
                for (int bj = 0; bj < 2; ++bj) {
                    EPI_V8(ai, bj, m);
                    const int cw = bj * 128 + wc * 32 + fq * 8;
                    if (pn < 2) {
                        const int head = (pn * 256 + cw) >> 6, i0 = (cw & 63) >> 1;
                        const f32x4 c4 = *(const f32x4*)(cosT + pos * 32 + i0), s4 = *(const f32x4*)(sinT + pos * 32 + i0);
                        float o1[4], o2[4];
#pragma unroll
                        for (int q = 0; q < 4; ++q) { const float x1 = v[2 * q], x2 = v[2 * q + 1]; o1[q] = (x1 * c4[q] - x2 * s4[q]) * QSCALE; o2[q] = (x2 * c4[q] + x1 * s4[q]) * QSCALE; }
                        bf16_t* qb = (bf16_t*)(ws + WS_QB) + (size_t)row * 512 + head * 64 + i0;
                        st_bf16x4(qb, o1[0], o1[1], o1[2], o1[3]); st_bf16x4(qb + 32, o2[0], o2[1], o2[2], o2[3]);
                    } else if (pn < 5) {
                        const int br = pn - 2, g = wc >> 1, cc = (wc & 1) * 32 + fq * 8;
                        float* dst;
                        if (!samp) dst = (br < 2) ? out + O_KVP + ((size_t)(b * TP + t) * 4 + 2 * br + bj) * 128 + g * 64
                                                  : (t >= TP - 512 ? out + O_WINP + ((size_t)(b * 512 + t - (TP - 512)) * 2 + bj) * 128 + g * 64 : nullptr);
                        else dst = (br < 2) ? out + O_KVS + ((size_t)bs * 4 + 2 * br + bj) * 128 + g * 64 : out + O_WINS + ((size_t)(bs * 512 + 511) * 2 + bj) * 128 + g * 64;
                        const size_t hb = ((size_t)(b * 2 + g) * TP + t) * 64;
                        if (bj == 0) {
                            const int i0 = cc >> 1;
                            const f32x4 c4 = *(const f32x4*)(cosT + pos * 32 + i0), s4 = *(const f32x4*)(sinT + pos * 32 + i0);
                            float o1[4], o2[4];
#pragma unroll
                            for (int q = 0; q < 4; ++q) { const float x1 = v[2 * q], x2 = v[2 * q + 1]; o1[q] = x1 * c4[q] - x2 * s4[q]; o2[q] = x2 * c4[q] + x1 * s4[q]; }
                            if (dst) { st_f32x4(dst + i0, o1[0], o1[1], o1[2], o1[3]); st_f32x4(dst + 32 + i0, o2[0], o2[1], o2[2], o2[3]); }
                            if (!samp) { bf16_t* kb = (bf16_t*)(ws + (br == 0 ? WS_KC : br == 1 ? WS_KSEL : WS_KWIN)) + hb + i0;
                                st_bf16x4(kb, o1[0], o1[1], o1[2], o1[3]); st_bf16x4(kb + 32, o2[0], o2[1], o2[2], o2[3]); }
                        } else {
                            if (dst) { st_f32x4(dst + cc, v[0], v[1], v[2], v[3]); st_f32x4(dst + cc + 4, v[4], v[5], v[6], v[7]); }
                            if (!samp) {
                                if (br == 0) st_bf16x8((bf16_t*)(ws + WS_VC) + hb + cc, v);
                                else { bf16_t* vt = (bf16_t*)(ws + (br == 1 ? WS_VSELT : WS_VWINT)) + ((size_t)(b * 2 + g) * 64 + cc) * TP + t;
#pragma unroll
                                    for (int j = 0; j < 8; ++j) vt[(size_t)j * TP] = f2bf(v[j]); }
                            }
                        }
                    } else if (pn < 11) {
                        const int ch0 = (pn - 5) * 256 + cw;
                        st_bf16x8((bf16_t*)(ws + WS_CI) + (size_t)row * CCH + ch0, v);
                        float* dst = nullptr;
                        if (!samp) { if (t >= TP - 3) dst = out + O_CONVP + (size_t)(b * 3 + t - (TP - 3)) * CCH + ch0; }
                        else dst = out + O_CONVS + (size_t)(bs * 3 + 2) * CCH + ch0;
                        if (dst) { st_f32x4(dst, v[0], v[1], v[2], v[3]); st_f32x4(dst + 4, v[4], v[5], v[6], v[7]); }
                    } else if (pn < 13) {
                        st_bf16x8((bf16_t*)(ws + WS_Z) + (size_t)row * 512 + (pn - 11) * 256 + cw, v);
                    } else {
                        if (bj == 0 && wc == 0) {
                            float o[8];
                            if (fq < 3) {
#pragma unroll
                                for (int j = 0; j < 8; ++j) o[j] = sigmoidf_(v[j]);
                            } else {
#pragma unroll
                                for (int j = 0; j < 4; ++j) { const float xx = v[j] + dt_bias[j]; const float sp = fmaxf(xx, 0.f) + log1pf(__expf(-fabsf(xx))); o[j] = -__expf(a_log[j]) * sp; }
#pragma unroll
                                for (int j = 4; j < 8; ++j) o[j] = sigmoidf_(v[j]);
                            }
                            float* gt = (float*)(ws + WS_GT) + (size_t)row * 32 + fq * 8;
                            st_f32x4(gt, o[0], o[1], o[2], o[3]); st_f32x4(gt + 4, o[4], o[5], o[6], o[7]);
                        }
                    }
                }
            }
    }
};

struct EpiOut {
    static constexpr bool PERM = true, AFTER_DRAIN = false;
    const float* xp; const float* xs; unsigned char* ws;
    DI void operator()(const f32x4 (&acc)[2][2][4][2], const Unit& u, int wr, int wc, int fr, int fq) const {
        float* hp = (float*)(ws + WS_HP); bf16_t* hpb = (bf16_t*)(ws + WS_HPB); float* ssq = (float*)(ws + WS_SSQ1);
#pragma unroll
        for (int ai = 0; ai < 2; ++ai)
#pragma unroll
            for (int m = 0; m < 4; ++m) {
                const int row = u.pm * 256 + ai * 128 + wr * 64 + m * 16 + fr;
                const float* xr = row < MP ? xp + (size_t)row * DM : (row < MP + NBS ? xs + (size_t)(row - MP) * DM : nullptr);
                float sq = 0.f;
#pragma unroll
                for (int bj = 0; bj < 2; ++bj) {
                    EPI_V8(ai, bj, m);
                    const int col = u.pn * 256 + bj * 128 + wc * 32 + fq * 8;
                    float h[8];
                    if (xr) { const f32x4 x0 = *(const f32x4*)(xr + col), x1 = *(const f32x4*)(xr + col + 4);
#pragma unroll
                        for (int j = 0; j < 4; ++j) { h[j] = x0[j] + v[j]; h[4 + j] = x1[j] + v[4 + j]; } }
                    else {
#pragma unroll
                        for (int j = 0; j < 8; ++j) h[j] = 0.f; }
#pragma unroll
                    for (int j = 0; j < 8; ++j) sq += h[j] * h[j];
                    st_f32x4(hp + (size_t)row * DM + col, h[0], h[1], h[2], h[3]); st_f32x4(hp + (size_t)row * DM + col + 4, h[4], h[5], h[6], h[7]);
                    st_bf16x8(hpb + (size_t)row * DM + col, h);
                }
                sq += __shfl_xor(sq, 16); sq += __shfl_xor(sq, 32);
                if (fq == 0) atomicAdd(ssq + row, sq);
            }
    }
};

struct EpiUp {
    static constexpr bool PERM = true, AFTER_DRAIN = false;
    unsigned char* ws;
    DI void operator()(const f32x4 (&acc)[2][2][4][2], const Unit& u, int wr, int wc, int fr, int fq) const {
        const float* ssq = (const float*)(ws + WS_SSQ1); bf16_t* hid = (bf16_t*)(ws + WS_HID);
#pragma unroll
        for (int ai = 0; ai < 2; ++ai)
#pragma unroll
            for (int m = 0; m < 4; ++m) {
                const int row = u.pm * 256 + ai * 128 + wr * 64 + m * 16 + fr;
                const float rs = rsqrtf(ssq[row] * (1.f / DM) + EPS);
#pragma unroll
                for (int bj = 0; bj < 2; ++bj) {
                    EPI_V8(ai, bj, m);
                    const int j0 = (u.pn * 256 + bj * 128 + wc * 32 + fq * 8) >> 1;
                    float h[4];
#pragma unroll
                    for (int q = 0; q < 4; ++q) { const float gte = v[2 * q] * rs, up = v[2 * q + 1] * rs; h[q] = siluf_(gte) * up; }
                    st_bf16x4(hid + (size_t)row * DFF + j0, h[0], h[1], h[2], h[3]);
                }
            }
    }
};

struct EpiDown {
    static constexpr bool PERM = true, AFTER_DRAIN = false;
    unsigned char* ws;
    DI void operator()(const f32x4 (&acc)[2][2][4][2], const Unit& u, int wr, int wc, int fr, int fq) const {
        float* hp = (float*)(ws + WS_HP); float* ssq = (float*)(ws + WS_SSQ2);
#pragma unroll
        for (int ai = 0; ai < 2; ++ai)
#pragma unroll
            for (int m = 0; m < 4; ++m) {
                const int row = u.pm * 256 + ai * 128 + wr * 64 + m * 16 + fr;
                float sq = 0.f;
#pragma unroll
                for (int bj = 0; bj < 2; ++bj) {
                    EPI_V8(ai, bj, m);
                    float* hr = hp + (size_t)row * DM + u.pn * 256 + bj * 128 + wc * 32 + fq * 8;
                    const f32x4 x0 = *(const f32x4*)hr, x1 = *(const f32x4*)(hr + 4);
                    float h[8];
#pragma unroll
                    for (int j = 0; j < 4; ++j) { h[j] = x0[j] + v[j]; h[4 + j] = x1[j] + v[4 + j]; }
#pragma unroll
                    for (int j = 0; j < 8; ++j) sq += h[j] * h[j];
                    st_f32x4(hr, h[0], h[1], h[2], h[3]); st_f32x4(hr + 4, h[4], h[5], h[6], h[7]);
                }
                (void)sq; (void)ssq;
            }
    }
};
}
namespace p0 {
DI int perm_in(int n) {
    if (n < 512) { const int cc = n & 63; return (n & ~63) + ((cc & 1) ? (cc >> 1) + 32 : (cc >> 1)); }
    if (n < 1280) { const int m = n - 512, grp = m >> 6, cc = m & 63, br = grp >> 2, kvi = (grp >> 1) & 1, g = grp & 1;
        const int d = kvi == 0 ? ((cc & 1) ? (cc >> 1) + 32 : (cc >> 1)) : cc; return 512 + br * 256 + kvi * 128 + g * 64 + d; }
    if (n < 2816) return 1304 + (n - 1280);
    if (n < 3328) return 2840 + (n - 2816);
    if (n < 3352) return 1280 + (n - 3328);
    if (n < 3360) return n;
    return -1;
}
template <int MODE> DI void wt_item(const float* W, int Nsrc, bf16_t* WT, int Kdst, int n0, int k0, const float* kscale, int lane) {
    const int n = n0 + lane;
    int src;
    if (MODE == 0) src = perm_in(n);
    else if (MODE == 1) src = n;
    else src = (n & 1) ? DFF + (n >> 1) : (n >> 1);
#pragma unroll 2
    for (int kk = 0; kk < 64; kk += 8) {
        float v[8];
#pragma unroll
        for (int i = 0; i < 8; ++i) { const int k = k0 + kk + i; float x = src >= 0 ? W[(size_t)k * Nsrc + src] : 0.f; if (kscale) x *= kscale[k]; v[i] = x; }
        epi::st_bf16x8(WT + (size_t)n * Kdst + k0 + kk, v);
    }
}
DI void run(const Params& p) {
    int tid_ = threadIdx.x; asm volatile("" : "+v"(tid_)); const int tid = tid_, lane = tid & 63, wave = tid >> 6;
    const int gw = blockIdx.x * 8 + wave, NGW = gridDim.x * 8;
    const int gt = blockIdx.x * 512 + tid, NGT = gridDim.x * 512;
    unsigned char* ws = p.ws;
    constexpr int I_IN = (INW_PAD / 64) * (DM / 64), I_OUT = (DM / 64) * (DM / 64), I_GU = (2 * DFF / 64) * (DM / 64), I_DN = (DM / 64) * (DFF / 64);
    constexpr int NIT = I_IN + I_OUT + I_GU + I_DN;
    for (int it = gw; it < NIT; it += NGW) {
        int r = it;
        if (r < I_IN) { wt_item<0>(p.w_in, INW, (bf16_t*)(ws + WS_WIN), DM, (r / 16) * 64, (r % 16) * 64, nullptr, lane); continue; } r -= I_IN;
        if (r < I_OUT) { wt_item<1>(p.w_out, DM, (bf16_t*)(ws + WS_WOUT), DM, (r / 16) * 64, (r % 16) * 64, nullptr, lane); continue; } r -= I_OUT;
        if (r < I_GU) { wt_item<2>(p.w_gate_up, 2 * DFF, (bf16_t*)(ws + WS_WGU), DM, (r / 16) * 64, (r % 16) * 64, p.norm_ffn, lane); continue; } r -= I_GU;
        wt_item<1>(p.w_down, DM, (bf16_t*)(ws + WS_WDN), DFF, (r / 44) * 64, (r % 44) * 64, nullptr, lane);
    }
    for (int i = gt; i < 2 * 128 * 2 * 64; i += NGT) {
        const int ln = i & 63, et = (i >> 6) & 1, ks = (i >> 7) & 127, kv = i >> 14;
        const float* w = p.cmp_w + ((size_t)kv * 2048 + ks * 16 + (ln >> 5) * 8) * 64 + et * 32 + (ln & 31);
        float v[8];
#pragma unroll
        for (int j = 0; j < 8; ++j) v[j] = w[j * 64];
        epi::st_bf16x8((bf16_t*)(ws + WS_WCMP) + (size_t)i * 8, v);
    }
    for (int o = gw; o < 128; o += NGW) {
        const int kv = o >> 6, e = o & 63; float s = 0.f;
        for (int k = lane; k < 2048; k += 64) s += p.cmp_pe[kv * 2048 + k] * p.cmp_w[((size_t)kv * 2048 + k) * 64 + e];
        s = wave_sum(s);
        if (lane == 0) ((float*)(ws + WS_CST))[o] = s;
    }
    { float* cosT = (float*)(ws + WS_ROPE); float* sinT = cosT + 8193 * 32;
      for (int i = gt; i < 8193 * 32; i += NGT) { const int pos = i >> 5, j = i & 31;
          const double a = (double)pos * pow(10000.0, -(double)j / 32.0); cosT[i] = (float)cos(a); sinT[i] = (float)sin(a); } }
    for (int row = gw; row < MROWS; row += NGW) {
        bf16_t* o = (bf16_t*)(ws + WS_XN) + (size_t)row * DM;
        if (row >= MP + NBS) { for (int j = 0; j < 4; ++j) *(u32x2*)(o + (j * 64 + lane) * 4) = (u32x2){0u, 0u}; continue; }
        const float* xr = row < MP ? p.x_prompt + (size_t)row * DM : p.x_sample + (size_t)(row - MP) * DM;
        f32x4 v[4]; float s = 0.f;
#pragma unroll
        for (int j = 0; j < 4; ++j) { v[j] = *(const f32x4*)(xr + (j * 64 + lane) * 4); s += v[j][0] * v[j][0] + v[j][1] * v[j][1] + v[j][2] * v[j][2] + v[j][3] * v[j][3]; }
        const float rs = rsqrtf(wave_sum(s) * (1.f / DM) + EPS);
#pragma unroll
        for (int j = 0; j < 4; ++j) { const f32x4 g = *(const f32x4*)(p.norm_mix + (j * 64 + lane) * 4);
            epi::st_bf16x4(o + (j * 64 + lane) * 4, v[j][0] * rs * g[0], v[j][1] * rs * g[1], v[j][2] * rs * g[2], v[j][3] * rs * g[3]); }
    }
    { const f32x4* src = (const f32x4*)p.cache_win; f32x4* dst = (f32x4*)(p.out + O_WINS);
      for (int i = gt; i < NBS * 511 * 64; i += NGT) { const int bs = i / (511 * 64), r = i % (511 * 64); dst[(size_t)bs * 512 * 64 + r] = src[(size_t)bs * 512 * 64 + 64 + r]; } }
    { const f32x4* src = (const f32x4*)p.state_conv; f32x4* dst = (f32x4*)(p.out + O_CONVS);
      for (int i = gt; i < NBS * 2 * (CCH / 4); i += NGT) { const int bs = i / (2 * (CCH / 4)), r = i % (2 * (CCH / 4)); dst[(size_t)bs * 3 * (CCH / 4) + r] = src[(size_t)bs * 3 * (CCH / 4) + (CCH / 4) + r]; } }
}
}
namespace attn {
constexpr int KSTR = 72, VSTR = 68;
constexpr int KT_BYTES = 64 * KSTR * 2, VT_BYTES = 64 * VSTR * 2, TILE_BYTES = KT_BYTES + VT_BYTES;
constexpr int OFF_IMP = 36864, IMP_STR = 132;
constexpr int LDS_NEED = OFF_IMP + 8 * 8 * IMP_STR * 4;

DI void ld_tile(const bf16_t* kbase, const bf16_t* vtbase, size_t vts, u32x4& kr, u32x4& vr, int tid) {
    kr = *(const u32x4*)(kbase + (tid >> 3) * 64 + (tid & 7) * 8);
    vr = *(const u32x4*)(vtbase + (size_t)(tid >> 3) * vts + (tid & 7) * 8);
}
DI void st_tile(LAS unsigned char* buf, const u32x4& kr, const u32x4& vr, int tid) {
    *(LAS u32x4*)(buf + ((tid >> 3) * KSTR + (tid & 7) * 8) * 2) = kr;
    LAS u32x2* vp = (LAS u32x2*)(buf + KT_BYTES + ((tid >> 3) * VSTR + (tid & 7) * 8) * 2);
    vp[0] = (u32x2){vr.x, vr.y}; vp[1] = (u32x2){vr.z, vr.w};
}
DI void qk_tile(const LAS unsigned char* kb, const bf16x8 (&qf)[4], f32x16& s0, f32x16& s1, int lane) {
    const LAS unsigned char* p0 = kb + ((lane & 31) * KSTR + (lane >> 5) * 8) * 2;
    f32x16 z; for (int i = 0; i < 16; ++i) z[i] = 0.f;
    s0 = z; s1 = z;
#pragma unroll
    for (int kd = 0; kd < 4; ++kd) {
        const bf16x8 a0 = *(const LAS bf16x8*)(p0 + kd * 32), a1 = *(const LAS bf16x8*)(p0 + 32 * KSTR * 2 + kd * 32);
        s0 = MFMA32(a0, qf[kd], s0); s1 = MFMA32(a1, qf[kd], s1);
    }
}
DI bf16x8 pack8(const f32x16& p, int base) {
    u32x4 w; w.x = pk2(p[base], p[base + 1]); w.y = pk2(p[base + 2], p[base + 3]); w.z = pk2(p[base + 4], p[base + 5]); w.w = pk2(p[base + 6], p[base + 7]);
    return __builtin_bit_cast(bf16x8, w);
}
DI void pv_tile(const LAS unsigned char* vb, const f32x16& p0, const f32x16& p1, f32x16& o0, f32x16& o1, int lane) {
    const LAS unsigned char* v0 = vb + ((lane & 31) * VSTR + 4 * (lane >> 5)) * 2;
#pragma unroll
    for (int ks = 0; ks < 4; ++ks) {
        const bf16x8 pb = (ks < 2) ? pack8(p0, (ks & 1) * 8) : pack8(p1, (ks & 1) * 8);
#pragma unroll
        for (int dt = 0; dt < 2; ++dt) {
            const s16x4 lo = *(const LAS s16x4*)(v0 + (dt * 32 * VSTR + 16 * ks) * 2), hi = *(const LAS s16x4*)(v0 + (dt * 32 * VSTR + 16 * ks + 8) * 2);
            const bf16x8 a = __builtin_shufflevector(lo, hi, 0, 1, 2, 3, 4, 5, 6, 7);
            if (dt == 0) o0 = MFMA32(a, pb, o0); else o1 = MFMA32(a, pb, o1);
        }
    }
}
DI void softmax_step(f32x16& s0, f32x16& s1, float& m, float& l, f32x16& o0, f32x16& o1) {
    float mt = NEGBIG;
#pragma unroll
    for (int r = 0; r < 16; ++r) mt = fmaxf(mt, fmaxf(s0[r], s1[r]));
    mt = fmaxf(mt, __shfl_xor(mt, 32));
    const float mn = fmaxf(m, mt), alpha = __builtin_amdgcn_exp2f(m - mn);
    float sum = 0.f;
#pragma unroll
    for (int r = 0; r < 16; ++r) { s0[r] = __builtin_amdgcn_exp2f(s0[r] - mn); s1[r] = __builtin_amdgcn_exp2f(s1[r] - mn); sum += s0[r] + s1[r]; }
    l = l * alpha + sum; m = mn;
#pragma unroll
    for (int r = 0; r < 16; ++r) { o0[r] *= alpha; o1[r] *= alpha; }
}

#define ATT_TBUF(i) (lds + (i) * TILE_BYTES)
#define ATT_STREAM_BEGIN(NT, KP, VP, VTS) { u32x4 kr_, vr_; const int nt_ = (NT); \
    { const int i_ = 0; ld_tile((KP), (VP), (VTS), kr_, vr_, tid); } st_tile(ATT_TBUF(0), kr_, vr_, tid); __syncthreads(); \
    for (int it_ = 0; it_ < nt_; ++it_) { \
        if (it_ + 1 < nt_) { const int i_ = it_ + 1; ld_tile((KP), (VP), (VTS), kr_, vr_, tid); } \
        { const LAS unsigned char* tb = ATT_TBUF(it_ & 1); const int i_ = it_;
#define ATT_STREAM_END() } \
        if (it_ + 1 < nt_) st_tile(ATT_TBUF((it_ + 1) & 1), kr_, vr_, tid); \
        __syncthreads(); } }

DI void unit(const Params& p, LAS unsigned char* lds, int b, int g, int tt) {
    int tid_ = threadIdx.x; asm volatile("" : "+v"(tid_)); const int tid = tid_, lane = tid & 63, wave = __builtin_amdgcn_readfirstlane(tid >> 6), hi = lane >> 5, col = lane & 31, tokl = col & 7, r = col >> 3;
    const int t = tt * 64 + wave * 8 + tokl;
    const size_t row = (size_t)b * TP + t;
    const unsigned char* ws = p.ws;
    const size_t slab = (size_t)(b * 2 + g);
    bf16x8 qf[4];
    { const bf16_t* q = (const bf16_t*)(ws + WS_QB) + row * 512 + (g * 4 + r) * 64 + hi * 8;
#pragma unroll
      for (int kd = 0; kd < 4; ++kd) qf[kd] = *(const bf16x8*)(q + kd * 16); }
    const float* gt = (const float*)(ws + WS_GT) + row * 32 + (g * 4 + r) * 3;
    const float gate0 = gt[0], gate1 = gt[1], gate2 = gt[2];
    LAS float* imp = (LAS float*)(lds + OFF_IMP) + wave * 8 * IMP_STR;
    for (int i = lane; i < 8 * IMP_STR; i += 64) imp[i] = 0.f;
    f32x16 of0, of1; for (int i = 0; i < 16; ++i) { of0[i] = 0.f; of1[i] = 0.f; }

    const int nv = t >= 31 ? ((t - 31) >> 4) + 1 : 0;
    {
        const int ntile = (4 * tt + 3 + 63) >> 6;
        const bf16_t* ck = (const bf16_t*)(ws + WS_CKP) + slab * 512 * 64;
        const bf16_t* cvt = (const bf16_t*)(ws + WS_CVTP) + slab * 64 * 512;
        float m = NEGBIG, l = 0.f;
        ATT_STREAM_BEGIN(ntile, ck + (size_t)i_ * 64 * 64, cvt + i_ * 64, 512)
            f32x16 s0, s1; qk_tile(tb, qf, s0, s1, lane);
            float mt = NEGBIG;
#pragma unroll
            for (int rr = 0; rr < 16; ++rr) { const int n0 = i_ * 64 + crow(rr, hi); s0[rr] = n0 < nv ? s0[rr] : NEGBIG; s1[rr] = n0 + 32 < nv ? s1[rr] : NEGBIG; mt = fmaxf(mt, fmaxf(s0[rr], s1[rr])); }
            const float mn = fmaxf(m, mt); float sum = 0.f;
#pragma unroll
            for (int rr = 0; rr < 16; ++rr) sum += __builtin_amdgcn_exp2f(s0[rr] - mn) + __builtin_amdgcn_exp2f(s1[rr] - mn);
            l = l * __builtin_amdgcn_exp2f(m - mn) + sum; m = mn;
        ATT_STREAM_END()
        const float mo = __shfl_xor(m, 32), lo = __shfl_xor(l, 32);
        const float M = fmaxf(m, mo), L = l * __builtin_amdgcn_exp2f(m - M) + lo * __builtin_amdgcn_exp2f(mo - M);
        const float invL = M > -1e29f ? 1.f / L : 0.f;
        f32x16 o0, o1; for (int i = 0; i < 16; ++i) { o0[i] = 0.f; o1[i] = 0.f; }
        LAS float* myimp = imp + tokl * IMP_STR;
        ATT_STREAM_BEGIN(ntile, ck + (size_t)i_ * 64 * 64, cvt + i_ * 64, 512)
            f32x16 s0, s1; qk_tile(tb, qf, s0, s1, lane);
#pragma unroll
            for (int rr = 0; rr < 16; ++rr) { const int n0 = i_ * 64 + crow(rr, hi);
                s0[rr] = n0 < nv ? __builtin_amdgcn_exp2f(s0[rr] - M) * invL : 0.f; s1[rr] = n0 + 32 < nv ? __builtin_amdgcn_exp2f(s1[rr] - M) * invL : 0.f; }
#pragma unroll
            for (int a = 0; a < 4; ++a) {
                const int sb0 = i_ * 16 + 2 * a + hi, sb1 = sb0 + 8;
                LDS_FADD(myimp + sb0, (s0[4 * a] + s0[4 * a + 1]) + (s0[4 * a + 2] + s0[4 * a + 3])); LDS_FADD(myimp + sb0 + 1, s0[4 * a + 3]);
                LDS_FADD(myimp + sb1, (s1[4 * a] + s1[4 * a + 1]) + (s1[4 * a + 2] + s1[4 * a + 3])); LDS_FADD(myimp + sb1 + 1, s1[4 * a + 3]);
            }
            pv_tile(tb + KT_BYTES, s0, s1, o0, o1, lane);
        ATT_STREAM_END()
#pragma unroll
        for (int i = 0; i < 16; ++i) { of0[i] = gate0 * o0[i]; of1[i] = gate0 * o1[i]; }
    }
    unsigned long long sel_lo = 0ull, sel_hi = 0ull;
    {
        const unsigned long long lt = (1ull << lane) - 1ull;
#pragma unroll 1
        for (int j = 0; j < 8; ++j) {
            const float i0 = imp[j * IMP_STR + lane], i1 = imp[j * IMP_STR + 64 + lane];
            const int sA = lane, sB = lane + 64;
            const bool vA = sA <= tt, vB = sB <= tt;
            const bool fA = sA == 0 || sA == tt || sA == tt - 1, fB = sB == tt || sB == tt - 1;
            const int xA = vA ? __float_as_int(i0 + (fA ? 1e4f : 0.f)) : -1, xB = vB ? __float_as_int(i1 + (fB ? 1e4f : 0.f)) : -1;
            int T = 0;
#pragma unroll 1
            for (int bit = 30; bit >= 0; --bit) { const int T2 = T | (1 << bit);
                const int c = __popcll(__ballot(xA >= T2)) + __popcll(__ballot(xB >= T2)); T = __builtin_amdgcn_readfirstlane(c >= 16 ? T2 : T); }
            const bool gA = xA > T, gB = xB > T, eA = xA == T, eB = xB == T;
            const int need = 16 - (__popcll(__ballot(gA)) + __popcll(__ballot(gB)));
            const unsigned long long beA = __ballot(eA), beB = __ballot(eB);
            const int preA = __popcll(beA & lt), preB = __popcll(beA) + __popcll(beB & lt);
            const unsigned long long mA = __ballot(gA || (eA && preA < need)), mB = __ballot(gB || (eB && preB < need));
            if (tokl == j) { sel_lo = mA; sel_hi = mB; }
        }
    }
    {
        const bf16_t* kb = (const bf16_t*)(ws + WS_KSEL) + slab * TP * 64;
        const bf16_t* vt = (const bf16_t*)(ws + WS_VSELT) + slab * 64 * TP;
        float m = NEGBIG, l = 0.f; f32x16 o0, o1; for (int i = 0; i < 16; ++i) { o0[i] = 0.f; o1[i] = 0.f; }
        ATT_STREAM_BEGIN(tt + 1, kb + (size_t)(i_ == 0 ? tt : i_ - 1) * 64 * 64, vt + (size_t)(i_ == 0 ? tt : i_ - 1) * 64, TP)
            const int s = i_ == 0 ? tt : i_ - 1;
            const bool on = ((s < 64 ? (sel_lo >> s) : (sel_hi >> (s - 64))) & 1ull) != 0ull;
            f32x16 s0, s1; qk_tile(tb, qf, s0, s1, lane);
            const int lim = on ? (s == tt ? t - s * 64 : 64) : -1;
#pragma unroll
            for (int rr = 0; rr < 16; ++rr) { const int kk = crow(rr, hi); s0[rr] = kk <= lim ? s0[rr] : NEGBIG; s1[rr] = kk + 32 <= lim ? s1[rr] : NEGBIG; }
            softmax_step(s0, s1, m, l, o0, o1);
            pv_tile(tb + KT_BYTES, s0, s1, o0, o1, lane);
        ATT_STREAM_END()
        const float sc = gate1 / (l + __shfl_xor(l, 32));
#pragma unroll
        for (int i = 0; i < 16; ++i) { of0[i] += sc * o0[i]; of1[i] += sc * o1[i]; }
    }
    {
        const bf16_t* kb = (const bf16_t*)(ws + WS_KWIN) + slab * TP * 64;
        const bf16_t* vt = (const bf16_t*)(ws + WS_VWINT) + slab * 64 * TP;
        const int ntile = (tt < 8 ? tt : 8) + 1;
        float m = NEGBIG, l = 0.f; f32x16 o0, o1; for (int i = 0; i < 16; ++i) { o0[i] = 0.f; o1[i] = 0.f; }
        ATT_STREAM_BEGIN(ntile, kb + (size_t)(tt - i_) * 64 * 64, vt + (size_t)(tt - i_) * 64, TP)
            const int k0 = (tt - i_) * 64;
            f32x16 s0, s1; qk_tile(tb, qf, s0, s1, lane);
#pragma unroll
            for (int rr = 0; rr < 16; ++rr) { const int kp = k0 + crow(rr, hi);
                s0[rr] = (kp <= t && kp >= t - 512) ? s0[rr] : NEGBIG; s1[rr] = (kp + 32 <= t && kp + 32 >= t - 512) ? s1[rr] : NEGBIG; }
            softmax_step(s0, s1, m, l, o0, o1);
            pv_tile(tb + KT_BYTES, s0, s1, o0, o1, lane);
        ATT_STREAM_END()
        const float sc = gate2 / (l + __shfl_xor(l, 32));
#pragma unroll
        for (int i = 0; i < 16; ++i) { of0[i] += sc * o0[i]; of1[i] += sc * o1[i]; }
    }
    { bf16_t* o = (bf16_t*)(p.ws + WS_MIX) + row * DM + (g * 4 + r) * 64 + 4 * hi;
#pragma unroll
      for (int i = 0; i < 4; ++i) { epi::st_bf16x4(o + 8 * i, of0[4 * i], of0[4 * i + 1], of0[4 * i + 2], of0[4 * i + 3]);
                                    epi::st_bf16x4(o + 32 + 8 * i, of1[4 * i], of1[4 * i + 1], of1[4 * i + 2], of1[4 * i + 3]); } }
}
}
namespace gdn {
template <int I> struct SolveRow {
    static DI void run(float (&x)[64], const LAS float* LM, const LAS float* VF, const LAS float* KF, const LAS float* GC, bool isu, int col) {
        SolveRow<I - 1>::run(x, LM, VF, KF, GC, isu, col);
        float acc = isu ? VF[I * 128 + col] * GC[64 + I] : KF[I * 128 + col] * GC[64 + I] * GC[128 + I];
        float a1 = 0.f, a2 = 0.f, a3 = 0.f;
#pragma unroll
        for (int j = 0; j < I; ++j) { const float t = LM[I * 64 + j] * x[j]; if ((j & 3) == 0) acc -= t; else if ((j & 3) == 1) a1 -= t; else if ((j & 3) == 2) a2 -= t; else a3 -= t; }
        x[I] = (acc + a1) + (a2 + a3);
        asm volatile("" : "+v"(x[I]) :: "memory");
    }
};
template <> struct SolveRow<-1> { static DI void run(float (&)[64], const LAS float*, const LAS float*, const LAS float*, const LAS float*, bool, int) {} };
constexpr int P_KF = 0, P_VF = 32768, P_QB = 65536, P_KB = 82944, P_LM = 100352, P_GC = 116736, PSTR = 136;
DI void prep_unit(const Params& p, LAS unsigned char* lds, int b, int h, int n) {
    int tid_ = threadIdx.x; asm volatile("" : "+v"(tid_)); const int tid = tid_, lane = tid & 63, wave = __builtin_amdgcn_readfirstlane(tid >> 6);
    const unsigned char* ws = p.ws;
    LAS float* KF = (LAS float*)(lds + P_KF); LAS float* VF = (LAS float*)(lds + P_VF);
    LAS bf16_t* QB = (LAS bf16_t*)(lds + P_QB); LAS bf16_t* KB = (LAS bf16_t*)(lds + P_KB);
    LAS float* LM = (LAS float*)(lds + P_LM); LAS float* GC = (LAS float*)(lds + P_GC);
    const int chunk = (b * GH + h) * NCHUNK + n;
    const size_t row0 = (size_t)b * TP + (size_t)n * 64;
    __syncthreads();
    if (wave == 0) {
        const float* gt = (const float*)(ws + WS_GT) + (row0 + lane) * 32;
        float g = gt[24 + h]; const float be = gt[28 + h];
#pragma unroll
        for (int o = 1; o < 64; o <<= 1) { const float x = __shfl_up(g, o); if (lane >= o) g += x; }
        GC[lane] = g; GC[64 + lane] = be; GC[128 + lane] = __expf(g);
    }
    __syncthreads();
    {
        const int dd = (tid & 15) * 8;
        const float* cw = p.conv_w;
        const bf16_t* ci = (const bf16_t*)(ws + WS_CI);
#pragma unroll 1
        for (int cc = 0; cc < 2; ++cc) {
            const int c = (tid >> 4) + cc * 32; const int t = n * 64 + c;
            float val[3][8];
#pragma unroll
            for (int part = 0; part < 3; ++part) {
                const int ch = part * 512 + h * 128 + dd;
                float a[8]; for (int i = 0; i < 8; ++i) a[i] = 0.f;
#pragma unroll
                for (int j = 0; j < 4; ++j) {
                    const int tj = t - 3 + j;
                    if (tj >= 0) {
                        const u32x4 xv = *(const u32x4*)(ci + ((size_t)b * TP + tj) * CCH + ch);
                        const f32x4 w0 = *(const f32x4*)(cw + j * CCH + ch), w1 = *(const f32x4*)(cw + j * CCH + ch + 4);
                        const unsigned xs[4] = {xv.x, xv.y, xv.z, xv.w};
#pragma unroll
                        for (int i = 0; i < 4; ++i) { a[2 * i] += __uint_as_float(xs[i] << 16) * (i < 2 ? w0[2 * i] : w1[2 * i - 4]); a[2 * i + 1] += __uint_as_float(xs[i] & 0xffff0000u) * (i < 2 ? w0[2 * i + 1] : w1[2 * i - 3]); }
                    }
                }
#pragma unroll
                for (int i = 0; i < 8; ++i) val[part][i] = siluf_(a[i]);
            }
            float sq = 0.f, sk = 0.f;
#pragma unroll
            for (int i = 0; i < 8; ++i) { sq += val[0][i] * val[0][i]; sk += val[1][i] * val[1][i]; }
#pragma unroll
            for (int o = 1; o < 16; o <<= 1) { sq += __shfl_xor(sq, o); sk += __shfl_xor(sk, o); }
            const float rq = rsqrtf(sq + EPS) * 0.08838834764831845f, rk = rsqrtf(sk + EPS), eg = GC[128 + c];
            float qn[8], qg[8], kn[8];
#pragma unroll
            for (int i = 0; i < 8; ++i) { qn[i] = val[0][i] * rq; qg[i] = qn[i] * eg; kn[i] = val[1][i] * rk; }
            {
              bf16_t* qf = (bf16_t*)(ws + WS_GQG) + (size_t)chunk * 8192 + (size_t)(((c >> 5) * 8 + (dd >> 4)) * 64 + (c & 31)) * 8 + ((dd >> 3) & 1) * 4;
              epi::st_bf16x4(qf, qg[0], qg[1], qg[2], qg[3]); epi::st_bf16x4(qf + 32 * 8, qg[4], qg[5], qg[6], qg[7]); }
            { u32x4 w; w.x = pk2(qn[0], qn[1]); w.y = pk2(qn[2], qn[3]); w.z = pk2(qn[4], qn[5]); w.w = pk2(qn[6], qn[7]); *(LAS u32x4*)(QB + c * PSTR + dd) = w; }
            { u32x4 w; w.x = pk2(kn[0], kn[1]); w.y = pk2(kn[2], kn[3]); w.z = pk2(kn[4], kn[5]); w.w = pk2(kn[6], kn[7]); *(LAS u32x4*)(KB + c * PSTR + dd) = w; }
            *(LAS f32x4*)(KF + c * 128 + dd) = (f32x4){kn[0], kn[1], kn[2], kn[3]}; *(LAS f32x4*)(KF + c * 128 + dd + 4) = (f32x4){kn[4], kn[5], kn[6], kn[7]};
            *(LAS f32x4*)(VF + c * 128 + dd) = (f32x4){val[2][0], val[2][1], val[2][2], val[2][3]}; *(LAS f32x4*)(VF + c * 128 + dd + 4) = (f32x4){val[2][4], val[2][5], val[2][6], val[2][7]};
        }
    }
    __syncthreads();
    {
        const int mat = wave >> 2, ti = (wave >> 1) & 1, tj = wave & 1, hi = lane >> 5, cl = lane & 31;
        const LAS bf16_t* A = (mat == 0 ? KB : QB) + (ti * 32 + cl) * PSTR + hi * 8;
        const LAS bf16_t* B = KB + (tj * 32 + cl) * PSTR + hi * 8;
        f32x16 acc; for (int i = 0; i < 16; ++i) acc[i] = 0.f;
#pragma unroll
        for (int ks = 0; ks < 8; ++ks) acc = MFMA32(*(const LAS bf16x8*)(A + ks * 16), *(const LAS bf16x8*)(B + ks * 16), acc);
        const int j = tj * 32 + cl; const float gj = GC[j];
#pragma unroll
        for (int r = 0; r < 16; ++r) {
            const int i = ti * 32 + crow(r, hi);
            const float dec = __expf(fminf(GC[i] - gj, 0.f));
            if (mat == 0) LM[i * 64 + j] = i > j ? GC[64 + i] * acc[r] * dec : 0.f;
            else ((bf16_t*)(ws + WS_GAQK))[(size_t)chunk * 4096 + (size_t)(((i >> 5) * 4 + (j >> 4)) * 64 + (i & 31) + 32 * ((j >> 2) & 1)) * 8 + ((j >> 3) & 1) * 4 + (j & 3)] = f2bf(i >= j ? acc[r] * dec : 0.f);
        }
    }
    __syncthreads();
    if (wave < 4) {
        const int cc = tid; const bool isu = cc < 128; const int col = cc & 127;
        float x[64];
        int zoff = 0; asm volatile("" : "+v"(zoff));
        SolveRow<63>::run(x, LM + zoff, VF, KF, GC + zoff, isu, col);
        if (isu) {
            float* gu = (float*)(ws + WS_GU) + (size_t)chunk * 8192 + (size_t)(col >> 5) * 2048;
#pragma unroll
            for (int ct = 0; ct < 2; ++ct)
#pragma unroll
                for (int i4 = 0; i4 < 4; ++i4)
#pragma unroll
                    for (int hh = 0; hh < 2; ++hh) { const int c0 = 32 * ct + 8 * i4 + 4 * hh;
                        *(f32x4*)(gu + ((ct * 4 + i4) * 64 + (col & 31) + 32 * hh) * 4) = (f32x4){x[c0], x[c0 + 1], x[c0 + 2], x[c0 + 3]}; }
        } else {
            bf16_t* gw = (bf16_t*)(ws + WS_GW) + (size_t)chunk * 8192 + (size_t)((col >> 4) * 64 + 32 * ((col >> 2) & 1)) * 8 + ((col >> 3) & 1) * 4 + (col & 3);
#pragma unroll
            for (int i = 0; i < 64; ++i) gw[(size_t)((i >> 5) * 8 * 64 + (i & 31)) * 8] = f2bf(-x[i]);
        }
    } else {
        const int t2 = tid - 256, dk = t2 & 127, c0 = (t2 >> 7) * 32; const float glast = GC[63];
        bf16_t* kg = (bf16_t*)(ws + WS_GKGT) + (size_t)chunk * 8192;
#pragma unroll
        for (int q = 0; q < 4; ++q) { const int kc = (c0 >> 4) + (q >> 1), hh = q & 1; float v[8];
#pragma unroll
            for (int e = 0; e < 8; ++e) { const int c = 16 * kc + 8 * (e >> 2) + 4 * hh + (e & 3); v[e] = KF[c * 128 + dk] * __expf(glast - GC[c]); }
            epi::st_bf16x8(kg + (size_t)(((dk >> 5) * 4 + kc) * 64 + (dk & 31) + 32 * hh) * 8, v); }
        if (t2 == 0) ((float*)(ws + WS_GGL))[chunk] = __expf(glast);
    }
}

constexpr int SC_STAGE = 40960  , SC_X = 2 * SC_STAGE, SC_XB = 12288  ;
DI void scan_unit(const Params& p, LAS unsigned char* lds, int b, int h, int dvs) {
    int tid_ = threadIdx.x; asm volatile("" : "+v"(tid_)); const int tid = tid_, lane = tid & 63, wave = __builtin_amdgcn_readfirstlane(tid >> 6), hi = lane >> 5, cl = lane & 31;
    const unsigned char* ws = p.ws;
    const int chunk0 = (b * GH + h) * NCHUNK;
    __syncthreads();
    if (wave == 0) {
        f32x16 S[4]; for (int k = 0; k < 4; ++k) for (int i = 0; i < 16; ++i) S[k][i] = 0.f;
        float gl = ((const float*)(ws + WS_GGL))[chunk0];
        __syncthreads();
        for (int n = 0; n < NCHUNK; ++n) {
            const LAS unsigned char* st = lds + (n & 1) * SC_STAGE; LAS unsigned char* xb = lds + SC_X + (n & 1) * SC_XB;
            const float gln = n + 1 < NCHUNK ? ((const float*)(ws + WS_GGL))[chunk0 + n + 1] : 0.f;
            bf16x8 Sb[8];
#pragma unroll
            for (int ks = 0; ks < 8; ++ks) { Sb[ks] = attn::pack8(S[ks >> 1], (ks & 1) * 8); *(LAS bf16x8*)(xb + ks * 1024 + lane * 16) = Sb[ks]; }
            bf16x8 vb[4];
#pragma unroll
            for (int ct = 0; ct < 2; ++ct) { f32x16 vn;
#pragma unroll
                for (int i4 = 0; i4 < 4; ++i4) { const f32x4 u4 = *(const LAS f32x4*)(st + 32768 + (ct * 4 + i4) * 1024 + lane * 16); vn[4 * i4] = u4[0]; vn[4 * i4 + 1] = u4[1]; vn[4 * i4 + 2] = u4[2]; vn[4 * i4 + 3] = u4[3]; }
#pragma unroll
                for (int ks = 0; ks < 8; ++ks) vn = MFMA32(*(const LAS bf16x8*)(st + (ct * 8 + ks) * 1024 + lane * 16), Sb[ks], vn);
                vb[2 * ct] = attn::pack8(vn, 0); vb[2 * ct + 1] = attn::pack8(vn, 8);
                *(LAS bf16x8*)(xb + 8192 + (2 * ct) * 1024 + lane * 16) = vb[2 * ct]; *(LAS bf16x8*)(xb + 8192 + (2 * ct + 1) * 1024 + lane * 16) = vb[2 * ct + 1]; }
#pragma unroll
            for (int dkt = 0; dkt < 4; ++dkt) {
#pragma unroll
                for (int i = 0; i < 16; ++i) S[dkt][i] *= gl;
#pragma unroll
                for (int kc = 0; kc < 4; ++kc) S[dkt] = MFMA32(*(const LAS bf16x8*)(st + 16384 + (dkt * 4 + kc) * 1024 + lane * 16), vb[kc], S[dkt]); }
            gl = gln;
            __syncthreads();
        }
        __syncthreads();
        float* so = p.out + O_SP + (size_t)(b * GH + h) * 16384 + dvs * 32 + cl;
#pragma unroll
        for (int dkt = 0; dkt < 4; ++dkt)
#pragma unroll
            for (int r = 0; r < 16; ++r) so[(size_t)(dkt * 32 + crow(r, hi)) * 128] = S[dkt][r];
    } else if (wave <= 2) {
        const int par = wave - 1;
        bf16x8 qf[16], af[8];
#define SCAN_LDF(n_) do { const bf16_t* q_ = (const bf16_t*)(ws + WS_GQG) + (size_t)(chunk0 + (n_)) * 8192 + lane * 8; const bf16_t* a_ = (const bf16_t*)(ws + WS_GAQK) + (size_t)(chunk0 + (n_)) * 4096 + lane * 8; \
            _Pragma("unroll") for (int f = 0; f < 16; ++f) qf[f] = *(const bf16x8*)(q_ + f * 512); _Pragma("unroll") for (int f = 0; f < 8; ++f) af[f] = *(const bf16x8*)(a_ + f * 512); } while (0)
        SCAN_LDF(par);
        __syncthreads();
        for (int n = 0; n <= NCHUNK; ++n) {
            const int m = n - 1;
            if (m >= 0 && (m & 1) == par) {
                const LAS unsigned char* xb = lds + SC_X + (m & 1) * SC_XB;
                bf16x8 Sb[8], vb[4];
#pragma unroll
                for (int ks = 0; ks < 8; ++ks) Sb[ks] = *(const LAS bf16x8*)(xb + ks * 1024 + lane * 16);
#pragma unroll
                for (int kc = 0; kc < 4; ++kc) vb[kc] = *(const LAS bf16x8*)(xb + 8192 + kc * 1024 + lane * 16);
                float* og = (float*)(p.ws + WS_OG) + ((size_t)(b * GH + h) * TP + (size_t)m * 64) * 128 + dvs * 32 + cl;
#pragma unroll
                for (int ct = 0; ct < 2; ++ct) { f32x16 o; for (int i = 0; i < 16; ++i) o[i] = 0.f;
#pragma unroll
                    for (int ks = 0; ks < 8; ++ks) o = MFMA32(qf[ct * 8 + ks], Sb[ks], o);
#pragma unroll
                    for (int kc = 0; kc < 4; ++kc) o = MFMA32(af[ct * 4 + kc], vb[kc], o);
#pragma unroll
                    for (int r = 0; r < 16; ++r) og[(size_t)(ct * 32 + crow(r, hi)) * 128] = o[r]; }
                if (m + 2 < NCHUNK) SCAN_LDF(m + 2);
            }
            __syncthreads();
        }
    } else {
        const int t3 = tid - 192;
        u32x4 ra[8], rb[8];
#define SCAN_SRC(n_, q_) ({ const int pc_ = (q_) * 320 + t3; const unsigned char* s_ = pc_ < 1024 ? ws + WS_GW + (size_t)(chunk0 + (n_)) * 16384 + (size_t)pc_ * 16 \
            : pc_ < 2048 ? ws + WS_GKGT + (size_t)(chunk0 + (n_)) * 16384 + (size_t)(pc_ - 1024) * 16 : ws + WS_GU + (size_t)(chunk0 + (n_)) * 32768 + (size_t)dvs * 8192 + (size_t)(pc_ - 2048) * 16; s_; })
#define SCAN_ISSUE(R, n_) do { _Pragma("unroll") for (int q = 0; q < 8; ++q) if (q * 320 + t3 < 2560) R[q] = *(const u32x4*)SCAN_SRC(n_, q); } while (0)
#define SCAN_COMMIT(R, n_) do { LAS unsigned char* d_ = lds + ((n_) & 1) * SC_STAGE; _Pragma("unroll") for (int q = 0; q < 8; ++q) if (q * 320 + t3 < 2560) *(LAS u32x4*)(d_ + (q * 320 + t3) * 16) = R[q]; } while (0)
        SCAN_ISSUE(ra, 0); SCAN_ISSUE(rb, 1); SCAN_COMMIT(ra, 0);
        __syncthreads();
        for (int n = 0; n < NCHUNK; n += 2) {
            if (n + 2 < NCHUNK) SCAN_ISSUE(ra, n + 2);
            SCAN_COMMIT(rb, n + 1);
            __syncthreads();
            if (n + 3 < NCHUNK) SCAN_ISSUE(rb, n + 3);
            if (n + 2 < NCHUNK) SCAN_COMMIT(ra, n + 2);
            __syncthreads();
        }
        __syncthreads();
    }
}

DI void post(const Params& p) {
    int tid_ = threadIdx.x; asm volatile("" : "+v"(tid_)); const int tid = tid_, lane = tid & 63;
    const int gh = (blockIdx.x * 512 + tid) >> 5, NGH = (gridDim.x * 512) >> 5, l32 = lane & 31;
    const f32x4 nw = *(const f32x4*)(p.gdn_norm + l32 * 4);
    for (int it = gh; it < MP * GH; it += NGH) {
        const int row = it >> 2, h = it & 3, b = row >> 13, t = row & (TP - 1);
        const f32x4 o = *(const f32x4*)((const float*)(p.ws + WS_OG) + ((size_t)(b * GH + h) * TP + t) * 128 + l32 * 4);
        float s = o[0] * o[0] + o[1] * o[1] + o[2] * o[2] + o[3] * o[3];
#pragma unroll
        for (int x = 1; x < 32; x <<= 1) s += __shfl_xor(s, x);
        const float rs = rsqrtf(s * (1.f / 128.f) + EPS);
        const u32x2 zz = *(const u32x2*)((const bf16_t*)(p.ws + WS_Z) + (size_t)row * 512 + h * 128 + l32 * 4);
        const float z0 = __uint_as_float(zz.x << 16), z1 = __uint_as_float(zz.x & 0xffff0000u), z2 = __uint_as_float(zz.y << 16), z3 = __uint_as_float(zz.y & 0xffff0000u);
        epi::st_bf16x4((bf16_t*)(p.ws + WS_MIX) + (size_t)row * DM + 512 + h * 128 + l32 * 4, o[0] * rs * nw[0] * siluf_(z0), o[1] * rs * nw[1] * siluf_(z1), o[2] * rs * nw[2] * siluf_(z2), o[3] * rs * nw[3] * siluf_(z3));
    }
}
}
namespace cmp {
constexpr int TSTR = 72, C_TOK = 0, C_PART = 76032, C_LDS = C_PART + 8 * 32 * 64 * 4;
constexpr int NSLAB = 8 + 128, NUNIT = NSLAB * 16;
DI void unit(const Params& p, LAS unsigned char* lds, int u) {
    int tid_ = threadIdx.x; asm volatile("" : "+v"(tid_)); const int tid = tid_, lane = tid & 63, wave = __builtin_amdgcn_readfirstlane(tid >> 6), hi = lane >> 5, cl = lane & 31;
    const unsigned char* ws = p.ws;
    const int sl = u >> 4, n0 = (u & 15) * 32;
    const bool samp = sl >= 8;
    int kv, bb, g;
    if (!samp) { kv = sl >> 2; bb = (sl >> 1) & 1; g = sl & 1; } else { const int s2 = sl - 8; kv = s2 >> 6; bb = (s2 >> 1) & 31; g = s2 & 1; }
    LAS bf16_t* TOK = (LAS bf16_t*)(lds + C_TOK); LAS float* PART = (LAS float*)(lds + C_PART);
    __syncthreads();
    if (!samp) {
        u32x4 w[9];
        const bf16_t* src = (const bf16_t*)(ws + (kv ? WS_VC : WS_KC)) + (size_t)(bb * 2 + g) * TP * 64;
#pragma unroll
        for (int q = 0; q < 9; ++q) { const int i = q * 512 + tid, tok = i >> 3, ch = i & 7, tk = n0 * 16 + tok;
            w[q] = (i < 528 * 8 && tk < TP) ? *(const u32x4*)(src + (size_t)tk * 64 + ch * 8) : (u32x4){0u, 0u, 0u, 0u}; }
#pragma unroll
        for (int q = 0; q < 9; ++q) { const int i = q * 512 + tid, tok = i >> 3, ch = i & 7;
            if (i < 528 * 8) *(LAS u32x4*)(TOK + ((tok & 15) * 33 + (tok >> 4)) * TSTR + ch * 8) = w[q]; }
    } else {
        int pg[9];
#pragma unroll
        for (int q = 0; q < 9; ++q) { const int i = q * 512 + tid, tok = i >> 3, tk = n0 * 16 + tok;
            pg[q] = (i < 528 * 8 && tk < TP) ? p.page_table[bb * NPAGES + (tk >> 7)] : -1; }
        f32x4 a[9], c[9];
#pragma unroll
        for (int q = 0; q < 9; ++q) { const int i = q * 512 + tid, tok = i >> 3, ch = i & 7, tk = n0 * 16 + tok;
            if (pg[q] >= 0) { const float* src = p.cache_kv + (((size_t)pg[q] * PAGE + (tk & 127)) * 4 + kv) * 128 + g * 64 + ch * 8;
                a[q] = __builtin_nontemporal_load((const f32x4*)src); c[q] = __builtin_nontemporal_load((const f32x4*)(src + 4)); }
            else { a[q] = (f32x4){0.f, 0.f, 0.f, 0.f}; c[q] = a[q]; } }
#pragma unroll
        for (int q = 0; q < 9; ++q) { const int i = q * 512 + tid, tok = i >> 3, ch = i & 7;
            u32x4 w; w.x = pk2(a[q][0], a[q][1]); w.y = pk2(a[q][2], a[q][3]); w.z = pk2(c[q][0], c[q][1]); w.w = pk2(c[q][2], c[q][3]);
            if (i < 528 * 8) *(LAS u32x4*)(TOK + ((tok & 15) * 33 + (tok >> 4)) * TSTR + ch * 8) = w; }
    }
    __syncthreads();
    f32x16 acc[2]; for (int i = 0; i < 16; ++i) { acc[0][i] = 0.f; acc[1][i] = 0.f; }
    const bf16_t* wt = (const bf16_t*)(ws + WS_WCMP) + (size_t)kv * 64 * 2048 + lane * 8;
#pragma unroll
    for (int k = 0; k < 16; ++k) {
        const int ks = wave * 16 + k, l = ks >> 2, d0 = (ks & 3) * 16;
        const bf16x8 a = *(const LAS bf16x8*)(TOK + ((l & 15) * 33 + cl + (l >> 4)) * TSTR + d0 + hi * 8);
        const bf16x8 b0 = *(const bf16x8*)(wt + (size_t)ks * 1024), b1 = *(const bf16x8*)(wt + (size_t)ks * 1024 + 512);
        acc[0] = MFMA32(a, b0, acc[0]); acc[1] = MFMA32(a, b1, acc[1]);
    }
#pragma unroll
    for (int et = 0; et < 2; ++et)
#pragma unroll
        for (int r = 0; r < 16; ++r) PART[(wave * 32 + crow(r, hi)) * 64 + et * 32 + cl] = acc[et][r];
    __syncthreads();
    const float* cst = (const float*)(ws + WS_CST) + kv * 64;
    for (int i = tid; i < 32 * 64; i += 512) {
        const int n = i >> 6, e = i & 63;
        float s = cst[e];
#pragma unroll
        for (int w = 0; w < 8; ++w) s += PART[(w * 32 + n) * 64 + e];
        const int ng = n0 + n;
        if (ng >= NCMP) s = 0.f;
        if (!samp) { if (kv == 0) ((bf16_t*)(p.ws + WS_CKP))[((size_t)(bb * 2 + g) * 512 + ng) * 64 + e] = f2bf(s);
                     else ((bf16_t*)(p.ws + WS_CVTP))[((size_t)(bb * 2 + g) * 64 + e) * 512 + ng] = f2bf(s); }
        else ((float*)(p.ws + (kv == 0 ? WS_CKS : WS_CVS)))[((size_t)(bb * 2 + g) * 512 + ng) * 64 + e] = s;
    }
}
}
namespace samp {
constexpr int L_KP = 0, L_VP = 8192, L_SC = 16384, L_RED = 32768, L_QS = 34816, L_IMP = 35840, L_SELB = 36400, L_STAT = 36480;
constexpr int L_RED2 = 40960;
DI float attend(LAS unsigned char* lds, int nk) {
    int tid_ = threadIdx.x; asm volatile("" : "+v"(tid_)); const int tid = tid_, lane = tid & 63, wave = tid >> 6, kq = tid >> 4, dq = tid & 15;
    const float* const LAS* KP = (const float* const LAS*)(lds + L_KP); const float* const LAS* VP = (const float* const LAS*)(lds + L_VP);
    LAS float* SC = (LAS float*)(lds + L_SC); LAS float* RED2 = (LAS float*)(lds + L_RED2); const LAS float* QS = (const LAS float*)(lds + L_QS);
    __syncthreads();
    {
        f32x4 q[4];
#pragma unroll
        for (int r = 0; r < 4; ++r) q[r] = *(const LAS f32x4*)(QS + r * 64 + dq * 4);
        for (int j0 = 0; j0 < nk; j0 += 128) {
            f32x4 kv[4];
#pragma unroll
            for (int u = 0; u < 4; ++u) { const int j = j0 + u * 32 + kq; kv[u] = j < nk ? ((const f32x4*)KP[j])[dq] : (f32x4){0.f, 0.f, 0.f, 0.f}; }
#pragma unroll
            for (int u = 0; u < 4; ++u) { const int j = j0 + u * 32 + kq;
                float pr[4];
#pragma unroll
                for (int r = 0; r < 4; ++r) { float a = (kv[u][0] * q[r][0] + kv[u][1] * q[r][1]) + (kv[u][2] * q[r][2] + kv[u][3] * q[r][3]);
                    a += __shfl_xor(a, 1); a += __shfl_xor(a, 2); a += __shfl_xor(a, 4); a += __shfl_xor(a, 8); pr[r] = a; }
                if (j < nk && dq < 4) SC[dq * 1024 + j] = dq == 0 ? pr[0] : dq == 1 ? pr[1] : dq == 2 ? pr[2] : pr[3]; }
        }
    }
    __syncthreads();
    if (wave < 4) {
        LAS float* sc = SC + wave * 1024;
        float m = NEGBIG; for (int j = lane; j < nk; j += 64) m = fmaxf(m, sc[j]);
#pragma unroll
        for (int o = 1; o < 64; o <<= 1) m = fmaxf(m, __shfl_xor(m, o));
        float l = 0.f; for (int j = lane; j < nk; j += 64) { const float e = __builtin_amdgcn_exp2f(sc[j] - m); sc[j] = e; l += e; }
        l = wave_sum(l); const float inv = 1.f / l;
        for (int j = lane; j < nk; j += 64) sc[j] *= inv;
    }
    __syncthreads();
    {
        f32x4 acc[4]; for (int r = 0; r < 4; ++r) acc[r] = (f32x4){0.f, 0.f, 0.f, 0.f};
        for (int j0 = 0; j0 < nk; j0 += 128) {
            f32x4 vv[4];
#pragma unroll
            for (int u = 0; u < 4; ++u) { const int j = j0 + u * 32 + kq; vv[u] = j < nk ? ((const f32x4*)VP[j])[dq] : (f32x4){0.f, 0.f, 0.f, 0.f}; }
#pragma unroll
            for (int u = 0; u < 4; ++u) { const int j = j0 + u * 32 + kq;
                if (j < nk) {
#pragma unroll
                    for (int r = 0; r < 4; ++r) acc[r] += SC[r * 1024 + j] * vv[u]; } }
        }
#pragma unroll
        for (int r = 0; r < 4; ++r) *(LAS f32x4*)(RED2 + kq * 256 + r * 64 + dq * 4) = acc[r];
    }
    __syncthreads();
    float o = 0.f;
    if (tid < 256) {
#pragma unroll 8
        for (int k = 0; k < 32; ++k) o += RED2[k * 256 + tid];
    }
    return o;
}

DI void attn_unit(const Params& p, LAS unsigned char* lds, int bs, int g) {
    int tid_ = threadIdx.x; asm volatile("" : "+v"(tid_)); const int tid = tid_, lane = tid & 63, wave = tid >> 6;
    const unsigned char* ws = p.ws;
    const float* LAS* KP = (const float* LAS*)(lds + L_KP); const float* LAS* VP = (const float* LAS*)(lds + L_VP);
    LAS float* SC = (LAS float*)(lds + L_SC); LAS float* QS = (LAS float*)(lds + L_QS); LAS float* IMP = (LAS float*)(lds + L_IMP); LAS int* SELB = (LAS int*)(lds + L_SELB);
    const size_t row = (size_t)MP + bs;
    __syncthreads();
    if (tid < 256) QS[tid] = bf2f(((const bf16_t*)(ws + WS_QB))[row * 512 + g * 256 + tid]);
    float gate[3] = {0.f, 0.f, 0.f};
    if (tid < 256) { const float* gt = (const float*)(ws + WS_GT) + row * 32 + (g * 4 + (tid >> 6)) * 3; gate[0] = gt[0]; gate[1] = gt[1]; gate[2] = gt[2]; }
    { const float* ck = (const float*)(ws + WS_CKS) + (size_t)(bs * 2 + g) * 512 * 64; const float* cv = (const float*)(ws + WS_CVS) + (size_t)(bs * 2 + g) * 512 * 64;
      for (int j = tid; j < NCMP; j += 512) { KP[j] = ck + j * 64; VP[j] = cv + j * 64; } }
    float ofin = gate[0] * attend(lds, NCMP);
    if (tid < 128) { const int s = tid; float a = 0.f;
        for (int n = 4 * s - 1; n <= 4 * s + 3; ++n) if (n >= 0 && n < NCMP) a += (SC[n] + SC[1024 + n]) + (SC[2048 + n] + SC[3072 + n]);
        IMP[s] = a; }
    __syncthreads();
    if (wave == 0) {
        const unsigned long long lt = (1ull << lane) - 1ull;
        const int xA = __float_as_int(IMP[lane] + (lane == 0 ? 1e4f : 0.f)), xB = __float_as_int(IMP[64 + lane] + (lane == 63 ? 1e4f : 0.f));
        int T = 0;
        for (int bit = 30; bit >= 0; --bit) { const int T2 = T | (1 << bit); const int c = __popcll(__ballot(xA >= T2)) + __popcll(__ballot(xB >= T2)); if (c >= 15) T = T2; }
        const bool gA = xA > T, gB = xB > T, eA = xA == T, eB = xB == T;
        const int need = 15 - (__popcll(__ballot(gA)) + __popcll(__ballot(gB)));
        const unsigned long long beA = __ballot(eA), beB = __ballot(eB);
        const bool sA = gA || (eA && __popcll(beA & lt) < need), sB = gB || (eB && __popcll(beA) + __popcll(beB & lt) < need);
        const unsigned long long mA = __ballot(sA), mB = __ballot(sB);
        if (sA) SELB[__popcll(mA & lt)] = lane;
        if (sB) SELB[__popcll(mA) + __popcll(mB & lt)] = 64 + lane;
    }
    __syncthreads();
    for (int j = tid; j < 961; j += 512) {
        if (j < 960) { const int tp = SELB[j >> 6] * 64 + (j & 63); const int page = p.page_table[bs * NPAGES + (tp >> 7)];
            const float* rb = p.cache_kv + ((size_t)page * PAGE + (tp & 127)) * 512 + g * 64; KP[j] = rb + 256; VP[j] = rb + 384; }
        else { const float* rb = p.out + O_KVS + (size_t)bs * 512 + g * 64; KP[j] = rb + 256; VP[j] = rb + 384; }
    }
    ofin += gate[1] * attend(lds, 961);
    for (int j = tid; j < 513; j += 512) {
        const float* rb = j < 512 ? p.cache_win + ((size_t)bs * 512 + j) * 256 + g * 64 : p.out + O_WINS + ((size_t)bs * 512 + 511) * 256 + g * 64;
        KP[j] = rb; VP[j] = rb + 128; }
    ofin += gate[2] * attend(lds, 513);
    if (tid < 256) ((bf16_t*)(p.ws + WS_MIX))[row * DM + g * 256 + tid] = f2bf(ofin);
}

DI void gdn_unit(const Params& p, LAS unsigned char* lds, int bs, int h) {
    int tid_ = threadIdx.x; asm volatile("" : "+v"(tid_)); const int tid = tid_, lane = tid & 63;
    const unsigned char* ws = p.ws;
    LAS float* QKV = (LAS float*)lds;
    LAS float* RED = QKV + 384;
    LAS float* VN = RED + 1024;
    LAS float* ST = VN + 128;
    const size_t row = (size_t)MP + bs;
    __syncthreads();
    if (tid < 384) {
        const int part = tid >> 7, dd = tid & 127, ch = part * 512 + h * 128 + dd;
        const float* st = p.state_conv + (size_t)bs * 3 * CCH + ch;
        const float xn = p.out[O_CONVS + (size_t)(bs * 3 + 2) * CCH + ch];
        const float a = st[0] * p.conv_w[ch] + st[CCH] * p.conv_w[CCH + ch] + st[2 * CCH] * p.conv_w[2 * CCH + ch] + xn * p.conv_w[3 * CCH + ch];
        const float c = siluf_(a);
        QKV[tid] = c;
        float s = wave_sum(c * c);
        if (lane == 0) ST[tid >> 6] = s;
    }
    __syncthreads();
    const float rq = rsqrtf(ST[0] + ST[1] + EPS) * 0.08838834764831845f, rk = rsqrtf(ST[2] + ST[3] + EPS);
    const float* gt = (const float*)(ws + WS_GT) + row * 32;
    const float eg = __expf(gt[24 + h]), beta = gt[28 + h];
    const int dv = tid & 127, qd = tid >> 7;
    const float* S0 = p.state_S + (size_t)(bs * GH + h) * 16384;
    float sreg[32], ks = 0.f, qs = 0.f, qk = 0.f;
#pragma unroll
    for (int i = 0; i < 32; ++i) { const int dk = qd * 32 + i; const float s = S0[dk * 128 + dv]; sreg[i] = s; const float kk = QKV[128 + dk] * rk, qq = QKV[dk] * rq; ks += kk * s; qs += qq * s; qk += kk * qq; }
    RED[(qd * 2 + 0) * 128 + dv] = ks; RED[(qd * 2 + 1) * 128 + dv] = qs;
    if (dv == 0) ST[8 + qd] = qk;
    __syncthreads();
    const float kS = (RED[dv] + RED[256 + dv]) + (RED[512 + dv] + RED[768 + dv]);
    const float qS = (RED[128 + dv] + RED[384 + dv]) + (RED[640 + dv] + RED[896 + dv]);
    const float qkd = (ST[8] + ST[9]) + (ST[10] + ST[11]);
    const float vn = beta * (QKV[256 + dv] - eg * kS);
    const float o = eg * qS + qkd * vn;
    float* Sn = p.out + O_SS + (size_t)(bs * GH + h) * 16384;
#pragma unroll
    for (int i = 0; i < 32; ++i) { const int dk = qd * 32 + i; Sn[dk * 128 + dv] = eg * sreg[i] + QKV[128 + dk] * rk * vn; }
    if (tid < 128) {
        float s = wave_sum(o * o); if (lane == 0) ST[16 + (tid >> 6)] = s;
    }
    __syncthreads();
    if (tid < 128) {
        const float rs = rsqrtf((ST[16] + ST[17]) * (1.f / 128.f) + EPS);
        const float z = bf2f(((const bf16_t*)(ws + WS_Z))[row * 512 + h * 128 + tid]);
        ((bf16_t*)(p.ws + WS_MIX))[row * DM + 512 + h * 128 + tid] = f2bf(o * rs * p.gdn_norm[tid] * siluf_(z));
    }
}
}
#define RLX_AGENT __ATOMIC_RELAXED, __HIP_MEMORY_SCOPE_AGENT
#define XB_TMO      128
#define XB_XCNT(j)  (256  + 64 * (j))
#define XB_XSUB(j)  (1280 + 64 * (j))
#define XB_XGEN(j)  (2304 + 64 * (j))
#define XB_TOP      3328
#define XB_TOPGEN   3392
#define XCD_BAR_WORDS 3456
#define XB_SPIN_CAP (1u << 18)

__device__ __forceinline__ unsigned xb_ld(unsigned* p)              { return __hip_atomic_load(p, __ATOMIC_RELAXED, __HIP_MEMORY_SCOPE_AGENT); }
__device__ __forceinline__ unsigned xb_add(unsigned* p, unsigned v) { return __hip_atomic_fetch_add(p, v, __ATOMIC_RELAXED, __HIP_MEMORY_SCOPE_AGENT); }
__device__ __forceinline__ unsigned xb_xcc_id() { return (unsigned)__builtin_amdgcn_s_getreg((3 << 11) | 20) & 0xFu; }
#define XB_SPIN(cond, bar) do { unsigned _sp = 0; while (cond) { __builtin_amdgcn_s_sleep(1); \
    if ((++_sp & 255u) == 0u) { if (xb_ld(&(bar)[XB_TMO])) break; if (_sp > XB_SPIN_CAP) { atomicAdd(&(bar)[XB_TMO], 1u); break; } } } } while (0)

struct XcdBarrier {
    unsigned* bar; unsigned x;
    volatile LAS unsigned* st;
};

__device__ __forceinline__ XcdBarrier xcd_barrier_post(unsigned* bar, volatile LAS unsigned* st) {
    XcdBarrier b; b.bar = bar; b.x = xb_xcc_id(); b.st = st;
    if (threadIdx.x == 0) (void)xb_add(&bar[XB_XCNT(b.x)], 1u);
    return b;
}
__device__ __forceinline__ void xcd_barrier_complete(unsigned* bar, unsigned x, unsigned& nloc, unsigned& nx) {
    const unsigned G = gridDim.x * gridDim.y * gridDim.z;
    unsigned sum, cnt, mine, sp = 0u;
    for (;;) {
        sum = 0u; cnt = 0u; mine = 0u;
#pragma unroll
        for (unsigned j = 0; j < 16; ++j) { const unsigned c = xb_ld(&bar[XB_XCNT(j)]); sum += c; cnt += (c > 0u) ? 1u : 0u; mine = (j == x) ? c : mine; }
        if (sum == G) break;
        __builtin_amdgcn_s_sleep(1);
        if ((++sp & 255u) == 0u) { if (xb_ld(&bar[XB_TMO])) break; if (sp > XB_SPIN_CAP) { atomicAdd(&bar[XB_TMO], 1u); break; } }
    }
    nloc = mine > 0u ? mine : 1u; nx = cnt > 0u ? cnt : 1u;
}

__device__ __forceinline__ void xcd_barrier(const XcdBarrier& b) {
    asm volatile("s_waitcnt vmcnt(0)" ::: "memory");
    __syncthreads();
    if (threadIdx.x == 0) {
        unsigned* bar = b.bar;
        __builtin_amdgcn_s_waitcnt(0);
        unsigned nloc = b.st[0], nx = b.st[1];
        if (nloc == 0u) { xcd_barrier_complete(bar, b.x, nloc, nx); b.st[0] = nloc; b.st[1] = nx; }
        const unsigned old = xb_add(&bar[XB_XSUB(b.x)], 1u);
        const unsigned gen = old / nloc;
        if (old + 1u == (gen + 1u) * nloc) {
            __builtin_amdgcn_fence(__ATOMIC_RELEASE, "agent");
            asm volatile("s_waitcnt vmcnt(0)" ::: "memory");
            const unsigned og = xb_add(&bar[XB_TOP], 1u);
            const unsigned tg = og / nx;
            if (og + 1u == (tg + 1u) * nx) xb_add(&bar[XB_TOPGEN], 1u);
            else XB_SPIN(xb_ld(&bar[XB_TOPGEN]) == tg, bar);
            __builtin_amdgcn_fence(__ATOMIC_ACQUIRE, "agent");
            xb_add(&bar[XB_XGEN(b.x)], 1u);
            asm volatile("s_waitcnt vmcnt(0)" ::: "memory");
        } else {
            XB_SPIN(xb_ld(&bar[XB_XGEN(b.x)]) == gen, bar);
            __builtin_amdgcn_fence(__ATOMIC_ACQUIRE, "agent");
            asm volatile("s_waitcnt vmcnt(0)" ::: "memory");
        }
    }
    __syncthreads();
}
constexpr int NTHREADS = 512;
constexpr int LDS_BYTES = 147456;
constexpr int LDS_SLOT = LDS_BYTES - 16, LDS_BARW = LDS_BYTES - 32;
constexpr int CW_BAR = 4096;

DI int next_unit(unsigned* ctr, LAS unsigned char* lds) {
    LAS int* slot = (LAS int*)(lds + LDS_SLOT);
    __syncthreads();
    if (threadIdx.x == 0) *slot = (int)atomicAdd(ctr, 1u);
    __syncthreads();
    return *slot;
}

DI void phase_proj(const Params& p, LAS unsigned char* lds) {
    pg8::Gemm g{(const bf16_t*)(p.ws + WS_XN), (const bf16_t*)(p.ws + WS_WIN), MROWS, INW_PAD, DM};
    pg8::StaticOrder S; S.init(MROWS, INW_PAD, gridDim.x, blockIdx.x);
    epi::EpiProj E{p.out, p.ws, p.a_log, p.dt_bias};
    pg8::gemm_phase<epi::EpiProj, pg8::StaticOrder, true, true>(lds, g, S, E);
}
DI void phase_prep(const Params& p, LAS unsigned char* lds, int rep = 0) {
    unsigned* ctr = (unsigned*)(p.ws + WS_CTL) + 64 + 256 * rep;
    constexpr int NU = cmp::NUNIT + NBP * GH * NCHUNK;
    for (;;) {
        const int u = next_unit(ctr, lds); if (u >= NU) break;
        Params q = p; asm volatile("" : "+s"(q.ws), "+s"(q.out));
        if (u < cmp::NUNIT) { const int v = cmp::NUNIT - 1 - u; cmp::unit(q, lds, v); }
        else { const int v = u - cmp::NUNIT; gdn::prep_unit(q, lds, v >> 9, (v >> 7) & 3, v & 127); }
    }
}
DI void phase_mix(const Params& p, LAS unsigned char* lds, int rep = 0) {
    unsigned* ctr = (unsigned*)(p.ws + WS_CTL) + 128 + 256 * rep;
    constexpr int NU = 32 + 64 + 128 + 512;
    for (;;) {
        const int u = next_unit(ctr, lds); if (u >= NU) break;
        Params q = p; asm volatile("" : "+s"(q.ws), "+s"(q.out));
        if (u < 32) gdn::scan_unit(q, lds, u >> 4, (u >> 2) & 3, u & 3);
        else if (u < 96) { const int v = u - 32; samp::attn_unit(q, lds, v >> 1, v & 1); }
        else if (u < 224) { const int v = u - 96; samp::gdn_unit(q, lds, v >> 2, v & 3); }
        else { const int v = u - 224; attn::unit(q, lds, (v >> 1) & 1, v & 1, 127 - (v >> 2)); }
    }
}
DI void phase_out(const Params& p, LAS unsigned char* lds) {
    pg8::Gemm g{(const bf16_t*)(p.ws + WS_MIX), (const bf16_t*)(p.ws + WS_WOUT), MROWS, DM, DM};
    pg8::StaticOrder S; S.init(MROWS, DM, gridDim.x, blockIdx.x);
    epi::EpiOut E{p.x_prompt, p.x_sample, p.ws};
    pg8::gemm_phase<epi::EpiOut, pg8::StaticOrder, true, true>(lds, g, S, E);
}
DI void phase_up(const Params& p, LAS unsigned char* lds) {
    pg8::Gemm g{(const bf16_t*)(p.ws + WS_HPB), (const bf16_t*)(p.ws + WS_WGU), MROWS, 2 * DFF, DM};
    pg8::StaticOrder S; S.init(MROWS, 2 * DFF, gridDim.x, blockIdx.x);
    epi::EpiUp E{p.ws};
    pg8::gemm_phase<epi::EpiUp, pg8::StaticOrder, true, true>(lds, g, S, E);
}
DI void phase_down(const Params& p, LAS unsigned char* lds) {
    pg8::Gemm g{(const bf16_t*)(p.ws + WS_HID), (const bf16_t*)(p.ws + WS_WDN), MROWS, DM, DFF};
    pg8::StaticOrder S; S.init(MROWS, DM, gridDim.x, blockIdx.x);
    epi::EpiDown E{p.ws};
    pg8::gemm_phase<epi::EpiDown, pg8::StaticOrder, true, true>(lds, g, S, E);
}
DI void phase_final(const Params& p) {
    int tid_ = threadIdx.x; asm volatile("" : "+v"(tid_)); const int tid = tid_, lane = tid & 63, gw = blockIdx.x * 8 + (tid >> 6), NGW = gridDim.x * 8;
    for (int row = gw; row < MP + NBS; row += NGW) {
        const float* hr = (const float*)(p.ws + WS_HP) + (size_t)row * DM;
        float* o = row < MP ? p.out + O_YP + (size_t)row * DM : p.out + O_YS + (size_t)(row - MP) * DM;
        f32x4 v[4]; float s = 0.f;
#pragma unroll
        for (int j = 0; j < 4; ++j) { v[j] = *(const f32x4*)(hr + (j * 64 + lane) * 4); s += v[j][0] * v[j][0] + v[j][1] * v[j][1] + v[j][2] * v[j][2] + v[j][3] * v[j][3]; }
        const float rs = rsqrtf(wave_sum(s) * (1.f / DM) + EPS);
#pragma unroll
        for (int j = 0; j < 4; ++j) { const f32x4 g = *(const f32x4*)(p.norm_final + (j * 64 + lane) * 4); *(f32x4*)(o + (j * 64 + lane) * 4) = (f32x4){v[j][0] * rs * g[0], v[j][1] * rs * g[1], v[j][2] * rs * g[2], v[j][3] * rs * g[3]}; }
    }
}

#define LDS_DECL extern __shared__ __attribute__((aligned(16))) unsigned char lds_raw[]; LAS unsigned char* lds = (LAS unsigned char*)lds_raw
#ifndef MK_MULTI
#define MK_MULTI 0
#endif
#ifndef MK_PROBE
#define MK_PROBE 0
#endif
#ifndef MK_DUP
#define MK_DUP 0
#endif
#if MK_MULTI
__global__ void __launch_bounds__(NTHREADS, 2) k_p0(Params p) { p0::run(p); }
__global__ void __launch_bounds__(NTHREADS, 2) k_p1(Params p) { LDS_DECL; phase_proj(p, lds); }
__global__ void __launch_bounds__(NTHREADS, 2) k_p2(Params p) { LDS_DECL; phase_prep(p, lds); }
__global__ void __launch_bounds__(NTHREADS, 2) k_p3(Params p) { LDS_DECL; phase_mix(p, lds); }
__global__ void __launch_bounds__(NTHREADS, 2) k_p4(Params p) { gdn::post(p); }
__global__ void __launch_bounds__(NTHREADS, 2) k_p5(Params p) { LDS_DECL; phase_out(p, lds); }
__global__ void __launch_bounds__(NTHREADS, 2) k_p6(Params p) { LDS_DECL; phase_up(p, lds); }
__global__ void __launch_bounds__(NTHREADS, 2) k_p7(Params p) { LDS_DECL; phase_down(p, lds); }
__global__ void __launch_bounds__(NTHREADS, 2) k_p8(Params p) { phase_final(p); }
#else
__global__ void __launch_bounds__(NTHREADS, 2) k_mega(Params p) {
    LDS_DECL;
    cg::grid_group grid = cg::this_grid();
    if (threadIdx.x < 2) ((LAS unsigned*)(lds + LDS_BARW))[threadIdx.x] = 0u;
    __syncthreads();
    const XcdBarrier xbar = xcd_barrier_post((unsigned*)(p.ws + WS_CTL) + CW_BAR, (volatile LAS unsigned*)(lds + LDS_BARW));
#define SEAM() xcd_barrier(xbar)
#define PHASE(call) do { Params q = p; asm volatile("" : "+s"(q.ws), "+s"(q.out)); call; } while (0)
#if MK_PROBE
    unsigned long long* ts = (unsigned long long*)(p.ws + WS_CTL) + 1024;
#define STAMP(k) do { if (blockIdx.x == 0 && threadIdx.x == 0) ts[k] = __builtin_amdgcn_s_memrealtime(); } while (0)
#else
#define STAMP(k) do { } while (0)
#endif
    STAMP(0);
    PHASE(p0::run(q));            grid.sync(); STAMP(1);
#if MK_DUP & 1
    PHASE(p0::run(q));            SEAM();
#endif
    PHASE(phase_proj(q, lds));    SEAM();      STAMP(2);
    PHASE(phase_prep(q, lds));    SEAM();      STAMP(3);
#if MK_DUP & 2
    PHASE(phase_prep(q, lds, 1)); SEAM();
#endif
    PHASE(phase_mix(q, lds));     SEAM();      STAMP(4);
#if MK_DUP & 4
    PHASE(phase_mix(q, lds, 1));  SEAM();
#endif
#if MK_DUP & 8
    SEAM(); SEAM(); SEAM(); SEAM(); SEAM(); SEAM(); SEAM(); SEAM();
#endif
    PHASE(gdn::post(q));          SEAM();      STAMP(5);
    PHASE(phase_out(q, lds));     SEAM();      STAMP(6);
    PHASE(phase_up(q, lds));      SEAM();      STAMP(7);
    PHASE(phase_down(q, lds));    SEAM();      STAMP(8);
    PHASE(phase_final(q));
#if MK_PROBE
    grid.sync(); STAMP(9);
    if (blockIdx.x == 0) {
        __syncthreads();
        const size_t offs[10] = {O_YP, O_YS, O_KVP, O_WINP, O_SP, O_CONVP, O_KVS, O_WINS, O_SS, O_CONVS};
        for (int k = 0; k < 10; ++k) {
            const unsigned long long t0 = k < 9 ? ts[k] : ts[0], t1 = k < 9 ? ts[k + 1] : ts[9];
            int n = (int)((t1 - t0) / 10ull); if (k == 9) n = (int)((t1 - t0) / 100ull);
            if (n > 9000) n = 9000; if (n < 1) n = 1;
            unsigned* o = (unsigned*)(p.out + offs[k]);
            for (int i = threadIdx.x; i < n; i += NTHREADS) o[i] = 0xAAAAAAAAu;
        }
    }
#endif
}
#endif

extern "C" void kernel_launch(void* const* d_in, const int* in_sizes, int n_in, void* d_out, int out_size, void* d_ws, size_t ws_size, hipStream_t stream) {
    static int grid = 0;
    if (grid == 0) {
        if (n_in != 20 || out_size != (int)O_END || ws_size < WS_END) { fprintf(stderr, "kernel_launch: unexpected shapes n_in %d out %d ws %zu\n", n_in, out_size, ws_size); grid = -1; return; }
        int dev = 0, cus = 0;
        (void)hipGetDevice(&dev); (void)hipDeviceGetAttribute(&cus, hipDeviceAttributeMultiprocessorCount, dev);
#if MK_MULTI
        const void* ks[] = {(const void*)k_p1, (const void*)k_p2, (const void*)k_p3, (const void*)k_p5, (const void*)k_p6, (const void*)k_p7};
        for (auto k : ks) (void)hipFuncSetAttribute(k, hipFuncAttributeMaxDynamicSharedMemorySize, LDS_BYTES);
        grid = cus > 0 ? cus : 256;
#else
        (void)hipFuncSetAttribute((const void*)k_mega, hipFuncAttributeMaxDynamicSharedMemorySize, LDS_BYTES);
        int per_cu = 0;
        if (hipOccupancyMaxActiveBlocksPerMultiprocessor(&per_cu, (const void*)k_mega, NTHREADS, LDS_BYTES) != hipSuccess || per_cu < 1) { fprintf(stderr, "kernel_launch: occupancy query failed (%d)\n", per_cu); (void)hipGetLastError(); per_cu = 1; }
        if (per_cu > 1) per_cu = 1;
        grid = (cus > 0 ? cus : 256) * per_cu;
#endif
    }
    if (grid < 0) return;
    Params p{};
    p.x_prompt = (const float*)d_in[0]; p.x_sample = (const float*)d_in[1]; p.cache_kv = (const float*)d_in[2]; p.cache_win = (const float*)d_in[3];
    p.state_S = (const float*)d_in[4]; p.state_conv = (const float*)d_in[5]; p.page_table = (const int*)d_in[6]; p.norm_mix = (const float*)d_in[7];
    p.w_in = (const float*)d_in[8]; p.cmp_pe = (const float*)d_in[9]; p.cmp_w = (const float*)d_in[10]; p.conv_w = (const float*)d_in[11];
    p.a_log = (const float*)d_in[12]; p.dt_bias = (const float*)d_in[13]; p.gdn_norm = (const float*)d_in[14]; p.w_out = (const float*)d_in[15];
    p.norm_ffn = (const float*)d_in[16]; p.w_gate_up = (const float*)d_in[17]; p.w_down = (const float*)d_in[18]; p.norm_final = (const float*)d_in[19];
    p.out = (float*)d_out; p.ws = (unsigned char*)d_ws;
    (void)hipMemsetAsync((char*)d_ws + WS_CTL, 0, WS_ZERO_BYTES, stream);
#if MK_MULTI
    hipLaunchKernelGGL(k_p0, dim3(grid), dim3(NTHREADS), 0, stream, p);
    hipLaunchKernelGGL(k_p1, dim3(grid), dim3(NTHREADS), LDS_BYTES, stream, p);
    hipLaunchKernelGGL(k_p2, dim3(grid), dim3(NTHREADS), LDS_BYTES, stream, p);
    hipLaunchKernelGGL(k_p3, dim3(grid), dim3(NTHREADS), LDS_BYTES, stream, p);
    hipLaunchKernelGGL(k_p4, dim3(grid), dim3(NTHREADS), 0, stream, p);
    hipLaunchKernelGGL(k_p5, dim3(grid), dim3(NTHREADS), LDS_BYTES, stream, p);
    hipLaunchKernelGGL(k_p6, dim3(grid), dim3(NTHREADS), LDS_BYTES, stream, p);
    hipLaunchKernelGGL(k_p7, dim3(grid), dim3(NTHREADS), LDS_BYTES, stream, p);
    hipLaunchKernelGGL(k_p8, dim3(grid), dim3(NTHREADS), 0, stream, p);
#else
    void* args[] = {&p};
    hipError_t e = hipLaunchCooperativeKernel((const void*)k_mega, dim3(grid), dim3(NTHREADS), args, LDS_BYTES, stream);
    if (e != hipSuccess) fprintf(stderr, "kernel_launch: cooperative launch failed: %s (grid %d)\n", hipGetErrorString(e), grid);
#endif
}
```

```cpp
#include <hip/hip_runtime.h>
#include <hip/hip_cooperative_groups.h>
#include <cstdio>
#include <cstdint>
namespace cg = cooperative_groups;

#define DI __device__ __forceinline__
#define LAS __attribute__((address_space(3)))
typedef unsigned short bf16_t;
typedef short bf16x8 __attribute__((ext_vector_type(8)));
typedef short s16x4 __attribute__((ext_vector_type(4)));
typedef float f32x4 __attribute__((ext_vector_type(4)));
typedef float f32x2 __attribute__((ext_vector_type(2)));
typedef float f32x16 __attribute__((ext_vector_type(16)));
typedef unsigned u32x4 __attribute__((ext_vector_type(4)));
typedef unsigned u32x2 __attribute__((ext_vector_type(2)));
typedef __bf16 bf16x2_t __attribute__((ext_vector_type(2)));

constexpr int DM = 1024, TP = 8192, NBP = 2, MP = NBP * TP, NBS = 32, MROWS = 16640  ;
constexpr int HD = 64, NQH = 8, NG = 2, NREP = 4;
constexpr int NPAGES = 64, PAGE = 128, NPOOL = 2560;
constexpr int GH = 4, GDK = 128, GDV = 128, CCH = 1536, NCHUNK = 128;
constexpr int INW = 3360, INW_PAD = 3584, DFF = 2816;
constexpr int NCMP = 511;
constexpr float EPS = 1e-6f, LOG2E = 1.4426950408889634f, QSCALE = 0.125f * LOG2E, NEGBIG = -1e30f;

constexpr size_t O_YP = 0, O_YS = 16777216, O_KVP = 16809984, O_WINP = 25198592, O_SP = 25460736, O_CONVP = 25591808,
                 O_KVS = 25601024, O_WINS = 25617408, O_SS = 29811712, O_CONVS = 31908864, O_END = 32056320;

constexpr size_t MiB = 1u << 20;
constexpr size_t WS_CTL = 0;
constexpr size_t WS_SSQ1 = 1 * MiB, WS_SSQ2 = WS_SSQ1 + 128 * 1024;
constexpr size_t WS_ZERO_BYTES = 2 * MiB;
constexpr size_t WS_WIN = 2 * MiB;
constexpr size_t WS_WOUT = 10 * MiB;
constexpr size_t WS_WGU = 12 * MiB;
constexpr size_t WS_WDN = 24 * MiB;
constexpr size_t WS_WCMP = 30 * MiB;
constexpr size_t WS_CST = 31 * MiB;
constexpr size_t WS_ROPE = 32 * MiB;
constexpr size_t WS_XN = 36 * MiB;
constexpr size_t WS_QB = 70 * MiB;
constexpr size_t WS_KC = 88 * MiB, WS_VC = 93 * MiB;
constexpr size_t WS_KSEL = 98 * MiB, WS_VSELT = 103 * MiB;
constexpr size_t WS_KWIN = 108 * MiB, WS_VWINT = 113 * MiB;
constexpr size_t WS_CI = 118 * MiB;
constexpr size_t WS_Z = 168 * MiB;
constexpr size_t WS_GT = 186 * MiB;
constexpr size_t WS_CKP = 190 * MiB, WS_CVTP = 191 * MiB;
constexpr size_t WS_CKS = 192 * MiB, WS_CVS = 200 * MiB;
constexpr size_t WS_MIX = 208 * MiB;
constexpr size_t WS_HP = 242 * MiB;
constexpr size_t WS_HPB = 308 * MiB;
constexpr size_t WS_HID = 342 * MiB;
constexpr size_t WS_GW = 432 * MiB;
constexpr size_t WS_GQG = 448 * MiB;
constexpr size_t WS_GKGT = 464 * MiB;
constexpr size_t WS_GAQK = 480 * MiB;
constexpr size_t WS_GU = 488 * MiB;
constexpr size_t WS_GGL = 520 * MiB;
constexpr size_t WS_OG = 521 * MiB;
constexpr size_t WS_END = 560 * MiB;
constexpr int CW_Q3 = 64;

struct Params {
    const float *x_prompt, *x_sample, *cache_kv, *cache_win, *state_S, *state_conv;
    const int* page_table;
    const float *norm_mix, *w_in, *cmp_pe, *cmp_w, *conv_w, *a_log, *dt_bias, *gdn_norm, *w_out, *norm_ffn, *w_gate_up, *w_down, *norm_final;
    float* out;
    unsigned char* ws;
};

DI unsigned pk2(float lo, float hi) { f32x2 v = {lo, hi}; bf16x2_t b = __builtin_convertvector(v, bf16x2_t); return __builtin_bit_cast(unsigned, b); }
DI bf16_t f2bf(float f) { return (bf16_t)(pk2(f, 0.f) & 0xffffu); }
DI float bf2f(bf16_t h) { return __uint_as_float(((unsigned)h) << 16); }
DI float sigmoidf_(float x) { return 1.f / (1.f + __expf(-x)); }
DI float siluf_(float x) { return x / (1.f + __expf(-x)); }
DI float wave_sum(float v) {
#pragma unroll
    for (int o = 1; o < 64; o <<= 1) v += __shfl_xor(v, o);
    return v;
}
#define MFMA32(a, b, c) __builtin_amdgcn_mfma_f32_32x32x16_bf16((a), (b), (c), 0, 0, 0)
DI int crow(int r, int hi) { return (r & 3) + 8 * (r >> 2) + 4 * hi; }
#define LDS_FADD(ptr, v) (void)__hip_atomic_fetch_add((ptr), (v), __ATOMIC_RELAXED, __HIP_MEMORY_SCOPE_WORKGROUP)
namespace pg8 {
#define PG8_LAS __attribute__((address_space(3)))
typedef ::bf16_t bf16_t;
typedef ::bf16x8 bf16x8;
typedef ::f32x4 f32x4;
typedef ::u32x4 u32x4;
constexpr int BM = 256, BK = 64, HALF = 128, HTB = HALF * BK * 2  , STAGE_BYTES = 8 * HTB, NXCD = 8, WGM = 8;

__host__ __device__ __forceinline__ int lds_byte(int r, int c) { const int st = (r >> 4) * 2 + (c >> 5), rr = r & 15, cc = c & 31, ob = rr * 64 + cc * 2; return st * 1024 + (ob ^ (((ob >> 9) & 1) << 5)); }
__host__ __device__ __forceinline__ void stage_rc(int b, int& R, int& C) { const int st = b / 1024, sb = b % 1024, swz = sb ^ (((sb >> 9) & 1) << 5); R = (st >> 1) * 16 + swz / 64; C = (st & 1) * 32 + (swz % 64) / 2; }
__host__ __device__ __forceinline__ int perm32(int rho) { const int n = rho >> 4, i = rho & 15; return 8 * (i >> 2) + 4 * n + (i & 3); }

struct Unit { int pm, pn; };
struct Gemm { const bf16_t* A; const bf16_t* Bt; int M, N, K; };

struct StaticOrder {
    int nM, nN, nwg, G, c;
    __host__ __device__ void init(int M, int N, int G_, int c_) { nM = M / BM; nN = N / BM; nwg = nM * nN; G = G_; c = c_; }
    __host__ __device__ bool next(int i, Unit& u) const {
        const long L = (long)i * G + c; if (L >= nwg) return false;
        int wgid = (int)L; { const int q = nwg / NXCD, r = nwg % NXCD, xcd = wgid % NXCD, off = wgid / NXCD; wgid = (xcd < r ? xcd * (q + 1) : r * (q + 1) + (xcd - r) * q) + off; }
        const int nig = WGM * nN, gid = wgid / nig, fm = gid * WGM, gsz = (nM - fm) < WGM ? (nM - fm) : WGM;
        u.pm = fm + ((wgid % nig) % gsz); u.pn = (wgid % nig) / gsz; return true;
    }
    __device__ __forceinline__ void a_ready(const Unit&) const {}
    __device__ __forceinline__ void done(const Unit&) const {}
};


template <class Epi, class Sched, bool ALIGN_EPI = false, bool SP2 = false>
__device__ __forceinline__ void gemm_phase(PG8_LAS unsigned char* lds, const Gemm g, const Sched& S, const Epi& E) {
    int tid_ = threadIdx.x; asm volatile("" : "+v"(tid_)); const int tid = tid_, wid = __builtin_amdgcn_readfirstlane(tid >> 6), lane = tid & 63, wr = wid >> 2, wc = wid & 3, fr = lane & 15, fq = lane >> 4;
    const int K = g.K, nt = K / BK;
    unsigned voffA[2], voffB[2];
#pragma unroll
    for (int i = 0; i < 2; ++i) { int R, C; stage_rc(tid * 16 + i * 8192, R, C); const int Rb = Epi::PERM ? ((R & ~31) + perm32(R & 31)) : R;
        voffA[i] = (unsigned)(R * K + C) * 2u; voffB[i] = (unsigned)(Rb * K + C) * 2u; }
    const size_t kstep = (size_t)(BK * 2);
    const size_t hstep = (size_t)HALF * K * 2;
    const size_t tstep = 2 * hstep;
    const unsigned ldsw = (unsigned)wid * 1024u;
    const int aoff = lds_byte(wr * 64 + fr, fq * 8), boff = lds_byte(wc * 32 + fr, fq * 8);
#define PG8_SA(b, h) (((b) * 2 + (h)) * HTB)
#define PG8_SB(b, h) ((4 + (b) * 2 + (h)) * HTB)
#define PG8_STAGE(bufoff, gbase, voff) do { _Pragma("unroll") for (int _i = 0; _i < 2; ++_i) \
        __builtin_amdgcn_global_load_lds((const unsigned*)((const char*)(gbase) + (voff)[_i]), (PG8_LAS unsigned*)(lds + (bufoff) + ldsw + _i * 8192), 16, 0, 0); } while (0)
#define PG8_LDA(dst, b, h) do { _Pragma("unroll") for (int m = 0; m < 4; ++m) _Pragma("unroll") for (int k = 0; k < 2; ++k) dst[m][k] = *(const PG8_LAS bf16x8*)(lds + PG8_SA(b, h) + aoff + m * 2048 + k * 1024); } while (0)
#define PG8_LDB(dst, b, h) do { _Pragma("unroll") for (int n = 0; n < 2; ++n) _Pragma("unroll") for (int k = 0; k < 2; ++k) dst[n][k] = *(const PG8_LAS bf16x8*)(lds + PG8_SB(b, h) + boff + n * 2048 + k * 1024); } while (0)
#define PG8_MMA(ai, bj, At, Bt) do { __builtin_amdgcn_s_setprio(1); _Pragma("unroll") for (int m = 0; m < 4; ++m) _Pragma("unroll") for (int n = 0; n < 2; ++n) _Pragma("unroll") for (int k = 0; k < 2; ++k) \
        acc[ai][bj][m][n] = __builtin_amdgcn_mfma_f32_16x16x32_bf16(Bt[n][k], At[m][k], acc[ai][bj][m][n], 0, 0, 0); __builtin_amdgcn_s_setprio(0); } while (0)
#define PG8_WAIT_V(n) asm volatile("s_waitcnt vmcnt(" #n ")" ::: "memory")
#define PG8_WAIT_L(n) asm volatile("s_waitcnt lgkmcnt(" #n ")" ::: "memory")
#define PG8_BAR __builtin_amdgcn_s_barrier()
#define PG8_SCHED __builtin_amdgcn_sched_barrier(0)
    Unit cur, nxt; int ui = 0;
    if (!S.next(0, cur)) return;
    f32x4 acc[2][2][4][2];
#pragma unroll
    for (int a = 0; a < 2; ++a)
#pragma unroll
        for (int b = 0; b < 2; ++b)
#pragma unroll
            for (int m = 0; m < 4; ++m)
#pragma unroll
                for (int n = 0; n < 2; ++n) acc[a][b][m][n] = (f32x4){0.f, 0.f, 0.f, 0.f};
    bf16x8 At[4][2], B0[2][2], B1[2][2];
    const char* cA = (const char*)g.A + (size_t)cur.pm * tstep; const char* cB = (const char*)g.Bt + (size_t)cur.pn * tstep;
    S.a_ready(cur);
    if constexpr (SP2) {
        PG8_STAGE(PG8_SB(0, 0), cB, voffB); PG8_STAGE(PG8_SB(0, 1), cB + hstep, voffB); PG8_STAGE(PG8_SA(0, 0), cA, voffA); PG8_STAGE(PG8_SA(0, 1), cA + hstep, voffA);
        if (wr == 1) PG8_BAR;
        PG8_WAIT_V(2); PG8_BAR;
        PG8_STAGE(PG8_SB(1, 0), cB + kstep, voffB); PG8_STAGE(PG8_SA(1, 0), cA + kstep, voffA); PG8_STAGE(PG8_SB(1, 1), cB + hstep + kstep, voffB);
        PG8_WAIT_V(6); PG8_BAR;
    } else {
        PG8_STAGE(PG8_SB(0, 0), cB, voffB); PG8_STAGE(PG8_SA(0, 0), cA, voffA); PG8_STAGE(PG8_SB(0, 1), cB + hstep, voffB); PG8_STAGE(PG8_SA(0, 1), cA + hstep, voffA);
        if (wr == 1) PG8_BAR;
        PG8_WAIT_V(4); PG8_BAR;
        PG8_STAGE(PG8_SB(1, 0), cB + kstep, voffB); PG8_STAGE(PG8_SA(1, 0), cA + kstep, voffA); PG8_STAGE(PG8_SB(1, 1), cB + hstep + kstep, voffB);
        PG8_WAIT_V(6); PG8_BAR;
    }
    for (;;) {
        const bool has_next = S.next(ui + 1, nxt);
        const char* nA = has_next ? (const char*)g.A + (size_t)nxt.pm * tstep : cA; const char* nB = has_next ? (const char*)g.Bt + (size_t)nxt.pn * tstep : cB;
        for (int t = 0; t < nt; t += 2) {
            const bool last = (t == nt - 2);
            const char* a1 = cA + (size_t)(t + 1) * kstep;
            const char* a2 = last ? nA : cA + (size_t)(t + 2) * kstep; const char* b2 = last ? nB : cB + (size_t)(t + 2) * kstep;
            const char* a3 = a2 + kstep; const char* b3 = b2 + kstep;
            if (last && has_next) S.a_ready(nxt);
            if constexpr (SP2) {
            PG8_LDB(B0, 0, 0); PG8_LDB(B1, 0, 1); PG8_SCHED; PG8_LDA(At, 0, 0); PG8_STAGE(PG8_SA(1, 1), a1 + hstep, voffA);
            PG8_WAIT_V(8); PG8_WAIT_L(0); PG8_BAR; PG8_MMA(0, 0, At, B0); PG8_MMA(0, 1, At, B1); PG8_BAR; PG8_SCHED;
            PG8_LDA(At, 0, 1); PG8_STAGE(PG8_SB(0, 0), b2, voffB); PG8_STAGE(PG8_SB(0, 1), b2 + hstep, voffB); PG8_STAGE(PG8_SA(0, 0), a2, voffA);
            PG8_WAIT_V(8); PG8_WAIT_L(0); PG8_BAR; PG8_MMA(1, 0, At, B0); PG8_MMA(1, 1, At, B1); PG8_BAR; PG8_SCHED;
            PG8_LDB(B0, 1, 0); PG8_LDB(B1, 1, 1); PG8_SCHED; PG8_LDA(At, 1, 0); PG8_STAGE(PG8_SA(0, 1), a2 + hstep, voffA);
            PG8_WAIT_V(8); PG8_WAIT_L(0); PG8_BAR; PG8_MMA(0, 0, At, B0); PG8_MMA(0, 1, At, B1); PG8_BAR; PG8_SCHED;
            PG8_LDA(At, 1, 1); PG8_STAGE(PG8_SB(1, 0), b3, voffB); PG8_STAGE(PG8_SB(1, 1), b3 + hstep, voffB); PG8_STAGE(PG8_SA(1, 0), a3, voffA);
            PG8_WAIT_V(8); PG8_WAIT_L(0); PG8_BAR; PG8_MMA(1, 0, At, B0); PG8_MMA(1, 1, At, B1); PG8_BAR; PG8_SCHED;
            } else {
            PG8_LDB(B0, 0, 0); PG8_SCHED; PG8_LDA(At, 0, 0); PG8_STAGE(PG8_SA(1, 1), a1 + hstep, voffA);
            PG8_WAIT_L(8); PG8_BAR; PG8_WAIT_L(0); PG8_MMA(0, 0, At, B0); PG8_BAR; PG8_SCHED;
            PG8_LDB(B1, 0, 1); PG8_STAGE(PG8_SB(0, 0), b2, voffB);
            PG8_BAR; PG8_WAIT_L(0); PG8_MMA(0, 1, At, B1); PG8_BAR;
            PG8_LDA(At, 0, 1); PG8_STAGE(PG8_SA(0, 0), a2, voffA);
            PG8_BAR; PG8_WAIT_L(0); PG8_MMA(1, 0, At, B0); PG8_BAR; PG8_SCHED;
            PG8_STAGE(PG8_SB(0, 1), b2 + hstep, voffB);
            PG8_WAIT_V(6); PG8_BAR; PG8_MMA(1, 1, At, B1); PG8_BAR;
            PG8_LDB(B0, 1, 0); PG8_SCHED; PG8_LDA(At, 1, 0); PG8_STAGE(PG8_SA(0, 1), a2 + hstep, voffA);
            PG8_WAIT_L(8); PG8_BAR; PG8_WAIT_L(0); PG8_MMA(0, 0, At, B0); PG8_BAR; PG8_SCHED;
            PG8_LDB(B1, 1, 1); PG8_STAGE(PG8_SB(1, 0), b3, voffB);
            PG8_BAR; PG8_WAIT_L(0); PG8_MMA(0, 1, At, B1); PG8_BAR;
            PG8_LDA(At, 1, 1); PG8_STAGE(PG8_SA(1, 0), a3, voffA);
            PG8_BAR; PG8_WAIT_L(0); PG8_MMA(1, 0, At, B0); PG8_BAR; PG8_SCHED;
            PG8_STAGE(PG8_SB(1, 1), b3 + hstep, voffB);
            PG8_WAIT_V(6); PG8_BAR; PG8_MMA(1, 1, At, B1); PG8_BAR;
            }
        }
        if constexpr (ALIGN_EPI) { if (wr == 0) PG8_BAR; }
        if constexpr (!Epi::AFTER_DRAIN) { E(acc, cur, wr, wc, fr, fq); S.done(cur); }
        if (!has_next) break;
#pragma unroll
        for (int a = 0; a < 2; ++a)
#pragma unroll
            for (int b = 0; b < 2; ++b)
#pragma unroll
                for (int m = 0; m < 4; ++m)
#pragma unroll
                    for (int n = 0; n < 2; ++n) acc[a][b][m][n] = (f32x4){0.f, 0.f, 0.f, 0.f};
        cur = nxt; cA = nA; cB = nB; ++ui;
        if constexpr (ALIGN_EPI) { if (wr == 1) PG8_BAR; }
    }
    PG8_WAIT_V(0);
    if constexpr (!ALIGN_EPI) { if (wr == 0) PG8_BAR; }
    PG8_BAR;
    if constexpr (Epi::AFTER_DRAIN) { E.fused(acc, cur, wr, wc, fr, fq, lds, wid, lane); S.done(cur); }
#undef PG8_SA
#undef PG8_SB
#undef PG8_STAGE
#undef PG8_LDA
#undef PG8_LDB
#undef PG8_MMA
#undef PG8_WAIT_V
#undef PG8_WAIT_L
#undef PG8_BAR
#undef PG8_SCHED
}
}
namespace epi {
using pg8::Unit;
#define EPI_V8(ai, bj, m) const float v[8] = {acc[ai][bj][m][0][0], acc[ai][bj][m][0][1], acc[ai][bj][m][0][2], acc[ai][bj][m][0][3], acc[ai][bj][m][1][0], acc[ai][bj][m][1][1], acc[ai][bj][m][1][2], acc[ai][bj][m][1][3]}
DI void st_bf16x8(bf16_t* p, const float* v) { u32x4 w; w.x = pk2(v[0], v[1]); w.y = pk2(v[2], v[3]); w.z = pk2(v[4], v[5]); w.w = pk2(v[6], v[7]); *(u32x4*)p = w; }
DI void st_bf16x4(bf16_t* p, float a, float b, float c, float d) { u32x2 w; w.x = pk2(a, b); w.y = pk2(c, d); *(u32x2*)p = w; }
DI void st_f32x4(float* p, float a, float b, float c, float d) { *(f32x4*)p = (f32x4){a, b, c, d}; }

struct EpiProj {
    static constexpr bool PERM = true, AFTER_DRAIN = false;
    float* out; unsigned char* ws; const float* a_log; const float* dt_bias;
    DI void operator()(const f32x4 (&acc)[2][2][4][2], const Unit& u, int wr, int wc, int fr, int fq) const {
        const int pn = u.pn;
        const float* cosT = (const float*)(ws + WS_ROPE); const float* sinT = cosT + 8193 * 32;
#pragma unroll
        for (int ai = 0; ai < 2; ++ai)
#pragma unroll
            for (int m = 0; m < 4; ++m) {
                const int row = u.pm * 256 + ai * 128 + wr * 64 + m * 16 + fr;
                if (row >= MP + NBS) continue;
                const bool samp = row >= MP; const int b = row >> 13, t = row & (TP - 1), bs = row - MP;
                const int pos = samp ? TP : t;
#pragma unroll
                for (int bj = 0; bj < 2; ++bj) {
                    EPI_V8(ai, bj, m);
                    const int cw = bj * 128 + wc * 32 + fq * 8;
                    if (pn < 2) {
                        const int head = (pn * 256 + cw) >> 6, i0 = (cw & 63) >> 1;
                        const f32x4 c4 = *(const f32x4*)(cosT + pos * 32 + i0), s4 = *(const f32x4*)(sinT + pos * 32 + i0);
                        float o1[4], o2[4];
#pragma unroll
                        for (int q = 0; q < 4; ++q) { const float x1 = v[2 * q], x2 = v[2 * q + 1]; o1[q] = (x1 * c4[q] - x2 * s4[q]) * QSCALE; o2[q] = (x2 * c4[q] + x1 * s4[q]) * QSCALE; }
                        bf16_t* qb = (bf16_t*)(ws + WS_QB) + (size_t)row * 512 + head * 64 + i0;
                        st_bf16x4(qb, o1[0], o1[1], o1[2], o1[3]); st_bf16x4(qb + 32, o2[0], o2[1], o2[2], o2[3]);
                    } else if (pn < 5) {
                        const int br = pn - 2, g = wc >> 1, cc = (wc & 1) * 32 + fq * 8;
                        float* dst;
                        if (!samp) dst = (br < 2) ? out + O_KVP + ((size_t)(b * TP + t) * 4 + 2 * br + bj) * 128 + g * 64
                                                  : (t >= TP - 512 ? out + O_WINP + ((size_t)(b * 512 + t - (TP - 512)) * 2 + bj) * 128 + g * 64 : nullptr);
                        else dst = (br < 2) ? out + O_KVS + ((size_t)bs * 4 + 2 * br + bj) * 128 + g * 64 : out + O_WINS + ((size_t)(bs * 512 + 511) * 2 + bj) * 128 + g * 64;
                        const size_t hb = ((size_t)(b * 2 + g) * TP + t) * 64;
                        if (bj == 0) {
                            const int i0 = cc >> 1;
                            const f32x4 c4 = *(const f32x4*)(cosT + pos * 32 + i0), s4 = *(const f32x4*)(sinT + pos * 32 + i0);
                            float o1[4], o2[4];
#pragma unroll
                            for (int q = 0; q < 4; ++q) { const float x1 = v[2 * q], x2 = v[2 * q + 1]; o1[q] = x1 * c4[q] - x2 * s4[q]; o2[q] = x2 * c4[q] + x1 * s4[q]; }
                            if (dst) { st_f32x4(dst + i0, o1[0], o1[1], o1[2], o1[3]); st_f32x4(dst + 32 + i0, o2[0], o2[1], o2[2], o2[3]); }
                            if (!samp) { bf16_t* kb = (bf16_t*)(ws + (br == 0 ? WS_KC : br == 1 ? WS_KSEL : WS_KWIN)) + hb + i0;
                                st_bf16x4(kb, o1[0], o1[1], o1[2], o1[3]); st_bf16x4(kb + 32, o2[0], o2[1], o2[2], o2[3]); }
                        } else {
                            if (dst) { st_f32x4(dst + cc, v[0], v[1], v[2], v[3]); st_f32x4(dst + cc + 4, v[4], v[5], v[6], v[7]); }
                            if (!samp) {
                                if (br == 0) st_bf16x8((bf16_t*)(ws + WS_VC) + hb + cc, v);
                                else { bf16_t* vt = (bf16_t*)(ws + (br == 1 ? WS_VSELT : WS_VWINT)) + ((size_t)(b * 2 + g) * 64 + cc) * TP + t;
#pragma unroll
                                    for (int j = 0; j < 8; ++j) vt[(size_t)j * TP] = f2bf(v[j]); }
                            }
                        }
                    } else if (pn < 11) {
                        const int ch0 = (pn - 5) * 256 + cw;
                        st_bf16x8((bf16_t*)(ws + WS_CI) + (size_t)row * CCH + ch0, v);
                        float* dst = nullptr;
                        if (!samp) { if (t >= TP - 3) dst = out + O_CONVP + (size_t)(b * 3 + t - (TP - 3)) * CCH + ch0; }
                        else dst = out + O_CONVS + (size_t)(bs * 3 + 2) * CCH + ch0;
                        if (dst) { st_f32x4(dst, v[0], v[1], v[2], v[3]); st_f32x4(dst + 4, v[4], v[5], v[6], v[7]); }
                    } else if (pn < 13) {
                        st_bf16x8((bf16_t*)(ws + WS_Z) + (size_t)row * 512 + (pn - 11) * 256 + cw, v);
                    } else {
                        if (bj == 0 && wc == 0) {
                            float o[8];
                            if (fq < 3) {
#pragma unroll
                                for (int j = 0; j < 8; ++j) o[j] = sigmoidf_(v[j]);
                            } else {
#pragma unroll
                                for (int j = 0; j < 4; ++j) { const float xx = v[j] + dt_bias[j]; const float sp = fmaxf(xx, 0.f) + log1pf(__expf(-fabsf(xx))); o[j] = -__expf(a_log[j]) * sp; }
#pragma unroll
                                for (int j = 4; j < 8; ++j) o[j] = sigmoidf_(v[j]);
                            }
                            float* gt = (float*)(ws + WS_GT) + (size_t)row * 32 + fq * 8;
                            st_f32x4(gt, o[0], o[1], o[2], o[3]); st_f32x4(gt + 4, o[4], o[5], o[6], o[7]);
                        }
                    }
                }
            }
    }
};

struct EpiOut {
    static constexpr bool PERM = true, AFTER_DRAIN = false;
    const float* xp; const float* xs; unsigned char* ws;
    DI void operator()(const f32x4 (&acc)[2][2][4][2], const Unit& u, int wr, int wc, int fr, int fq) const {
        float* hp = (float*)(ws + WS_HP); bf16_t* hpb = (bf16_t*)(ws + WS_HPB); float* ssq = (float*)(ws + WS_SSQ1);
#pragma unroll
        for (int ai = 0; ai < 2; ++ai)
#pragma unroll
            for (int m = 0; m < 4; ++m) {
                const int row = u.pm * 256 + ai * 128 + wr * 64 + m * 16 + fr;
                const float* xr = row < MP ? xp + (size_t)row * DM : (row < MP + NBS ? xs + (size_t)(row - MP) * DM : nullptr);
                float sq = 0.f;
#pragma unroll
                for (int bj = 0; bj < 2; ++bj) {
                    EPI_V8(ai, bj, m);
                    const int col = u.pn * 256 + bj * 128 + wc * 32 + fq * 8;
                    float h[8];
                    if (xr) { const f32x4 x0 = *(const f32x4*)(xr + col), x1 = *(const f32x4*)(xr + col + 4);
#pragma unroll
                        for (int j = 0; j < 4; ++j) { h[j] = x0[j] + v[j]; h[4 + j] = x1[j] + v[4 + j]; } }
                    else {
#pragma unroll
                        for (int j = 0; j < 8; ++j) h[j] = 0.f; }
#pragma unroll
                    for (int j = 0; j < 8; ++j) sq += h[j] * h[j];
                    st_f32x4(hp + (size_t)row * DM + col, h[0], h[1], h[2], h[3]); st_f32x4(hp + (size_t)row * DM + col + 4, h[4], h[5], h[6], h[7]);
                    st_bf16x8(hpb + (size_t)row * DM + col, h);
                }
                sq += __shfl_xor(sq, 16); sq += __shfl_xor(sq, 32);
                if (fq == 0) atomicAdd(ssq + row, sq);
            }
    }
};

struct EpiUp {
    static constexpr bool PERM = true, AFTER_DRAIN = false;
    unsigned char* ws;
    DI void operator()(const f32x4 (&acc)[2][2][4][2], const Unit& u, int wr, int wc, int fr, int fq) const {
        const float* ssq = (const float*)(ws + WS_SSQ1); bf16_t* hid = (bf16_t*)(ws + WS_HID);
#pragma unroll
        for (int ai = 0; ai < 2; ++ai)
#pragma unroll
            for (int m = 0; m < 4; ++m) {
                const int row = u.pm * 256 + ai * 128 + wr * 64 + m * 16 + fr;
                const float rs = rsqrtf(ssq[row] * (1.f / DM) + EPS);
#pragma unroll
                for (int bj = 0; bj < 2; ++bj) {
                    EPI_V8(ai, bj, m);
                    const int j0 = (u.pn * 256 + bj * 128 + wc * 32 + fq * 8) >> 1;
                    float h[4];
#pragma unroll
                    for (int q = 0; q < 4; ++q) { const float gte = v[2 * q] * rs, up = v[2 * q + 1] * rs; h[q] = siluf_(gte) * up; }
                    st_bf16x4(hid + (size_t)row * DFF + j0, h[0], h[1], h[2], h[3]);
                }
            }
    }
};

struct EpiDown {
    static constexpr bool PERM = true, AFTER_DRAIN = false;
    unsigned char* ws;
    DI void operator()(const f32x4 (&acc)[2][2][4][2], const Unit& u, int wr, int wc, int fr, int fq) const {
        float* hp = (float*)(ws + WS_HP); float* ssq = (float*)(ws + WS_SSQ2);
#pragma unroll
        for (int ai = 0; ai < 2; ++ai)
#pragma unroll
            for (int m = 0; m < 4; ++m) {
                const int row = u.pm * 256 + ai * 128 + wr * 64 + m * 16 + fr;
                float sq = 0.f;
#pragma unroll
                for (int bj = 0; bj < 2; ++bj) {
                    EPI_V8(ai, bj, m);
                    float* hr = hp + (size_t)row * DM + u.pn * 256 + bj * 128 + wc * 32 + fq * 8;
                    const f32x4 x0 = *(const f32x4*)hr, x1 = *(const f32x4*)(hr + 4);
                    float h[8];
#pragma unroll
                    for (int j = 0; j < 4; ++j) { h[j] = x0[j] + v[j]; h[4 + j] = x1[j] + v[4 + j]; }
#pragma unroll
                    for (int j = 0; j < 8; ++j) sq += h[j] * h[j];
                    st_f32x4(hr, h[0], h[1], h[2], h[3]); st_f32x4(hr + 4, h[4], h[5], h[6], h[7]);
                }
                (void)sq; (void)ssq;
            }
    }
};
}
namespace p0 {
DI int perm_in(int n) {
    if (n < 512) { const int cc = n & 63; return (n & ~63) + ((cc & 1) ? (cc >> 1) + 32 : (cc >> 1)); }
    if (n < 1280) { const int m = n - 512, grp = m >> 6, cc = m & 63, br = grp >> 2, kvi = (grp >> 1) & 1, g = grp & 1;
        const int d = kvi == 0 ? ((cc & 1) ? (cc >> 1) + 32 : (cc >> 1)) : cc; return 512 + br * 256 + kvi * 128 + g * 64 + d; }
    if (n < 2816) return 1304 + (n - 1280);
    if (n < 3328) return 2840 + (n - 2816);
    if (n < 3352) return 1280 + (n - 3328);
    if (n < 3360) return n;
    return -1;
}
template <int MODE> DI void wt_item(const float* W, int Nsrc, bf16_t* WT, int Kdst, int n0, int k0, const float* kscale, int lane) {
    const int n = n0 + lane;
    int src;
    if (MODE == 0) src = perm_in(n);
    else if (MODE == 1) src = n;
    else src = (n & 1) ? DFF + (n >> 1) : (n >> 1);
#pragma unroll 2
    for (int kk = 0; kk < 64; kk += 8) {
        float v[8];
#pragma unroll
        for (int i = 0; i < 8; ++i) { const int k = k0 + kk + i; float x = src >= 0 ? W[(size_t)k * Nsrc + src] : 0.f; if (kscale) x *= kscale[k]; v[i] = x; }
        epi::st_bf16x8(WT + (size_t)n * Kdst + k0 + kk, v);
    }
}
DI void run(const Params& p) {
    int tid_ = threadIdx.x; asm volatile("" : "+v"(tid_)); const int tid = tid_, lane = tid & 63, wave = tid >> 6;
    const int gw = blockIdx.x * 8 + wave, NGW = gridDim.x * 8;
    const int gt = blockIdx.x * 512 + tid, NGT = gridDim.x * 512;
    unsigned char* ws = p.ws;
    constexpr int I_IN = (INW_PAD / 64) * (DM / 64), I_OUT = (DM / 64) * (DM / 64), I_GU = (2 * DFF / 64) * (DM / 64), I_DN = (DM / 64) * (DFF / 64);
    constexpr int NIT = I_IN + I_OUT + I_GU + I_DN;
    for (int it = gw; it < NIT; it += NGW) {
        int r = it;
        if (r < I_IN) { wt_item<0>(p.w_in, INW, (bf16_t*)(ws + WS_WIN), DM, (r / 16) * 64, (r % 16) * 64, nullptr, lane); continue; } r -= I_IN;
        if (r < I_OUT) { wt_item<1>(p.w_out, DM, (bf16_t*)(ws + WS_WOUT), DM, (r / 16) * 64, (r % 16) * 64, nullptr, lane); continue; } r -= I_OUT;
        if (r < I_GU) { wt_item<2>(p.w_gate_up, 2 * DFF, (bf16_t*)(ws + WS_WGU), DM, (r / 16) * 64, (r % 16) * 64, p.norm_ffn, lane); continue; } r -= I_GU;
        wt_item<1>(p.w_down, DM, (bf16_t*)(ws + WS_WDN), DFF, (r / 44) * 64, (r % 44) * 64, nullptr, lane);
    }
    for (int i = gt; i < 2 * 128 * 2 * 64; i += NGT) {
        const int ln = i & 63, et = (i >> 6) & 1, ks = (i >> 7) & 127, kv = i >> 14;
        const float* w = p.cmp_w + ((size_t)kv * 2048 + ks * 16 + (ln >> 5) * 8) * 64 + et * 32 + (ln & 31);
        float v[8];
#pragma unroll
        for (int j = 0; j < 8; ++j) v[j] = w[j * 64];
        epi::st_bf16x8((bf16_t*)(ws + WS_WCMP) + (size_t)i * 8, v);
    }
    for (int o = gw; o < 128; o += NGW) {
        const int kv = o >> 6, e = o & 63; float s = 0.f;
        for (int k = lane; k < 2048; k += 64) s += p.cmp_pe[kv * 2048 + k] * p.cmp_w[((size_t)kv * 2048 + k) * 64 + e];
        s = wave_sum(s);
        if (lane == 0) ((float*)(ws + WS_CST))[o] = s;
    }
    { float* cosT = (float*)(ws + WS_ROPE); float* sinT = cosT + 8193 * 32;
      for (int i = gt; i < 8193 * 32; i += NGT) { const int pos = i >> 5, j = i & 31;
          const double a = (double)pos * pow(10000.0, -(double)j / 32.0); cosT[i] = (float)cos(a); sinT[i] = (float)sin(a); } }
    for (int row = gw; row < MROWS; row += NGW) {
        bf16_t* o = (bf16_t*)(ws + WS_XN) + (size_t)row * DM;
        if (row >= MP + NBS) { for (int j = 0; j < 4; ++j) *(u32x2*)(o + (j * 64 + lane) * 4) = (u32x2){0u, 0u}; continue; }
        const float* xr = row < MP ? p.x_prompt + (size_t)row * DM : p.x_sample + (size_t)(row - MP) * DM;
        f32x4 v[4]; float s = 0.f;
#pragma unroll
        for (int j = 0; j < 4; ++j) { v[j] = *(const f32x4*)(xr + (j * 64 + lane) * 4); s += v[j][0] * v[j][0] + v[j][1] * v[j][1] + v[j][2] * v[j][2] + v[j][3] * v[j][3]; }
        const float rs = rsqrtf(wave_sum(s) * (1.f / DM) + EPS);
#pragma unroll
        for (int j = 0; j < 4; ++j) { const f32x4 g = *(const f32x4*)(p.norm_mix + (j * 64 + lane) * 4);
            epi::st_bf16x4(o + (j * 64 + lane) * 4, v[j][0] * rs * g[0], v[j][1] * rs * g[1], v[j][2] * rs * g[2], v[j][3] * rs * g[3]); }
    }
    { const f32x4* src = (const f32x4*)p.cache_win; f32x4* dst = (f32x4*)(p.out + O_WINS);
      for (int i = gt; i < NBS * 511 * 64; i += NGT) { const int bs = i / (511 * 64), r = i % (511 * 64); dst[(size_t)bs * 512 * 64 + r] = src[(size_t)bs * 512 * 64 + 64 + r]; } }
    { const f32x4* src = (const f32x4*)p.state_conv; f32x4* dst = (f32x4*)(p.out + O_CONVS);
      for (int i = gt; i < NBS * 2 * (CCH / 4); i += NGT) { const int bs = i / (2 * (CCH / 4)), r = i % (2 * (CCH / 4)); dst[(size_t)bs * 3 * (CCH / 4) + r] = src[(size_t)bs * 3 * (CCH / 4) + (CCH / 4) + r]; } }
}
}
namespace attn {
constexpr int KSTR = 72, VSTR = 68;
constexpr int KT_BYTES = 64 * KSTR * 2, VT_BYTES = 64 * VSTR * 2, TILE_BYTES = KT_BYTES + VT_BYTES;
constexpr int OFF_IMP = 36864, IMP_STR = 132;
constexpr int LDS_NEED = OFF_IMP + 8 * 8 * IMP_STR * 4;

DI void ld_tile(const bf16_t* kbase, const bf16_t* vtbase, size_t vts, u32x4& kr, u32x4& vr, int tid) {
    kr = *(const u32x4*)(kbase + (tid >> 3) * 64 + (tid & 7) * 8);
    vr = *(const u32x4*)(vtbase + (size_t)(tid >> 3) * vts + (tid & 7) * 8);
}
DI void st_tile(LAS unsigned char* buf, const u32x4& kr, const u32x4& vr, int tid) {
    *(LAS u32x4*)(buf + ((tid >> 3) * KSTR + (tid & 7) * 8) * 2) = kr;
    LAS u32x2* vp = (LAS u32x2*)(buf + KT_BYTES + ((tid >> 3) * VSTR + (tid & 7) * 8) * 2);
    vp[0] = (u32x2){vr.x, vr.y}; vp[1] = (u32x2){vr.z, vr.w};
}
DI void qk_tile(const LAS unsigned char* kb, const bf16x8 (&qf)[4], f32x16& s0, f32x16& s1, int lane) {
    const LAS unsigned char* p0 = kb + ((lane & 31) * KSTR + (lane >> 5) * 8) * 2;
    f32x16 z; for (int i = 0; i < 16; ++i) z[i] = 0.f;
    s0 = z; s1 = z;
#pragma unroll
    for (int kd = 0; kd < 4; ++kd) {
        const bf16x8 a0 = *(const LAS bf16x8*)(p0 + kd * 32), a1 = *(const LAS bf16x8*)(p0 + 32 * KSTR * 2 + kd * 32);
        s0 = MFMA32(a0, qf[kd], s0); s1 = MFMA32(a1, qf[kd], s1);
    }
}
DI bf16x8 pack8(const f32x16& p, int base) {
    u32x4 w; w.x = pk2(p[base], p[base + 1]); w.y = pk2(p[base + 2], p[base + 3]); w.z = pk2(p[base + 4], p[base + 5]); w.w = pk2(p[base + 6], p[base + 7]);
    return __builtin_bit_cast(bf16x8, w);
}
DI void pv_tile(const LAS unsigned char* vb, const f32x16& p0, const f32x16& p1, f32x16& o0, f32x16& o1, int lane) {
    const LAS unsigned char* v0 = vb + ((lane & 31) * VSTR + 4 * (lane >> 5)) * 2;
#pragma unroll
    for (int ks = 0; ks < 4; ++ks) {
        const bf16x8 pb = (ks < 2) ? pack8(p0, (ks & 1) * 8) : pack8(p1, (ks & 1) * 8);
#pragma unroll
        for (int dt = 0; dt < 2; ++dt) {
            const s16x4 lo = *(const LAS s16x4*)(v0 + (dt * 32 * VSTR + 16 * ks) * 2), hi = *(const LAS s16x4*)(v0 + (dt * 32 * VSTR + 16 * ks + 8) * 2);
            const bf16x8 a = __builtin_shufflevector(lo, hi, 0, 1, 2, 3, 4, 5, 6, 7);
            if (dt == 0) o0 = MFMA32(a, pb, o0); else o1 = MFMA32(a, pb, o1);
        }
    }
}
DI void softmax_step(f32x16& s0, f32x16& s1, float& m, float& l, f32x16& o0, f32x16& o1) {
    float mt = NEGBIG;
#pragma unroll
    for (int r = 0; r < 16; ++r) mt = fmaxf(mt, fmaxf(s0[r], s1[r]));
    mt = fmaxf(mt, __shfl_xor(mt, 32));
    const float mn = fmaxf(m, mt), alpha = __builtin_amdgcn_exp2f(m - mn);
    float sum = 0.f;
#pragma unroll
    for (int r = 0; r < 16; ++r) { s0[r] = __builtin_amdgcn_exp2f(s0[r] - mn); s1[r] = __builtin_amdgcn_exp2f(s1[r] - mn); sum += s0[r] + s1[r]; }
    l = l * alpha + sum; m = mn;
#pragma unroll
    for (int r = 0; r < 16; ++r) { o0[r] *= alpha; o1[r] *= alpha; }
}

#define ATT_TBUF(i) (lds + (i) * TILE_BYTES)
#define ATT_STREAM_BEGIN(NT, KP, VP, VTS) { u32x4 kr_, vr_; const int nt_ = (NT); \
    { const int i_ = 0; ld_tile((KP), (VP), (VTS), kr_, vr_, tid); } st_tile(ATT_TBUF(0), kr_, vr_, tid); __syncthreads(); \
    for (int it_ = 0; it_ < nt_; ++it_) { \
        if (it_ + 1 < nt_) { const int i_ = it_ + 1; ld_tile((KP), (VP), (VTS), kr_, vr_, tid); } \
        { const LAS unsigned char* tb = ATT_TBUF(it_ & 1); const int i_ = it_;
#define ATT_STREAM_END() } \
        if (it_ + 1 < nt_) st_tile(ATT_TBUF((it_ + 1) & 1), kr_, vr_, tid); \
        __syncthreads(); } }

DI void unit(const Params& p, LAS unsigned char* lds, int b, int g, int tt) {
    int tid_ = threadIdx.x; asm volatile("" : "+v"(tid_)); const int tid = tid_, lane = tid & 63, wave = __builtin_amdgcn_readfirstlane(tid >> 6), hi = lane >> 5, col = lane & 31, tokl = col & 7, r = col >> 3;
    const int t = tt * 64 + wave * 8 + tokl;
    const size_t row = (size_t)b * TP + t;
    const unsigned char* ws = p.ws;
    const size_t slab = (size_t)(b * 2 + g);
    bf16x8 qf[4];
    { const bf16_t* q = (const bf16_t*)(ws + WS_QB) + row * 512 + (g * 4 + r) * 64 + hi * 8;
#pragma unroll
      for (int kd = 0; kd < 4; ++kd) qf[kd] = *(const bf16x8*)(q + kd * 16); }
    const float* gt = (const float*)(ws + WS_GT) + row * 32 + (g * 4 + r) * 3;
    const float gate0 = gt[0], gate1 = gt[1], gate2 = gt[2];
    LAS float* imp = (LAS float*)(lds + OFF_IMP) + wave * 8 * IMP_STR;
    for (int i = lane; i < 8 * IMP_STR; i += 64) imp[i] = 0.f;
    f32x16 of0, of1; for (int i = 0; i < 16; ++i) { of0[i] = 0.f; of1[i] = 0.f; }

    const int nv = t >= 31 ? ((t - 31) >> 4) + 1 : 0;
    {
        const int ntile = (4 * tt + 3 + 63) >> 6;
        const bf16_t* ck = (const bf16_t*)(ws + WS_CKP) + slab * 512 * 64;
        const bf16_t* cvt = (const bf16_t*)(ws + WS_CVTP) + slab * 64 * 512;
        float m = NEGBIG, l = 0.f;
        ATT_STREAM_BEGIN(ntile, ck + (size_t)i_ * 64 * 64, cvt + i_ * 64, 512)
            f32x16 s0, s1; qk_tile(tb, qf, s0, s1, lane);
            float mt = NEGBIG;
#pragma unroll
            for (int rr = 0; rr < 16; ++rr) { const int n0 = i_ * 64 + crow(rr, hi); s0[rr] = n0 < nv ? s0[rr] : NEGBIG; s1[rr] = n0 + 32 < nv ? s1[rr] : NEGBIG; mt = fmaxf(mt, fmaxf(s0[rr], s1[rr])); }
            const float mn = fmaxf(m, mt); float sum = 0.f;
#pragma unroll
            for (int rr = 0; rr < 16; ++rr) sum += __builtin_amdgcn_exp2f(s0[rr] - mn) + __builtin_amdgcn_exp2f(s1[rr] - mn);
            l = l * __builtin_amdgcn_exp2f(m - mn) + sum; m = mn;
        ATT_STREAM_END()
        const float mo = __shfl_xor(m, 32), lo = __shfl_xor(l, 32);
        const float M = fmaxf(m, mo), L = l * __builtin_amdgcn_exp2f(m - M) + lo * __builtin_amdgcn_exp2f(mo - M);
        const float invL = M > -1e29f ? 1.f / L : 0.f;
        f32x16 o0, o1; for (int i = 0; i < 16; ++i) { o0[i] = 0.f; o1[i] = 0.f; }
        LAS float* myimp = imp + tokl * IMP_STR;
        ATT_STREAM_BEGIN(ntile, ck + (size_t)i_ * 64 * 64, cvt + i_ * 64, 512)
            f32x16 s0, s1; qk_tile(tb, qf, s0, s1, lane);
#pragma unroll
            for (int rr = 0; rr < 16; ++rr) { const int n0 = i_ * 64 + crow(rr, hi);
                s0[rr] = n0 < nv ? __builtin_amdgcn_exp2f(s0[rr] - M) * invL : 0.f; s1[rr] = n0 + 32 < nv ? __builtin_amdgcn_exp2f(s1[rr] - M) * invL : 0.f; }
#pragma unroll
            for (int a = 0; a < 4; ++a) {
                const int sb0 = i_ * 16 + 2 * a + hi, sb1 = sb0 + 8;
                LDS_FADD(myimp + sb0, (s0[4 * a] + s0[4 * a + 1]) + (s0[4 * a + 2] + s0[4 * a + 3])); LDS_FADD(myimp + sb0 + 1, s0[4 * a + 3]);
                LDS_FADD(myimp + sb1, (s1[4 * a] + s1[4 * a + 1]) + (s1[4 * a + 2] + s1[4 * a + 3])); LDS_FADD(myimp + sb1 + 1, s1[4 * a + 3]);
            }
            pv_tile(tb + KT_BYTES, s0, s1, o0, o1, lane);
        ATT_STREAM_END()
#pragma unroll
        for (int i = 0; i < 16; ++i) { of0[i] = gate0 * o0[i]; of1[i] = gate0 * o1[i]; }
    }
    unsigned long long sel_lo = 0ull, sel_hi = 0ull;
    {
        const unsigned long long lt = (1ull << lane) - 1ull;
#pragma unroll 1
        for (int j = 0; j < 8; ++j) {
            const float i0 = imp[j * IMP_STR + lane], i1 = imp[j * IMP_STR + 64 + lane];
            const int sA = lane, sB = lane + 64;
            const bool vA = sA <= tt, vB = sB <= tt;
            const bool fA = sA == 0 || sA == tt || sA == tt - 1, fB = sB == tt || sB == tt - 1;
            const int xA = vA ? __float_as_int(i0 + (fA ? 1e4f : 0.f)) : -1, xB = vB ? __float_as_int(i1 + (fB ? 1e4f : 0.f)) : -1;
            int T = 0;
#pragma unroll 1
            for (int bit = 30; bit >= 0; --bit) { const int T2 = T | (1 << bit);
                const int c = __popcll(__ballot(xA >= T2)) + __popcll(__ballot(xB >= T2)); T = __builtin_amdgcn_readfirstlane(c >= 16 ? T2 : T); }
            const bool gA = xA > T, gB = xB > T, eA = xA == T, eB = xB == T;
            const int need = 16 - (__popcll(__ballot(gA)) + __popcll(__ballot(gB)));
            const unsigned long long beA = __ballot(eA), beB = __ballot(eB);
            const int preA = __popcll(beA & lt), preB = __popcll(beA) + __popcll(beB & lt);
            const unsigned long long mA = __ballot(gA || (eA && preA < need)), mB = __ballot(gB || (eB && preB < need));
            if (tokl == j) { sel_lo = mA; sel_hi = mB; }
        }
    }
    {
        const bf16_t* kb = (const bf16_t*)(ws + WS_KSEL) + slab * TP * 64;
        const bf16_t* vt = (const bf16_t*)(ws + WS_VSELT) + slab * 64 * TP;
        float m = NEGBIG, l = 0.f; f32x16 o0, o1; for (int i = 0; i < 16; ++i) { o0[i] = 0.f; o1[i] = 0.f; }
        ATT_STREAM_BEGIN(tt + 1, kb + (size_t)(i_ == 0 ? tt : i_ - 1) * 64 * 64, vt + (size_t)(i_ == 0 ? tt : i_ - 1) * 64, TP)
            const int s = i_ == 0 ? tt : i_ - 1;
            const bool on = ((s < 64 ? (sel_lo >> s) : (sel_hi >> (s - 64))) & 1ull) != 0ull;
            f32x16 s0, s1; qk_tile(tb, qf, s0, s1, lane);
            const int lim = on ? (s == tt ? t - s * 64 : 64) : -1;
#pragma unroll
            for (int rr = 0; rr < 16; ++rr) { const int kk = crow(rr, hi); s0[rr] = kk <= lim ? s0[rr] : NEGBIG; s1[rr] = kk + 32 <= lim ? s1[rr] : NEGBIG; }
            softmax_step(s0, s1, m, l, o0, o1);
            pv_tile(tb + KT_BYTES, s0, s1, o0, o1, lane);
        ATT_STREAM_END()
        const float sc = gate1 / (l + __shfl_xor(l, 32));
#pragma unroll
        for (int i = 0; i < 16; ++i) { of0[i] += sc * o0[i]; of1[i] += sc * o1[i]; }
    }
    {
        const bf16_t* kb = (const bf16_t*)(ws + WS_KWIN) + slab * TP * 64;
        const bf16_t* vt = (const bf16_t*)(ws + WS_VWINT) + slab * 64 * TP;
        const int ntile = (tt < 8 ? tt : 8) + 1;
        float m = NEGBIG, l = 0.f; f32x16 o0, o1; for (int i = 0; i < 16; ++i) { o0[i] = 0.f; o1[i] = 0.f; }
        ATT_STREAM_BEGIN(ntile, kb + (size_t)(tt - i_) * 64 * 64, vt + (size_t)(tt - i_) * 64, TP)
            const int k0 = (tt - i_) * 64;
            f32x16 s0, s1; qk_tile(tb, qf, s0, s1, lane);
#pragma unroll
            for (int rr = 0; rr < 16; ++rr) { const int kp = k0 + crow(rr, hi);
                s0[rr] = (kp <= t && kp >= t - 512) ? s0[rr] : NEGBIG; s1[rr] = (kp + 32 <= t && kp + 32 >= t - 512) ? s1[rr] : NEGBIG; }
            softmax_step(s0, s1, m, l, o0, o1);
            pv_tile(tb + KT_BYTES, s0, s1, o0, o1, lane);
        ATT_STREAM_END()
        const float sc = gate2 / (l + __shfl_xor(l, 32));
#pragma unroll
        for (int i = 0; i < 16; ++i) { of0[i] += sc * o0[i]; of1[i] += sc * o1[i]; }
    }
    { bf16_t* o = (bf16_t*)(p.ws + WS_MIX) + row * DM + (g * 4 + r) * 64 + 4 * hi;
#pragma unroll
      for (int i = 0; i < 4; ++i) { epi::st_bf16x4(o + 8 * i, of0[4 * i], of0[4 * i + 1], of0[4 * i + 2], of0[4 * i + 3]);
                                    epi::st_bf16x4(o + 32 + 8 * i, of1[4 * i], of1[4 * i + 1], of1[4 * i + 2], of1[4 * i + 3]); } }
}
}
namespace gdn {
template <int I> struct SolveRow {
    static DI void run(float (&x)[64], const LAS float* LM, const LAS float* VF, const LAS float* KF, const LAS float* GC, bool isu, int col) {
        SolveRow<I - 1>::run(x, LM, VF, KF, GC, isu, col);
        float acc = isu ? VF[I * 128 + col] * GC[64 + I] : KF[I * 128 + col] * GC[64 + I] * GC[128 + I];
        float a1 = 0.f, a2 = 0.f, a3 = 0.f;
#pragma unroll
        for (int j = 0; j < I; ++j) { const float t = LM[I * 64 + j] * x[j]; if ((j & 3) == 0) acc -= t; else if ((j & 3) == 1) a1 -= t; else if ((j & 3) == 2) a2 -= t; else a3 -= t; }
        x[I] = (acc + a1) + (a2 + a3);
        asm volatile("" : "+v"(x[I]) :: "memory");
    }
};
template <> struct SolveRow<-1> { static DI void run(float (&)[64], const LAS float*, const LAS float*, const LAS float*, const LAS float*, bool, int) {} };
constexpr int P_KF = 0, P_VF = 32768, P_QB = 65536, P_KB = 82944, P_LM = 100352, P_GC = 116736, PSTR = 136;
DI void prep_unit(const Params& p, LAS unsigned char* lds, int b, int h, int n) {
    int tid_ = threadIdx.x; asm volatile("" : "+v"(tid_)); const int tid = tid_, lane = tid & 63, wave = __builtin_amdgcn_readfirstlane(tid >> 6);
    const unsigned char* ws = p.ws;
    LAS float* KF = (LAS float*)(lds + P_KF); LAS float* VF = (LAS float*)(lds + P_VF);
    LAS bf16_t* QB = (LAS bf16_t*)(lds + P_QB); LAS bf16_t* KB = (LAS bf16_t*)(lds + P_KB);
    LAS float* LM = (LAS float*)(lds + P_LM); LAS float* GC = (LAS float*)(lds + P_GC);
    const int chunk = (b * GH + h) * NCHUNK + n;
    const size_t row0 = (size_t)b * TP + (size_t)n * 64;
    __syncthreads();
    if (wave == 0) {
        const float* gt = (const float*)(ws + WS_GT) + (row0 + lane) * 32;
        float g = gt[24 + h]; const float be = gt[28 + h];
#pragma unroll
        for (int o = 1; o < 64; o <<= 1) { const float x = __shfl_up(g, o); if (lane >= o) g += x; }
        GC[lane] = g; GC[64 + lane] = be; GC[128 + lane] = __expf(g);
    }
    __syncthreads();
    {
        const int dd = (tid & 15) * 8;
        const float* cw = p.conv_w;
        const bf16_t* ci = (const bf16_t*)(ws + WS_CI);
#pragma unroll 1
        for (int cc = 0; cc < 2; ++cc) {
            const int c = (tid >> 4) + cc * 32; const int t = n * 64 + c;
            float val[3][8];
#pragma unroll
            for (int part = 0; part < 3; ++part) {
                const int ch = part * 512 + h * 128 + dd;
                float a[8]; for (int i = 0; i < 8; ++i) a[i] = 0.f;
#pragma unroll
                for (int j = 0; j < 4; ++j) {
                    const int tj = t - 3 + j;
                    if (tj >= 0) {
                        const u32x4 xv = *(const u32x4*)(ci + ((size_t)b * TP + tj) * CCH + ch);
                        const f32x4 w0 = *(const f32x4*)(cw + j * CCH + ch), w1 = *(const f32x4*)(cw + j * CCH + ch + 4);
                        const unsigned xs[4] = {xv.x, xv.y, xv.z, xv.w};
#pragma unroll
                        for (int i = 0; i < 4; ++i) { a[2 * i] += __uint_as_float(xs[i] << 16) * (i < 2 ? w0[2 * i] : w1[2 * i - 4]); a[2 * i + 1] += __uint_as_float(xs[i] & 0xffff0000u) * (i < 2 ? w0[2 * i + 1] : w1[2 * i - 3]); }
                    }
                }
#pragma unroll
                for (int i = 0; i < 8; ++i) val[part][i] = siluf_(a[i]);
            }
            float sq = 0.f, sk = 0.f;
#pragma unroll
            for (int i = 0; i < 8; ++i) { sq += val[0][i] * val[0][i]; sk += val[1][i] * val[1][i]; }
#pragma unroll
            for (int o = 1; o < 16; o <<= 1) { sq += __shfl_xor(sq, o); sk += __shfl_xor(sk, o); }
            const float rq = rsqrtf(sq + EPS) * 0.08838834764831845f, rk = rsqrtf(sk + EPS), eg = GC[128 + c];
            float qn[8], qg[8], kn[8];
#pragma unroll
            for (int i = 0; i < 8; ++i) { qn[i] = val[0][i] * rq; qg[i] = qn[i] * eg; kn[i] = val[1][i] * rk; }
            {
              bf16_t* qf = (bf16_t*)(ws + WS_GQG) + (size_t)chunk * 8192 + (size_t)(((c >> 5) * 8 + (dd >> 4)) * 64 + (c & 31)) * 8 + ((dd >> 3) & 1) * 4;
              epi::st_bf16x4(qf, qg[0], qg[1], qg[2], qg[3]); epi::st_bf16x4(qf + 32 * 8, qg[4], qg[5], qg[6], qg[7]); }
            { u32x4 w; w.x = pk2(qn[0], qn[1]); w.y = pk2(qn[2], qn[3]); w.z = pk2(qn[4], qn[5]); w.w = pk2(qn[6], qn[7]); *(LAS u32x4*)(QB + c * PSTR + dd) = w; }
            { u32x4 w; w.x = pk2(kn[0], kn[1]); w.y = pk2(kn[2], kn[3]); w.z = pk2(kn[4], kn[5]); w.w = pk2(kn[6], kn[7]); *(LAS u32x4*)(KB + c * PSTR + dd) = w; }
            *(LAS f32x4*)(KF + c * 128 + dd) = (f32x4){kn[0], kn[1], kn[2], kn[3]}; *(LAS f32x4*)(KF + c * 128 + dd + 4) = (f32x4){kn[4], kn[5], kn[6], kn[7]};
            *(LAS f32x4*)(VF + c * 128 + dd) = (f32x4){val[2][0], val[2][1], val[2][2], val[2][3]}; *(LAS f32x4*)(VF + c * 128 + dd + 4) = (f32x4){val[2][4], val[2][5], val[2][6], val[2][7]};
        }
    }
    __syncthreads();
    {
        const int mat = wave >> 2, ti = (wave >> 1) & 1, tj = wave & 1, hi = lane >> 5, cl = lane & 31;
        const LAS bf16_t* A = (mat == 0 ? KB : QB) + (ti * 32 + cl) * PSTR + hi * 8;
        const LAS bf16_t* B = KB + (tj * 32 + cl) * PSTR + hi * 8;
        f32x16 acc; for (int i = 0; i < 16; ++i) acc[i] = 0.f;
#pragma unroll
        for (int ks = 0; ks < 8; ++ks) acc = MFMA32(*(const LAS bf16x8*)(A + ks * 16), *(const LAS bf16x8*)(B + ks * 16), acc);
        const int j = tj * 32 + cl; const float gj = GC[j];
#pragma unroll
        for (int r = 0; r < 16; ++r) {
            const int i = ti * 32 + crow(r, hi);
            const float dec = __expf(fminf(GC[i] - gj, 0.f));
            if (mat == 0) LM[i * 64 + j] = i > j ? GC[64 + i] * acc[r] * dec : 0.f;
            else ((bf16_t*)(ws + WS_GAQK))[(size_t)chunk * 4096 + (size_t)(((i >> 5) * 4 + (j >> 4)) * 64 + (i & 31) + 32 * ((j >> 2) & 1)) * 8 + ((j >> 3) & 1) * 4 + (j & 3)] = f2bf(i >= j ? acc[r] * dec : 0.f);
        }
    }
    __syncthreads();
    if (wave < 4) {
        const int cc = tid; const bool isu = cc < 128; const int col = cc & 127;
        float x[64];
        int zoff = 0; asm volatile("" : "+v"(zoff));
        SolveRow<63>::run(x, LM + zoff, VF, KF, GC + zoff, isu, col);
        if (isu) {
            float* gu = (float*)(ws + WS_GU) + (size_t)chunk * 8192 + (size_t)(col >> 5) * 2048;
#pragma unroll
            for (int ct = 0; ct < 2; ++ct)
#pragma unroll
                for (int i4 = 0; i4 < 4; ++i4)
#pragma unroll
                    for (int hh = 0; hh < 2; ++hh) { const int c0 = 32 * ct + 8 * i4 + 4 * hh;
                        *(f32x4*)(gu + ((ct * 4 + i4) * 64 + (col & 31) + 32 * hh) * 4) = (f32x4){x[c0], x[c0 + 1], x[c0 + 2], x[c0 + 3]}; }
        } else {
            bf16_t* gw = (bf16_t*)(ws + WS_GW) + (size_t)chunk * 8192 + (size_t)((col >> 4) * 64 + 32 * ((col >> 2) & 1)) * 8 + ((col >> 3) & 1) * 4 + (col & 3);
#pragma unroll
            for (int i = 0; i < 64; ++i) gw[(size_t)((i >> 5) * 8 * 64 + (i & 31)) * 8] = f2bf(-x[i]);
        }
    } else {
        const int t2 = tid - 256, dk = t2 & 127, c0 = (t2 >> 7) * 32; const float glast = GC[63];
        bf16_t* kg = (bf16_t*)(ws + WS_GKGT) + (size_t)chunk * 8192;
#pragma unroll
        for (int q = 0; q < 4; ++q) { const int kc = (c0 >> 4) + (q >> 1), hh = q & 1; float v[8];
#pragma unroll
            for (int e = 0; e < 8; ++e) { const int c = 16 * kc + 8 * (e >> 2) + 4 * hh + (e & 3); v[e] = KF[c * 128 + dk] * __expf(glast - GC[c]); }
            epi::st_bf16x8(kg + (size_t)(((dk >> 5) * 4 + kc) * 64 + (dk & 31) + 32 * hh) * 8, v); }
        if (t2 == 0) ((float*)(ws + WS_GGL))[chunk] = __expf(glast);
    }
}

constexpr int SC_STAGE = 40960  , SC_X = 2 * SC_STAGE, SC_XB = 12288  ;
DI void scan_unit(const Params& p, LAS unsigned char* lds, int b, int h, int dvs) {
    int tid_ = threadIdx.x; asm volatile("" : "+v"(tid_)); const int tid = tid_, lane = tid & 63, wave = __builtin_amdgcn_readfirstlane(tid >> 6), hi = lane >> 5, cl = lane & 31;
    const unsigned char* ws = p.ws;
    const int chunk0 = (b * GH + h) * NCHUNK;
    __syncthreads();
    if (wave == 0) {
        f32x16 S[4]; for (int k = 0; k < 4; ++k) for (int i = 0; i < 16; ++i) S[k][i] = 0.f;
        float gl = ((const float*)(ws + WS_GGL))[chunk0];
        __syncthreads();
        for (int n = 0; n < NCHUNK; ++n) {
            const LAS unsigned char* st = lds + (n & 1) * SC_STAGE; LAS unsigned char* xb = lds + SC_X + (n & 1) * SC_XB;
            const float gln = n + 1 < NCHUNK ? ((const float*)(ws + WS_GGL))[chunk0 + n + 1] : 0.f;
            bf16x8 Sb[8];
#pragma unroll
            for (int ks = 0; ks < 8; ++ks) { Sb[ks] = attn::pack8(S[ks >> 1], (ks & 1) * 8); *(LAS bf16x8*)(xb + ks * 1024 + lane * 16) = Sb[ks]; }
            bf16x8 vb[4];
#pragma unroll
            for (int ct = 0; ct < 2; ++ct) { f32x16 vn;
#pragma unroll
                for (int i4 = 0; i4 < 4; ++i4) { const f32x4 u4 = *(const LAS f32x4*)(st + 32768 + (ct * 4 + i4) * 1024 + lane * 16); vn[4 * i4] = u4[0]; vn[4 * i4 + 1] = u4[1]; vn[4 * i4 + 2] = u4[2]; vn[4 * i4 + 3] = u4[3]; }
#pragma unroll
                for (int ks = 0; ks < 8; ++ks) vn = MFMA32(*(const LAS bf16x8*)(st + (ct * 8 + ks) * 1024 + lane * 16), Sb[ks], vn);
                vb[2 * ct] = attn::pack8(vn, 0); vb[2 * ct + 1] = attn::pack8(vn, 8);
                *(LAS bf16x8*)(xb + 8192 + (2 * ct) * 1024 + lane * 16) = vb[2 * ct]; *(LAS bf16x8*)(xb + 8192 + (2 * ct + 1) * 1024 + lane * 16) = vb[2 * ct + 1]; }
#pragma unroll
            for (int dkt = 0; dkt < 4; ++dkt) {
#pragma unroll
                for (int i = 0; i < 16; ++i) S[dkt][i] *= gl;
#pragma unroll
                for (int kc = 0; kc < 4; ++kc) S[dkt] = MFMA32(*(const LAS bf16x8*)(st + 16384 + (dkt * 4 + kc) * 1024 + lane * 16), vb[kc], S[dkt]); }
            gl = gln;
            __syncthreads();
        }
        __syncthreads();
        float* so = p.out + O_SP + (size_t)(b * GH + h) * 16384 + dvs * 32 + cl;
#pragma unroll
        for (int dkt = 0; dkt < 4; ++dkt)
#pragma unroll
            for (int r = 0; r < 16; ++r) so[(size_t)(dkt * 32 + crow(r, hi)) * 128] = S[dkt][r];
    } else if (wave <= 2) {
        const int par = wave - 1;
        bf16x8 qf[16], af[8];
#define SCAN_LDF(n_) do { const bf16_t* q_ = (const bf16_t*)(ws + WS_GQG) + (size_t)(chunk0 + (n_)) * 8192 + lane * 8; const bf16_t* a_ = (const bf16_t*)(ws + WS_GAQK) + (size_t)(chunk0 + (n_)) * 4096 + lane * 8; \
            _Pragma("unroll") for (int f = 0; f < 16; ++f) qf[f] = *(const bf16x8*)(q_ + f * 512); _Pragma("unroll") for (int f = 0; f < 8; ++f) af[f] = *(const bf16x8*)(a_ + f * 512); } while (0)
        SCAN_LDF(par);
        __syncthreads();
        for (int n = 0; n <= NCHUNK; ++n) {
            const int m = n - 1;
            if (m >= 0 && (m & 1) == par) {
                const LAS unsigned char* xb = lds + SC_X + (m & 1) * SC_XB;
                bf16x8 Sb[8], vb[4];
#pragma unroll
                for (int ks = 0; ks < 8; ++ks) Sb[ks] = *(const LAS bf16x8*)(xb + ks * 1024 + lane * 16);
#pragma unroll
                for (int kc = 0; kc < 4; ++kc) vb[kc] = *(const LAS bf16x8*)(xb + 8192 + kc * 1024 + lane * 16);
                float* og = (float*)(p.ws + WS_OG) + ((size_t)(b * GH + h) * TP + (size_t)m * 64) * 128 + dvs * 32 + cl;
#pragma unroll
                for (int ct = 0; ct < 2; ++ct) { f32x16 o; for (int i = 0; i < 16; ++i) o[i] = 0.f;
#pragma unroll
                    for (int ks = 0; ks < 8; ++ks) o = MFMA32(qf[ct * 8 + ks], Sb[ks], o);
#pragma unroll
                    for (int kc = 0; kc < 4; ++kc) o = MFMA32(af[ct * 4 + kc], vb[kc], o);
#pragma unroll
                    for (int r = 0; r < 16; ++r) og[(size_t)(ct * 32 + crow(r, hi)) * 128] = o[r]; }
                if (m + 2 < NCHUNK) SCAN_LDF(m + 2);
            }
            __syncthreads();
        }
    } else {
        const int t3 = tid - 192;
        u32x4 ra[8], rb[8];
#define SCAN_SRC(n_, q_) ({ const int pc_ = (q_) * 320 + t3; const unsigned char* s_ = pc_ < 1024 ? ws + WS_GW + (size_t)(chunk0 + (n_)) * 16384 + (size_t)pc_ * 16 \
            : pc_ < 2048 ? ws + WS_GKGT + (size_t)(chunk0 + (n_)) * 16384 + (size_t)(pc_ - 1024) * 16 : ws + WS_GU + (size_t)(chunk0 + (n_)) * 32768 + (size_t)dvs * 8192 + (size_t)(pc_ - 2048) * 16; s_; })
#define SCAN_ISSUE(R, n_) do { _Pragma("unroll") for (int q = 0; q < 8; ++q) if (q * 320 + t3 < 2560) R[q] = *(const u32x4*)SCAN_SRC(n_, q); } while (0)
#define SCAN_COMMIT(R, n_) do { LAS unsigned char* d_ = lds + ((n_) & 1) * SC_STAGE; _Pragma("unroll") for (int q = 0; q < 8; ++q) if (q * 320 + t3 < 2560) *(LAS u32x4*)(d_ + (q * 320 + t3) * 16) = R[q]; } while (0)
        SCAN_ISSUE(ra, 0); SCAN_ISSUE(rb, 1); SCAN_COMMIT(ra, 0);
        __syncthreads();
        for (int n = 0; n < NCHUNK; n += 2) {
            if (n + 2 < NCHUNK) SCAN_ISSUE(ra, n + 2);
            SCAN_COMMIT(rb, n + 1);
            __syncthreads();
            if (n + 3 < NCHUNK) SCAN_ISSUE(rb, n + 3);
            if (n + 2 < NCHUNK) SCAN_COMMIT(ra, n + 2);
            __syncthreads();
        }
        __syncthreads();
    }
}

DI void post(const Params& p) {
    int tid_ = threadIdx.x; asm volatile("" : "+v"(tid_)); const int tid = tid_, lane = tid & 63;
    const int gh = (blockIdx.x * 512 + tid) >> 5, NGH = (gridDim.x * 512) >> 5, l32 = lane & 31;
    const f32x4 nw = *(const f32x4*)(p.gdn_norm + l32 * 4);
    for (int it = gh; it < MP * GH; it += NGH) {
        const int row = it >> 2, h = it & 3, b = row >> 13, t = row & (TP - 1);
        const f32x4 o = *(const f32x4*)((const float*)(p.ws + WS_OG) + ((size_t)(b * GH + h) * TP + t) * 128 + l32 * 4);
        float s = o[0] * o[0] + o[1] * o[1] + o[2] * o[2] + o[3] * o[3];
#pragma unroll
        for (int x = 1; x < 32; x <<= 1) s += __shfl_xor(s, x);
        const float rs = rsqrtf(s * (1.f / 128.f) + EPS);
        const u32x2 zz = *(const u32x2*)((const bf16_t*)(p.ws + WS_Z) + (size_t)row * 512 + h * 128 + l32 * 4);
        const float z0 = __uint_as_float(zz.x << 16), z1 = __uint_as_float(zz.x & 0xffff0000u), z2 = __uint_as_float(zz.y << 16), z3 = __uint_as_float(zz.y & 0xffff0000u);
        epi::st_bf16x4((bf16_t*)(p.ws + WS_MIX) + (size_t)row * DM + 512 + h * 128 + l32 * 4, o[0] * rs * nw[0] * siluf_(z0), o[1] * rs * nw[1] * siluf_(z1), o[2] * rs * nw[2] * siluf_(z2), o[3] * rs * nw[3] * siluf_(z3));
    }
}
}
namespace cmp {
constexpr int TSTR = 72, C_TOK = 0, C_PART = 76032, C_LDS = C_PART + 8 * 32 * 64 * 4;
constexpr int NSLAB = 8 + 128, NUNIT = NSLAB * 16;
DI void unit(const Params& p, LAS unsigned char* lds, int u) {
    int tid_ = threadIdx.x; asm volatile("" : "+v"(tid_)); const int tid = tid_, lane = tid & 63, wave = __builtin_amdgcn_readfirstlane(tid >> 6), hi = lane >> 5, cl = lane & 31;
    const unsigned char* ws = p.ws;
    const int sl = u >> 4, n0 = (u & 15) * 32;
    const bool samp = sl >= 8;
    int kv, bb, g;
    if (!samp) { kv = sl >> 2; bb = (sl >> 1) & 1; g = sl & 1; } else { const int s2 = sl - 8; kv = s2 >> 6; bb = (s2 >> 1) & 31; g = s2 & 1; }
    LAS bf16_t* TOK = (LAS bf16_t*)(lds + C_TOK); LAS float* PART = (LAS float*)(lds + C_PART);
    __syncthreads();
    if (!samp) {
        u32x4 w[9];
        const bf16_t* src = (const bf16_t*)(ws + (kv ? WS_VC : WS_KC)) + (size_t)(bb * 2 + g) * TP * 64;
#pragma unroll
        for (int q = 0; q < 9; ++q) { const int i = q * 512 + tid, tok = i >> 3, ch = i & 7, tk = n0 * 16 + tok;
            w[q] = (i < 528 * 8 && tk < TP) ? *(const u32x4*)(src + (size_t)tk * 64 + ch * 8) : (u32x4){0u, 0u, 0u, 0u}; }
#pragma unroll
        for (int q = 0; q < 9; ++q) { const int i = q * 512 + tid, tok = i >> 3, ch = i & 7;
            if (i < 528 * 8) *(LAS u32x4*)(TOK + ((tok & 15) * 33 + (tok >> 4)) * TSTR + ch * 8) = w[q]; }
    } else {
        int pg[9];
#pragma unroll
        for (int q = 0; q < 9; ++q) { const int i = q * 512 + tid, tok = i >> 3, tk = n0 * 16 + tok;
            pg[q] = (i < 528 * 8 && tk < TP) ? p.page_table[bb * NPAGES + (tk >> 7)] : -1; }
        f32x4 a[9], c[9];
#pragma unroll
        for (int q = 0; q < 9; ++q) { const int i = q * 512 + tid, tok = i >> 3, ch = i & 7, tk = n0 * 16 + tok;
            if (pg[q] >= 0) { const float* src = p.cache_kv + (((size_t)pg[q] * PAGE + (tk & 127)) * 4 + kv) * 128 + g * 64 + ch * 8;
                a[q] = __builtin_nontemporal_load((const f32x4*)src); c[q] = __builtin_nontemporal_load((const f32x4*)(src + 4)); }
            else { a[q] = (f32x4){0.f, 0.f, 0.f, 0.f}; c[q] = a[q]; } }
#pragma unroll
        for (int q = 0; q < 9; ++q) { const int i = q * 512 + tid, tok = i >> 3, ch = i & 7;
            u32x4 w; w.x = pk2(a[q][0], a[q][1]); w.y = pk2(a[q][2], a[q][3]); w.z = pk2(c[q][0], c[q][1]); w.w = pk2(c[q][2], c[q][3]);
            if (i < 528 * 8) *(LAS u32x4*)(TOK + ((tok & 15) * 33 + (tok >> 4)) * TSTR + ch * 8) = w; }
    }
    __syncthreads();
    f32x16 acc[2]; for (int i = 0; i < 16; ++i) { acc[0][i] = 0.f; acc[1][i] = 0.f; }
    const bf16_t* wt = (const bf16_t*)(ws + WS_WCMP) + (size_t)kv * 64 * 2048 + lane * 8;
#pragma unroll
    for (int k = 0; k < 16; ++k) {
        const int ks = wave * 16 + k, l = ks >> 2, d0 = (ks & 3) * 16;
        const bf16x8 a = *(const LAS bf16x8*)(TOK + ((l & 15) * 33 + cl + (l >> 4)) * TSTR + d0 + hi * 8);
        const bf16x8 b0 = *(const bf16x8*)(wt + (size_t)ks * 1024), b1 = *(const bf16x8*)(wt + (size_t)ks * 1024 + 512);
        acc[0] = MFMA32(a, b0, acc[0]); acc[1] = MFMA32(a, b1, acc[1]);
    }
#pragma unroll
    for (int et = 0; et < 2; ++et)
#pragma unroll
        for (int r = 0; r < 16; ++r) PART[(wave * 32 + crow(r, hi)) * 64 + et * 32 + cl] = acc[et][r];
    __syncthreads();
    const float* cst = (const float*)(ws + WS_CST) + kv * 64;
    for (int i = tid; i < 32 * 64; i += 512) {
        const int n = i >> 6, e = i & 63;
        float s = cst[e];
#pragma unroll
        for (int w = 0; w < 8; ++w) s += PART[(w * 32 + n) * 64 + e];
        const int ng = n0 + n;
        if (ng >= NCMP) s = 0.f;
        if (!samp) { if (kv == 0) ((bf16_t*)(p.ws + WS_CKP))[((size_t)(bb * 2 + g) * 512 + ng) * 64 + e] = f2bf(s);
                     else ((bf16_t*)(p.ws + WS_CVTP))[((size_t)(bb * 2 + g) * 64 + e) * 512 + ng] = f2bf(s); }
        else ((float*)(p.ws + (kv == 0 ? WS_CKS : WS_CVS)))[((size_t)(bb * 2 + g) * 512 + ng) * 64 + e] = s;
    }
}
}
namespace samp {
constexpr int L_KP = 0, L_VP = 8192, L_SC = 16384, L_RED = 32768, L_QS = 34816, L_IMP = 35840, L_SELB = 36400, L_STAT = 36480;
constexpr int L_RED2 = 40960;
DI float attend(LAS unsigned char* lds, int nk) {
    int tid_ = threadIdx.x; asm volatile("" : "+v"(tid_)); const int tid = tid_, lane = tid & 63, wave = tid >> 6, kq = tid >> 4, dq = tid & 15;
    const float* const LAS* KP = (const float* const LAS*)(lds + L_KP); const float* const LAS* VP = (const float* const LAS*)(lds + L_VP);
    LAS float* SC = (LAS float*)(lds + L_SC); LAS float* RED2 = (LAS float*)(lds + L_RED2); const LAS float* QS = (const LAS float*)(lds + L_QS);
    __syncthreads();
    {
        f32x4 q[4];
#pragma unroll
        for (int r = 0; r < 4; ++r) q[r] = *(const LAS f32x4*)(QS + r * 64 + dq * 4);
        for (int j0 = 0; j0 < nk; j0 += 128) {
            f32x4 kv[4];
#pragma unroll
            for (int u = 0; u < 4; ++u) { const int j = j0 + u * 32 + kq; kv[u] = j < nk ? ((const f32x4*)KP[j])[dq] : (f32x4){0.f, 0.f, 0.f, 0.f}; }
#pragma unroll
            for (int u = 0; u < 4; ++u) { const int j = j0 + u * 32 + kq;
                float pr[4];
#pragma unroll
                for (int r = 0; r < 4; ++r) { float a = (kv[u][0] * q[r][0] + kv[u][1] * q[r][1]) + (kv[u][2] * q[r][2] + kv[u][3] * q[r][3]);
                    a += __shfl_xor(a, 1); a += __shfl_xor(a, 2); a += __shfl_xor(a, 4); a += __shfl_xor(a, 8); pr[r] = a; }
                if (j < nk && dq < 4) SC[dq * 1024 + j] = dq == 0 ? pr[0] : dq == 1 ? pr[1] : dq == 2 ? pr[2] : pr[3]; }
        }
    }
    __syncthreads();
    if (wave < 4) {
        LAS float* sc = SC + wave * 1024;
        float m = NEGBIG; for (int j = lane; j < nk; j += 64) m = fmaxf(m, sc[j]);
#pragma unroll
        for (int o = 1; o < 64; o <<= 1) m = fmaxf(m, __shfl_xor(m, o));
        float l = 0.f; for (int j = lane; j < nk; j += 64) { const float e = __builtin_amdgcn_exp2f(sc[j] - m); sc[j] = e; l += e; }
        l = wave_sum(l); const float inv = 1.f / l;
        for (int j = lane; j < nk; j += 64) sc[j] *= inv;
    }
    __syncthreads();
    {
        f32x4 acc[4]; for (int r = 0; r < 4; ++r) acc[r] = (f32x4){0.f, 0.f, 0.f, 0.f};
        for (int j0 = 0; j0 < nk; j0 += 128) {
            f32x4 vv[4];
#pragma unroll
            for (int u = 0; u < 4; ++u) { const int j = j0 + u * 32 + kq; vv[u] = j < nk ? ((const f32x4*)VP[j])[dq] : (f32x4){0.f, 0.f, 0.f, 0.f}; }
#pragma unroll
            for (int u = 0; u < 4; ++u) { const int j = j0 + u * 32 + kq;
                if (j < nk) {
#pragma unroll
                    for (int r = 0; r < 4; ++r) acc[r] += SC[r * 1024 + j] * vv[u]; } }
        }
#pragma unroll
        for (int r = 0; r < 4; ++r) *(LAS f32x4*)(RED2 + kq * 256 + r * 64 + dq * 4) = acc[r];
    }
    __syncthreads();
    float o = 0.f;
    if (tid < 256) {
#pragma unroll 8
        for (int k = 0; k < 32; ++k) o += RED2[k * 256 + tid];
    }
    return o;
}

DI void attn_unit(const Params& p, LAS unsigned char* lds, int bs, int g) {
    int tid_ = threadIdx.x; asm volatile("" : "+v"(tid_)); const int tid = tid_, lane = tid & 63, wave = tid >> 6;
    const unsigned char* ws = p.ws;
    const float* LAS* KP = (const float* LAS*)(lds + L_KP); const float* LAS* VP = (const float* LAS*)(lds + L_VP);
    LAS float* SC = (LAS float*)(lds + L_SC); LAS float* QS = (LAS float*)(lds + L_QS); LAS float* IMP = (LAS float*)(lds + L_IMP); LAS int* SELB = (LAS int*)(lds + L_SELB);
    const size_t row = (size_t)MP + bs;
    __syncthreads();
    if (tid < 256) QS[tid] = bf2f(((const bf16_t*)(ws + WS_QB))[row * 512 + g * 256 + tid]);
    float gate[3] = {0.f, 0.f, 0.f};
    if (tid < 256) { const float* gt = (const float*)(ws + WS_GT) + row * 32 + (g * 4 + (tid >> 6)) * 3; gate[0] = gt[0]; gate[1] = gt[1]; gate[2] = gt[2]; }
    { const float* ck = (const float*)(ws + WS_CKS) + (size_t)(bs * 2 + g) * 512 * 64; const float* cv = (const float*)(ws + WS_CVS) + (size_t)(bs * 2 + g) * 512 * 64;
      for (int j = tid; j < NCMP; j += 512) { KP[j] = ck + j * 64; VP[j] = cv + j * 64; } }
    float ofin = gate[0] * attend(lds, NCMP);
    if (tid < 128) { const int s = tid; float a = 0.f;
        for (int n = 4 * s - 1; n <= 4 * s + 3; ++n) if (n >= 0 && n < NCMP) a += (SC[n] + SC[1024 + n]) + (SC[2048 + n] + SC[3072 + n]);
        IMP[s] = a; }
    __syncthreads();
    if (wave == 0) {
        const unsigned long long lt = (1ull << lane) - 1ull;
        const int xA = __float_as_int(IMP[lane] + (lane == 0 ? 1e4f : 0.f)), xB = __float_as_int(IMP[64 + lane] + (lane == 63 ? 1e4f : 0.f));
        int T = 0;
        for (int bit = 30; bit >= 0; --bit) { const int T2 = T | (1 << bit); const int c = __popcll(__ballot(xA >= T2)) + __popcll(__ballot(xB >= T2)); if (c >= 15) T = T2; }
        const bool gA = xA > T, gB = xB > T, eA = xA == T, eB = xB == T;
        const int need = 15 - (__popcll(__ballot(gA)) + __popcll(__ballot(gB)));
        const unsigned long long beA = __ballot(eA), beB = __ballot(eB);
        const bool sA = gA || (eA && __popcll(beA & lt) < need), sB = gB || (eB && __popcll(beA) + __popcll(beB & lt) < need);
        const unsigned long long mA = __ballot(sA), mB = __ballot(sB);
        if (sA) SELB[__popcll(mA & lt)] = lane;
        if (sB) SELB[__popcll(mA) + __popcll(mB & lt)] = 64 + lane;
    }
    __syncthreads();
    for (int j = tid; j < 961; j += 512) {
        if (j < 960) { const int tp = SELB[j >> 6] * 64 + (j & 63); const int page = p.page_table[bs * NPAGES + (tp >> 7)];
            const float* rb = p.cache_kv + ((size_t)page * PAGE + (tp & 127)) * 512 + g * 64; KP[j] = rb + 256; VP[j] = rb + 384; }
        else { const float* rb = p.out + O_KVS + (size_t)bs * 512 + g * 64; KP[j] = rb + 256; VP[j] = rb + 384; }
    }
    ofin += gate[1] * attend(lds, 961);
    for (int j = tid; j < 513; j += 512) {
        const float* rb = j < 512 ? p.cache_win + ((size_t)bs * 512 + j) * 256 + g * 64 : p.out + O_WINS + ((size_t)bs * 512 + 511) * 256 + g * 64;
        KP[j] = rb; VP[j] = rb + 128; }
    ofin += gate[2] * attend(lds, 513);
    if (tid < 256) ((bf16_t*)(p.ws + WS_MIX))[row * DM + g * 256 + tid] = f2bf(ofin);
}

DI void gdn_unit(const Params& p, LAS unsigned char* lds, int bs, int h) {
    int tid_ = threadIdx.x; asm volatile("" : "+v"(tid_)); const int tid = tid_, lane = tid & 63;
    const unsigned char* ws = p.ws;
    LAS float* QKV = (LAS float*)lds;
    LAS float* RED = QKV + 384;
    LAS float* VN = RED + 1024;
    LAS float* ST = VN + 128;
    const size_t row = (size_t)MP + bs;
    __syncthreads();
    if (tid < 384) {
        const int part = tid >> 7, dd = tid & 127, ch = part * 512 + h * 128 + dd;
        const float* st = p.state_conv + (size_t)bs * 3 * CCH + ch;
        const float xn = p.out[O_CONVS + (size_t)(bs * 3 + 2) * CCH + ch];
        const float a = st[0] * p.conv_w[ch] + st[CCH] * p.conv_w[CCH + ch] + st[2 * CCH] * p.conv_w[2 * CCH + ch] + xn * p.conv_w[3 * CCH + ch];
        const float c = siluf_(a);
        QKV[tid] = c;
        float s = wave_sum(c * c);
        if (lane == 0) ST[tid >> 6] = s;
    }
    __syncthreads();
    const float rq = rsqrtf(ST[0] + ST[1] + EPS) * 0.08838834764831845f, rk = rsqrtf(ST[2] + ST[3] + EPS);
    const float* gt = (const float*)(ws + WS_GT) + row * 32;
    const float eg = __expf(gt[24 + h]), beta = gt[28 + h];
    const int dv = tid & 127, qd = tid >> 7;
    const float* S0 = p.state_S + (size_t)(bs * GH + h) * 16384;
    float sreg[32], ks = 0.f, qs = 0.f, qk = 0.f;
#pragma unroll
    for (int i = 0; i < 32; ++i) { const int dk = qd * 32 + i; const float s = S0[dk * 128 + dv]; sreg[i] = s; const float kk = QKV[128 + dk] * rk, qq = QKV[dk] * rq; ks += kk * s; qs += qq * s; qk += kk * qq; }
    RED[(qd * 2 + 0) * 128 + dv] = ks; RED[(qd * 2 + 1) * 128 + dv] = qs;
    if (dv == 0) ST[8 + qd] = qk;
    __syncthreads();
    const float kS = (RED[dv] + RED[256 + dv]) + (RED[512 + dv] + RED[768 + dv]);
    const float qS = (RED[128 + dv] + RED[384 + dv]) + (RED[640 + dv] + RED[896 + dv]);
    const float qkd = (ST[8] + ST[9]) + (ST[10] + ST[11]);
    const float vn = beta * (QKV[256 + dv] - eg * kS);
    const float o = eg * qS + qkd * vn;
    float* Sn = p.out + O_SS + (size_t)(bs * GH + h) * 16384;
#pragma unroll
    for (int i = 0; i < 32; ++i) { const int dk = qd * 32 + i; Sn[dk * 128 + dv] = eg * sreg[i] + QKV[128 + dk] * rk * vn; }
    if (tid < 128) {
        float s = wave_sum(o * o); if (lane == 0) ST[16 + (tid >> 6)] = s;
    }
    __syncthreads();
    if (tid < 128) {
        const float rs = rsqrtf((ST[16] + ST[17]) * (1.f / 128.f) + EPS);
        const float z = bf2f(((const bf16_t*)(ws + WS_Z))[row * 512 + h * 128 + tid]);
        ((bf16_t*)(p.ws + WS_MIX))[row * DM + 512 + h * 128 + tid] = f2bf(o * rs * p.gdn_norm[tid] * siluf_(z));
    }
}
}
#define RLX_AGENT __ATOMIC_RELAXED, __HIP_MEMORY_SCOPE_AGENT
#define XB_TMO      128
#define XB_XCNT(j)  (256  + 64 * (j))
#define XB_XSUB(j)  (1280 + 64 * (j))
#define XB_XGEN(j)  (2304 + 64 * (j))
#define XB_TOP      3328
#define XB_TOPGEN   3392
#define XCD_BAR_WORDS 3456
#define XB_SPIN_CAP (1u << 18)

__device__ __forceinline__ unsigned xb_ld(unsigned* p)              { return __hip_atomic_load(p, __ATOMIC_RELAXED, __HIP_MEMORY_SCOPE_AGENT); }
__device__ __forceinline__ unsigned xb_add(unsigned* p, unsigned v) { return __hip_atomic_fetch_add(p, v, __ATOMIC_RELAXED, __HIP_MEMORY_SCOPE_AGENT); }
__device__ __forceinline__ unsigned xb_xcc_id() { return (unsigned)__builtin_amdgcn_s_getreg((3 << 11) | 20) & 0xFu; }
#define XB_SPIN(cond, bar) do { unsigned _sp = 0; while (cond) { __builtin_amdgcn_s_sleep(1); \
    if ((++_sp & 255u) == 0u) { if (xb_ld(&(bar)[XB_TMO])) break; if (_sp > XB_SPIN_CAP) { atomicAdd(&(bar)[XB_TMO], 1u); break; } } } } while (0)

struct XcdBarrier {
    unsigned* bar; unsigned x;
    volatile LAS unsigned* st;
};

__device__ __forceinline__ XcdBarrier xcd_barrier_post(unsigned* bar, volatile LAS unsigned* st) {
    XcdBarrier b; b.bar = bar; b.x = xb_xcc_id(); b.st = st;
    if (threadIdx.x == 0) (void)xb_add(&bar[XB_XCNT(b.x)], 1u);
    return b;
}
__device__ __forceinline__ void xcd_barrier_complete(unsigned* bar, unsigned x, unsigned& nloc, unsigned& nx) {
    const unsigned G = gridDim.x * gridDim.y * gridDim.z;
    unsigned sum, cnt, mine, sp = 0u;
    for (;;) {
        sum = 0u; cnt = 0u; mine = 0u;
#pragma unroll
        for (unsigned j = 0; j < 16; ++j) { const unsigned c = xb_ld(&bar[XB_XCNT(j)]); sum += c; cnt += (c > 0u) ? 1u : 0u; mine = (j == x) ? c : mine; }
        if (sum == G) break;
        __builtin_amdgcn_s_sleep(1);
        if ((++sp & 255u) == 0u) { if (xb_ld(&bar[XB_TMO])) break; if (sp > XB_SPIN_CAP) { atomicAdd(&bar[XB_TMO], 1u); break; } }
    }
    nloc = mine > 0u ? mine : 1u; nx = cnt > 0u ? cnt : 1u;
}

__device__ __forceinline__ void xcd_barrier(const XcdBarrier& b) {
    asm volatile("s_waitcnt vmcnt(0)" ::: "memory");
    __syncthreads();
    if (threadIdx.x == 0) {
        unsigned* bar = b.bar;
        __builtin_amdgcn_s_waitcnt(0);
        unsigned nloc = b.st[0], nx = b.st[1];
        if (nloc == 0u) { xcd_barrier_complete(bar, b.x, nloc, nx); b.st[0] = nloc; b.st[1] = nx; }
        const unsigned old = xb_add(&bar[XB_XSUB(b.x)], 1u);
        const unsigned gen = old / nloc;
        if (old + 1u == (gen + 1u) * nloc) {
            __builtin_amdgcn_fence(__ATOMIC_RELEASE, "agent");
            asm volatile("s_waitcnt vmcnt(0)" ::: "memory");
            const unsigned og = xb_add(&bar[XB_TOP], 1u);
            const unsigned tg = og / nx;
            if (og + 1u == (tg + 1u) * nx) xb_add(&bar[XB_TOPGEN], 1u);
            else XB_SPIN(xb_ld(&bar[XB_TOPGEN]) == tg, bar);
            __builtin_amdgcn_fence(__ATOMIC_ACQUIRE, "agent");
            xb_add(&bar[XB_XGEN(b.x)], 1u);
            asm volatile("s_waitcnt vmcnt(0)" ::: "memory");
        } else {
            XB_SPIN(xb_ld(&bar[XB_XGEN(b.x)]) == gen, bar);
            __builtin_amdgcn_fence(__ATOMIC_ACQUIRE, "agent");
            asm volatile("s_waitcnt vmcnt(0)" ::: "memory");
        }
    }
    __syncthreads();
}
constexpr int NTHREADS = 512;
constexpr int LDS_BYTES = 147456;
constexpr int LDS_SLOT = LDS_BYTES - 16, LDS_BARW = LDS_BYTES - 32;
constexpr int CW_BAR = 4096;

DI int next_unit(unsigned* ctr, LAS unsigned char* lds) {
    LAS int* slot = (LAS int*)(lds + LDS_SLOT);
    __syncthreads();
    if (threadIdx.x == 0) *slot = (int)atomicAdd(ctr, 1u);
    __syncthreads();
    return *slot;
}

DI void phase_proj(const Params& p, LAS unsigned char* lds) {
    pg8::Gemm g{(const bf16_t*)(p.ws + WS_XN), (const bf16_t*)(p.ws + WS_WIN), MROWS, INW_PAD, DM};
    pg8::StaticOrder S; S.init(MROWS, INW_PAD, gridDim.x, blockIdx.x);
    epi::EpiProj E{p.out, p.ws, p.a_log, p.dt_bias};
    pg8::gemm_phase<epi::EpiProj, pg8::StaticOrder, true, true>(lds, g, S, E);
}
DI void phase_prep(const Params& p, LAS unsigned char* lds, int rep = 0) {
    unsigned* ctr = (unsigned*)(p.ws + WS_CTL) + 64 + 256 * rep;
    constexpr int NU = cmp::NUNIT + NBP * GH * NCHUNK;
    for (;;) {
        const int u = next_unit(ctr, lds); if (u >= NU) break;
        Params q = p; asm volatile("" : "+s"(q.ws), "+s"(q.out));
        if (u < cmp::NUNIT) { const int v = cmp::NUNIT - 1 - u; cmp::unit(q, lds, v); }
        else { const int v = u - cmp::NUNIT; gdn::prep_unit(q, lds, v >> 9, (v >> 7) & 3, v & 127); }
    }
}
DI void phase_mix(const Params& p, LAS unsigned char* lds, int rep = 0) {
    unsigned* ctr = (unsigned*)(p.ws + WS_CTL) + 128 + 256 * rep;
    constexpr int NU = 32 + 64 + 128 + 512;
    for (;;) {
        const int u = next_unit(ctr, lds); if (u >= NU) break;
        Params q = p; asm volatile("" : "+s"(q.ws), "+s"(q.out));
        if (u < 32) gdn::scan_unit(q, lds, u >> 4, (u >> 2) & 3, u & 3);
        else if (u < 96) { const int v = u - 32; samp::attn_unit(q, lds, v >> 1, v & 1); }
        else if (u < 224) { const int v = u - 96; samp::gdn_unit(q, lds, v >> 2, v & 3); }
        else { const int v = u - 224; attn::unit(q, lds, (v >> 1) & 1, v & 1, 127 - (v >> 2)); }
    }
}
template <int MODE> DI void skinny_rows(const Params& p, LAS unsigned char* lds, const bf16_t* A, const bf16_t* Bt, int K, int N) {
    int tid_ = threadIdx.x; asm volatile("" : "+v"(tid_)); const int tid = tid_, lane = tid & 63, wave = __builtin_amdgcn_readfirstlane(tid >> 6), hi = lane >> 5, cl = lane & 31;
    const int tile = blockIdx.x; if (tile >= N / 32) return;
    const int nks = K / 16, per = (nks + 7) / 8, k0 = wave * per, k1 = (k0 + per < nks) ? k0 + per : nks;
    const bf16_t* a = A + (size_t)(MP + cl) * K + hi * 8; const bf16_t* b = Bt + (size_t)(tile * 32 + cl) * K + hi * 8;
    f32x16 acc; for (int i = 0; i < 16; ++i) acc[i] = 0.f;
#pragma unroll 4
    for (int ks = k0; ks < k1; ++ks) acc = MFMA32(*(const bf16x8*)(a + ks * 16), *(const bf16x8*)(b + ks * 16), acc);
    LAS float* PART = (LAS float*)lds;
    __syncthreads();
#pragma unroll
    for (int r = 0; r < 16; ++r) PART[(wave * 32 + crow(r, hi)) * 32 + cl] = acc[r];
    __syncthreads();
    for (int i = tid; i < 1024; i += NTHREADS) {
        const int row = i >> 5, col = tile * 32 + (i & 31); float s = 0.f;
#pragma unroll
        for (int w = 0; w < 8; ++w) s += PART[(w * 32 + row) * 32 + (i & 31)];
        float* hp = (float*)(p.ws + WS_HP) + (size_t)(MP + row) * DM + col;
        if (MODE == 0) { const float h = p.x_sample[(size_t)row * DM + col] + s; *hp = h; ((bf16_t*)(p.ws + WS_HPB))[(size_t)(MP + row) * DM + col] = f2bf(h);
            float sq = h * h; sq += __shfl_xor(sq, 1); sq += __shfl_xor(sq, 2); sq += __shfl_xor(sq, 4); sq += __shfl_xor(sq, 8); sq += __shfl_xor(sq, 16);
            if ((i & 31) == 0) atomicAdd((float*)(p.ws + WS_SSQ1) + MP + row, sq); }
        else *hp += s;
    }
    __syncthreads();
}

DI void phase_out(const Params& p, LAS unsigned char* lds) {
    pg8::Gemm g{(const bf16_t*)(p.ws + WS_MIX), (const bf16_t*)(p.ws + WS_WOUT), MP, DM, DM};
    pg8::StaticOrder S; S.init(MP, DM, gridDim.x, blockIdx.x);
    epi::EpiOut E{p.x_prompt, p.x_sample, p.ws};
    pg8::gemm_phase<epi::EpiOut, pg8::StaticOrder, true, true>(lds, g, S, E);
    skinny_rows<0>(p, lds, (const bf16_t*)(p.ws + WS_MIX), (const bf16_t*)(p.ws + WS_WOUT), DM, DM);
}
DI void phase_up(const Params& p, LAS unsigned char* lds) {
    pg8::Gemm g{(const bf16_t*)(p.ws + WS_HPB), (const bf16_t*)(p.ws + WS_WGU), MROWS, 2 * DFF, DM};
    pg8::StaticOrder S; S.init(MROWS, 2 * DFF, gridDim.x, blockIdx.x);
    epi::EpiUp E{p.ws};
    pg8::gemm_phase<epi::EpiUp, pg8::StaticOrder, true, true>(lds, g, S, E);
}
DI void phase_down(const Params& p, LAS unsigned char* lds) {
    pg8::Gemm g{(const bf16_t*)(p.ws + WS_HID), (const bf16_t*)(p.ws + WS_WDN), MP, DM, DFF};
    pg8::StaticOrder S; S.init(MP, DM, gridDim.x, blockIdx.x);
    epi::EpiDown E{p.ws};
    pg8::gemm_phase<epi::EpiDown, pg8::StaticOrder, true, true>(lds, g, S, E);
    skinny_rows<1>(p, lds, (const bf16_t*)(p.ws + WS_HID), (const bf16_t*)(p.ws + WS_WDN), DFF, DM);
}
DI void phase_final(const Params& p) {
    int tid_ = threadIdx.x; asm volatile("" : "+v"(tid_)); const int tid = tid_, lane = tid & 63, gw = blockIdx.x * 8 + (tid >> 6), NGW = gridDim.x * 8;
    for (int row = gw; row < MP + NBS; row += NGW) {
        const float* hr = (const float*)(p.ws + WS_HP) + (size_t)row * DM;
        float* o = row < MP ? p.out + O_YP + (size_t)row * DM : p.out + O_YS + (size_t)(row - MP) * DM;
        f32x4 v[4]; float s = 0.f;
#pragma unroll
        for (int j = 0; j < 4; ++j) { v[j] = *(const f32x4*)(hr + (j * 64 + lane) * 4); s += v[j][0] * v[j][0] + v[j][1] * v[j][1] + v[j][2] * v[j][2] + v[j][3] * v[j][3]; }
        const float rs = rsqrtf(wave_sum(s) * (1.f / DM) + EPS);
#pragma unroll
        for (int j = 0; j < 4; ++j) { const f32x4 g = *(const f32x4*)(p.norm_final + (j * 64 + lane) * 4); *(f32x4*)(o + (j * 64 + lane) * 4) = (f32x4){v[j][0] * rs * g[0], v[j][1] * rs * g[1], v[j][2] * rs * g[2], v[j][3] * rs * g[3]}; }
    }
}

#define LDS_DECL extern __shared__ __attribute__((aligned(16))) unsigned char lds_raw[]; LAS unsigned char* lds = (LAS unsigned char*)lds_raw
#ifndef MK_MULTI
#define MK_MULTI 0
#endif
#ifndef MK_PROBE
#define MK_PROBE 0
#endif
#ifndef MK_DUP
#define MK_DUP 0
#endif
#if MK_MULTI
__global__ void __launch_bounds__(NTHREADS, 2) k_p0(Params p) { p0::run(p); }
__global__ void __launch_bounds__(NTHREADS, 2) k_p1(Params p) { LDS_DECL; phase_proj(p, lds); }
__global__ void __launch_bounds__(NTHREADS, 2) k_p2(Params p) { LDS_DECL; phase_prep(p, lds); }
__global__ void __launch_bounds__(NTHREADS, 2) k_p3(Params p) { LDS_DECL; phase_mix(p, lds); }
__global__ void __launch_bounds__(NTHREADS, 2) k_p4(Params p) { gdn::post(p); }
__global__ void __launch_bounds__(NTHREADS, 2) k_p5(Params p) { LDS_DECL; phase_out(p, lds); }
__global__ void __launch_bounds__(NTHREADS, 2) k_p6(Params p) { LDS_DECL; phase_up(p, lds); }
__global__ void __launch_bounds__(NTHREADS, 2) k_p7(Params p) { LDS_DECL; phase_down(p, lds); }
__global__ void __launch_bounds__(NTHREADS, 2) k_p8(Params p) { phase_final(p); }
#else
__global__ void __launch_bounds__(NTHREADS, 2) k_mega(Params p) {
    LDS_DECL;
    cg::grid_group grid = cg::this_grid();
    if (threadIdx.x < 2) ((LAS unsigned*)(lds + LDS_BARW))[threadIdx.x] = 0u;
    __syncthreads();
    const XcdBarrier xbar = xcd_barrier_post((unsigned*)(p.ws + WS_CTL) + CW_BAR, (volatile LAS unsigned*)(lds + LDS_BARW));
#define SEAM() xcd_barrier(xbar)
#define PHASE(call) do { Params q = p; asm volatile("" : "+s"(q.ws), "+s"(q.out)); call; } while (0)
#if MK_PROBE
    unsigned long long* ts = (unsigned long long*)(p.ws + WS_CTL) + 1024;
#define STAMP(k) do { if (blockIdx.x == 0 && threadIdx.x == 0) ts[k] = __builtin_amdgcn_s_memrealtime(); } while (0)
#else
#define STAMP(k) do { } while (0)
#endif
    STAMP(0);
    PHASE(p0::run(q));            grid.sync(); STAMP(1);
#if MK_DUP & 1
    PHASE(p0::run(q));            SEAM();
#endif
    PHASE(phase_proj(q, lds));    SEAM();      STAMP(2);
    PHASE(phase_prep(q, lds));    SEAM();      STAMP(3);
#if MK_DUP & 2
    PHASE(phase_prep(q, lds, 1)); SEAM();
#endif
    PHASE(phase_mix(q, lds));     SEAM();      STAMP(4);
#if MK_DUP & 4
    PHASE(phase_mix(q, lds, 1));  SEAM();
#endif
#if MK_DUP & 8
    SEAM(); SEAM(); SEAM(); SEAM(); SEAM(); SEAM(); SEAM(); SEAM();
#endif
    PHASE(gdn::post(q));          SEAM();      STAMP(5);
    PHASE(phase_out(q, lds));     SEAM();      STAMP(6);
    PHASE(phase_up(q, lds));      SEAM();      STAMP(7);
    PHASE(phase_down(q, lds));    SEAM();      STAMP(8);
    PHASE(phase_final(q));
#if MK_PROBE
    grid.sync(); STAMP(9);
    if (blockIdx.x == 0) {
        __syncthreads();
        const size_t offs[10] = {O_YP, O_YS, O_KVP, O_WINP, O_SP, O_CONVP, O_KVS, O_WINS, O_SS, O_CONVS};
        for (int k = 0; k < 10; ++k) {
            const unsigned long long t0 = k < 9 ? ts[k] : ts[0], t1 = k < 9 ? ts[k + 1] : ts[9];
            int n = (int)((t1 - t0) / 10ull); if (k == 9) n = (int)((t1 - t0) / 100ull);
            if (n > 9000) n = 9000; if (n < 1) n = 1;
            unsigned* o = (unsigned*)(p.out + offs[k]);
            for (int i = threadIdx.x; i < n; i += NTHREADS) o[i] = 0xAAAAAAAAu;
        }
    }
#endif
}
#endif

extern "C" void kernel_launch(void* const* d_in, const int* in_sizes, int n_in, void* d_out, int out_size, void* d_ws, size_t ws_size, hipStream_t stream) {
    static int grid = 0;
    if (grid == 0) {
        if (n_in != 20 || out_size != (int)O_END || ws_size < WS_END) { fprintf(stderr, "kernel_launch: unexpected shapes n_in %d out %d ws %zu\n", n_in, out_size, ws_size); grid = -1; return; }
        int dev = 0, cus = 0;
        (void)hipGetDevice(&dev); (void)hipDeviceGetAttribute(&cus, hipDeviceAttributeMultiprocessorCount, dev);
#if MK_MULTI
        const void* ks[] = {(const void*)k_p1, (const void*)k_p2, (const void*)k_p3, (const void*)k_p5, (const void*)k_p6, (const void*)k_p7};
        for (auto k : ks) (void)hipFuncSetAttribute(k, hipFuncAttributeMaxDynamicSharedMemorySize, LDS_BYTES);
        grid = cus > 0 ? cus : 256;
#else
        (void)hipFuncSetAttribute((const void*)k_mega, hipFuncAttributeMaxDynamicSharedMemorySize, LDS_BYTES);
        int per_cu = 0;
        if (hipOccupancyMaxActiveBlocksPerMultiprocessor(&per_cu, (const void*)k_mega, NTHREADS, LDS_BYTES) != hipSuccess || per_cu < 1) { fprintf(stderr, "kernel_launch: occupancy query failed (%d)\n", per_cu); (void)hipGetLastError(); per_cu = 1; }
        if (per_cu > 1) per_cu = 1;
        grid = (cus > 0 ? cus : 256) * per_cu;
#endif
    }
    if (grid < 0) return;
    Params p{};
    p.x_prompt = (const float*)d_in[0]; p.x_sample = (const float*)d_in[1]; p.cache_kv = (const float*)d_in[2]; p.cache_win = (const float*)d_in[3];
    p.state_S = (const float*)d_in[4]; p.state_conv = (const float*)d_in[5]; p.page_table = (const int*)d_in[6]; p.norm_mix = (const float*)d_in[7];
    p.w_in = (const float*)d_in[8]; p.cmp_pe = (const float*)d_in[9]; p.cmp_w = (const float*)d_in[10]; p.conv_w = (const float*)d_in[11];
    p.a_log = (const float*)d_in[12]; p.dt_bias = (const float*)d_in[13]; p.gdn_norm = (const float*)d_in[14]; p.w_out = (const float*)d_in[15];
    p.norm_ffn = (const float*)d_in[16]; p.w_gate_up = (const float*)d_in[17]; p.w_down = (const float*)d_in[18]; p.norm_final = (const float*)d_in[19];
    p.out = (float*)d_out; p.ws = (unsigned char*)d_ws;
    (void)hipMemsetAsync((char*)d_ws + WS_CTL, 0, WS_ZERO_BYTES, stream);
#if MK_MULTI
    hipLaunchKernelGGL(k_p0, dim3(grid), dim3(NTHREADS), 0, stream, p);
    hipLaunchKernelGGL(k_p1, dim3(grid), dim3(NTHREADS), LDS_BYTES, stream, p);
    hipLaunchKernelGGL(k_p2, dim3(grid), dim3(NTHREADS), LDS_BYTES, stream, p);
    hipLaunchKernelGGL(k_p3, dim3(grid), dim3(NTHREADS), LDS_BYTES, stream, p);
    hipLaunchKernelGGL(k_p4, dim3(grid), dim3(NTHREADS), 0, stream, p);
    hipLaunchKernelGGL(k_p5, dim3(grid), dim3(NTHREADS), LDS_BYTES, stream, p);
    hipLaunchKernelGGL(k_p6, dim3(grid), dim3(NTHREADS), LDS_BYTES, stream, p);
    hipLaunchKernelGGL(k_p7, dim3(grid), dim3(NTHREADS), LDS_BYTES, stream, p);
    hipLaunchKernelGGL(k_p8, dim3(grid), dim3(NTHREADS), 0, stream, p);
#else
    void* args[] = {&p};
    hipError_t e = hipLaunchCooperativeKernel((const void*)k_mega, dim3(grid), dim3(NTHREADS), args, LDS_BYTES, stream);
    if (e != hipSuccess) fprintf(stderr, "kernel_launch: cooperative launch failed: %s (grid %d)\n", hipGetErrorString(e), grid);
#endif
}
```

```cpp
#include <hip/hip_runtime.h>
#include <hip/hip_cooperative_groups.h>
#include <cstdio>
#include <cstdint>
namespace cg = cooperative_groups;
#ifndef MK_PROBE
#define MK_PROBE 0
#endif

#define DI __device__ __forceinline__
#define LAS __attribute__((address_space(3)))
typedef unsigned short bf16_t;
typedef short bf16x8 __attribute__((ext_vector_type(8)));
typedef short s16x4 __attribute__((ext_vector_type(4)));
typedef float f32x4 __attribute__((ext_vector_type(4)));
typedef float f32x2 __attribute__((ext_vector_type(2)));
typedef float f32x16 __attribute__((ext_vector_type(16)));
typedef unsigned u32x4 __attribute__((ext_vector_type(4)));
typedef unsigned u32x2 __attribute__((ext_vector_type(2)));
typedef __bf16 bf16x2_t __attribute__((ext_vector_type(2)));

constexpr int DM = 1024, TP = 8192, NBP = 2, MP = NBP * TP, NBS = 32, MROWS = 16640  ;
constexpr int HD = 64, NQH = 8, NG = 2, NREP = 4;
constexpr int NPAGES = 64, PAGE = 128, NPOOL = 2560;
constexpr int GH = 4, GDK = 128, GDV = 128, CCH = 1536, NCHUNK = 128;
constexpr int INW = 3360, INW_PAD = 3584, DFF = 2816;
constexpr int NCMP = 511;
constexpr float EPS = 1e-6f, LOG2E = 1.4426950408889634f, QSCALE = 0.125f * LOG2E, NEGBIG = -1e30f;

constexpr size_t O_YP = 0, O_YS = 16777216, O_KVP = 16809984, O_WINP = 25198592, O_SP = 25460736, O_CONVP = 25591808,
                 O_KVS = 25601024, O_WINS = 25617408, O_SS = 29811712, O_CONVS = 31908864, O_END = 32056320;

constexpr size_t MiB = 1u << 20;
constexpr size_t WS_CTL = 0;
constexpr size_t WS_SSQ1 = 1 * MiB, WS_SSQ2 = WS_SSQ1 + 128 * 1024;
constexpr size_t WS_ZERO_BYTES = 2 * MiB;
constexpr size_t WS_WIN = 2 * MiB;
constexpr size_t WS_WOUT = 10 * MiB;
constexpr size_t WS_WGU = 12 * MiB;
constexpr size_t WS_WDN = 24 * MiB;
constexpr size_t WS_WCMP = 30 * MiB;
constexpr size_t WS_CST = 31 * MiB;
constexpr size_t WS_ROPE = 32 * MiB;
constexpr size_t WS_XN = 36 * MiB;
constexpr size_t WS_QB = 70 * MiB;
constexpr size_t WS_KC = 88 * MiB, WS_VC = 93 * MiB;
constexpr size_t WS_KSEL = 98 * MiB, WS_VSELT = 103 * MiB;
constexpr size_t WS_KWIN = 108 * MiB, WS_VWINT = 113 * MiB;
constexpr size_t WS_CI = 118 * MiB;
constexpr size_t WS_Z = 168 * MiB;
constexpr size_t WS_GT = 186 * MiB;
constexpr size_t WS_CKP = 190 * MiB, WS_CVTP = 191 * MiB;
constexpr size_t WS_CKS = 192 * MiB, WS_CVS = 200 * MiB;
constexpr size_t WS_MIX = 208 * MiB;
constexpr size_t WS_HP = 242 * MiB;
constexpr size_t WS_HPB = 308 * MiB;
constexpr size_t WS_HID = 342 * MiB;
constexpr size_t WS_VSEL = 553 * MiB, WS_VWIN = 557 * MiB;
constexpr size_t WS_GW = 432 * MiB;
constexpr size_t WS_GQG = 448 * MiB;
constexpr size_t WS_GKGT = 464 * MiB;
constexpr size_t WS_GAQK = 480 * MiB;
constexpr size_t WS_GU = 488 * MiB;
constexpr size_t WS_GGL = 520 * MiB;
constexpr size_t WS_OG = 521 * MiB;
constexpr size_t WS_END = 562 * MiB;
constexpr int CW_Q3 = 64;

struct Params {
    const float *x_prompt, *x_sample, *cache_kv, *cache_win, *state_S, *state_conv;
    const int* page_table;
    const float *norm_mix, *w_in, *cmp_pe, *cmp_w, *conv_w, *a_log, *dt_bias, *gdn_norm, *w_out, *norm_ffn, *w_gate_up, *w_down, *norm_final;
    float* out;
    unsigned char* ws;
};

DI unsigned pk2(float lo, float hi) { f32x2 v = {lo, hi}; bf16x2_t b = __builtin_convertvector(v, bf16x2_t); return __builtin_bit_cast(unsigned, b); }
DI bf16_t f2bf(float f) { return (bf16_t)(pk2(f, 0.f) & 0xffffu); }
DI float bf2f(bf16_t h) { return __uint_as_float(((unsigned)h) << 16); }
DI float sigmoidf_(float x) { return 1.f / (1.f + __expf(-x)); }
DI float siluf_(float x) { return x / (1.f + __expf(-x)); }
DI float wave_sum(float v) {
#pragma unroll
    for (int o = 1; o < 64; o <<= 1) v += __shfl_xor(v, o);
    return v;
}
#define MFMA32(a, b, c) __builtin_amdgcn_mfma_f32_32x32x16_bf16((a), (b), (c), 0, 0, 0)
DI int crow(int r, int hi) { return (r & 3) + 8 * (r >> 2) + 4 * hi; }
#define LDS_FADD(ptr, v) (void)__hip_atomic_fetch_add((ptr), (v), __ATOMIC_RELAXED, __HIP_MEMORY_SCOPE_WORKGROUP)
#if MK_PROBE == 2
__device__ unsigned long long g_acc[8];
#define TICK_INIT() unsigned long long tk_ = __builtin_amdgcn_s_memrealtime()
#define TICK(k) do { const unsigned long long now_ = __builtin_amdgcn_s_memrealtime(); if (blockIdx.x == 0 && threadIdx.x == 0) g_acc[k] += now_ - tk_; tk_ = now_; } while (0)
#else
#define TICK_INIT() do { } while (0)
#define TICK(k) do { } while (0)
#endif
namespace pg8 {
#define PG8_LAS __attribute__((address_space(3)))
typedef ::bf16_t bf16_t;
typedef ::bf16x8 bf16x8;
typedef ::f32x4 f32x4;
typedef ::u32x4 u32x4;
constexpr int BM = 256, BK = 64, HALF = 128, HTB = HALF * BK * 2  , STAGE_BYTES = 8 * HTB, NXCD = 8, WGM = 8;

__host__ __device__ __forceinline__ int lds_byte(int r, int c) { const int st = (r >> 4) * 2 + (c >> 5), rr = r & 15, cc = c & 31, ob = rr * 64 + cc * 2; return st * 1024 + (ob ^ (((ob >> 9) & 1) << 5)); }
__host__ __device__ __forceinline__ void stage_rc(int b, int& R, int& C) { const int st = b / 1024, sb = b % 1024, swz = sb ^ (((sb >> 9) & 1) << 5); R = (st >> 1) * 16 + swz / 64; C = (st & 1) * 32 + (swz % 64) / 2; }
__host__ __device__ __forceinline__ int perm32(int rho) { const int n = rho >> 4, i = rho & 15; return 8 * (i >> 2) + 4 * n + (i & 3); }

struct Unit { int pm, pn; };
struct Gemm { const bf16_t* A; const bf16_t* Bt; int M, N, K; };

struct StaticOrder {
    int nM, nN, nwg, G, c;
    __host__ __device__ void init(int M, int N, int G_, int c_) { nM = M / BM; nN = N / BM; nwg = nM * nN; G = G_; c = c_; }
    __host__ __device__ bool next(int i, Unit& u) const {
        const long L = (long)i * G + c; if (L >= nwg) return false;
        int wgid = (int)L; { const int q = nwg / NXCD, r = nwg % NXCD, xcd = wgid % NXCD, off = wgid / NXCD; wgid = (xcd < r ? xcd * (q + 1) : r * (q + 1) + (xcd - r) * q) + off; }
        const int nig = WGM * nN, gid = wgid / nig, fm = gid * WGM, gsz = (nM - fm) < WGM ? (nM - fm) : WGM;
        u.pm = fm + ((wgid % nig) % gsz); u.pn = (wgid % nig) / gsz; return true;
    }
    __device__ __forceinline__ void a_ready(const Unit&) const {}
    __device__ __forceinline__ void done(const Unit&) const {}
};


template <class Epi, class Sched, bool ALIGN_EPI = false, bool SP2 = false>
__device__ __forceinline__ void gemm_phase(PG8_LAS unsigned char* lds, const Gemm g, const Sched& S, const Epi& E) {
    int tid_ = threadIdx.x; asm volatile("" : "+v"(tid_)); const int tid = tid_, wid = __builtin_amdgcn_readfirstlane(tid >> 6), lane = tid & 63, wr = wid >> 2, wc = wid & 3, fr = lane & 15, fq = lane >> 4;
    const int K = g.K, nt = K / BK;
    unsigned voffA[2], voffB[2];
#pragma unroll
    for (int i = 0; i < 2; ++i) { int R, C; stage_rc(tid * 16 + i * 8192, R, C); const int Rb = Epi::PERM ? ((R & ~31) + perm32(R & 31)) : R;
        voffA[i] = (unsigned)(R * K + C) * 2u; voffB[i] = (unsigned)(Rb * K + C) * 2u; }
    const size_t kstep = (size_t)(BK * 2);
    const size_t hstep = (size_t)HALF * K * 2;
    const size_t tstep = 2 * hstep;
    const unsigned ldsw = (unsigned)wid * 1024u;
    const int aoff = lds_byte(wr * 64 + fr, fq * 8), boff = lds_byte(wc * 32 + fr, fq * 8);
#define PG8_SA(b, h) (((b) * 2 + (h)) * HTB)
#define PG8_SB(b, h) ((4 + (b) * 2 + (h)) * HTB)
#define PG8_STAGE(bufoff, gbase, voff) do { _Pragma("unroll") for (int _i = 0; _i < 2; ++_i) \
        __builtin_amdgcn_global_load_lds((const unsigned*)((const char*)(gbase) + (voff)[_i]), (PG8_LAS unsigned*)(lds + (bufoff) + ldsw + _i * 8192), 16, 0, 0); } while (0)
#define PG8_LDA(dst, b, h) do { _Pragma("unroll") for (int m = 0; m < 4; ++m) _Pragma("unroll") for (int k = 0; k < 2; ++k) dst[m][k] = *(const PG8_LAS bf16x8*)(lds + PG8_SA(b, h) + aoff + m * 2048 + k * 1024); } while (0)
#define PG8_LDB(dst, b, h) do { _Pragma("unroll") for (int n = 0; n < 2; ++n) _Pragma("unroll") for (int k = 0; k < 2; ++k) dst[n][k] = *(const PG8_LAS bf16x8*)(lds + PG8_SB(b, h) + boff + n * 2048 + k * 1024); } while (0)
#define PG8_MMA(ai, bj, At, Bt) do { __builtin_amdgcn_s_setprio(1); _Pragma("unroll") for (int m = 0; m < 4; ++m) _Pragma("unroll") for (int n = 0; n < 2; ++n) _Pragma("unroll") for (int k = 0; k < 2; ++k) \
        acc[ai][bj][m][n] = __builtin_amdgcn_mfma_f32_16x16x32_bf16(Bt[n][k], At[m][k], acc[ai][bj][m][n], 0, 0, 0); __builtin_amdgcn_s_setprio(0); } while (0)
#define PG8_WAIT_V(n) asm volatile("s_waitcnt vmcnt(" #n ")" ::: "memory")
#define PG8_WAIT_L(n) asm volatile("s_waitcnt lgkmcnt(" #n ")" ::: "memory")
#define PG8_BAR __builtin_amdgcn_s_barrier()
#define PG8_SCHED __builtin_amdgcn_sched_barrier(0)
    Unit cur, nxt; int ui = 0;
    if (!S.next(0, cur)) return;
    f32x4 acc[2][2][4][2];
#pragma unroll
    for (int a = 0; a < 2; ++a)
#pragma unroll
        for (int b = 0; b < 2; ++b)
#pragma unroll
            for (int m = 0; m < 4; ++m)
#pragma unroll
                for (int n = 0; n < 2; ++n) acc[a][b][m][n] = (f32x4){0.f, 0.f, 0.f, 0.f};
    bf16x8 At[4][2], B0[2][2], B1[2][2];
    const char* cA = (const char*)g.A + (size_t)cur.pm * tstep; const char* cB = (const char*)g.Bt + (size_t)cur.pn * tstep;
    S.a_ready(cur);
    if constexpr (SP2) {
        PG8_STAGE(PG8_SB(0, 0), cB, voffB); PG8_STAGE(PG8_SB(0, 1), cB + hstep, voffB); PG8_STAGE(PG8_SA(0, 0), cA, voffA); PG8_STAGE(PG8_SA(0, 1), cA + hstep, voffA);
        if (wr == 1) PG8_BAR;
        PG8_WAIT_V(2); PG8_BAR;
        PG8_STAGE(PG8_SB(1, 0), cB + kstep, voffB); PG8_STAGE(PG8_SA(1, 0), cA + kstep, voffA); PG8_STAGE(PG8_SB(1, 1), cB + hstep + kstep, voffB);
        PG8_WAIT_V(6); PG8_BAR;
    } else {
        PG8_STAGE(PG8_SB(0, 0), cB, voffB); PG8_STAGE(PG8_SA(0, 0), cA, voffA); PG8_STAGE(PG8_SB(0, 1), cB + hstep, voffB); PG8_STAGE(PG8_SA(0, 1), cA + hstep, voffA);
        if (wr == 1) PG8_BAR;
        PG8_WAIT_V(4); PG8_BAR;
        PG8_STAGE(PG8_SB(1, 0), cB + kstep, voffB); PG8_STAGE(PG8_SA(1, 0), cA + kstep, voffA); PG8_STAGE(PG8_SB(1, 1), cB + hstep + kstep, voffB);
        PG8_WAIT_V(6); PG8_BAR;
    }
    for (;;) {
        const bool has_next = S.next(ui + 1, nxt);
        const char* nA = has_next ? (const char*)g.A + (size_t)nxt.pm * tstep : cA; const char* nB = has_next ? (const char*)g.Bt + (size_t)nxt.pn * tstep : cB;
        for (int t = 0; t < nt; t += 2) {
            const bool last = (t == nt - 2);
            const char* a1 = cA + (size_t)(t + 1) * kstep;
            const char* a2 = last ? nA : cA + (size_t)(t + 2) * kstep; const char* b2 = last ? nB : cB + (size_t)(t + 2) * kstep;
            const char* a3 = a2 + kstep; const char* b3 = b2 + kstep;
            if (last && has_next) S.a_ready(nxt);
            if constexpr (SP2) {
            PG8_LDB(B0, 0, 0); PG8_LDB(B1, 0, 1); PG8_SCHED; PG8_LDA(At, 0, 0); PG8_STAGE(PG8_SA(1, 1), a1 + hstep, voffA);
            PG8_WAIT_V(8); PG8_WAIT_L(0); PG8_BAR; PG8_MMA(0, 0, At, B0); PG8_MMA(0, 1, At, B1); PG8_BAR; PG8_SCHED;
            PG8_LDA(At, 0, 1); PG8_STAGE(PG8_SB(0, 0), b2, voffB); PG8_STAGE(PG8_SB(0, 1), b2 + hstep, voffB); PG8_STAGE(PG8_SA(0, 0), a2, voffA);
            PG8_WAIT_V(8); PG8_WAIT_L(0); PG8_BAR; PG8_MMA(1, 0, At, B0); PG8_MMA(1, 1, At, B1); PG8_BAR; PG8_SCHED;
            PG8_LDB(B0, 1, 0); PG8_LDB(B1, 1, 1); PG8_SCHED; PG8_LDA(At, 1, 0); PG8_STAGE(PG8_SA(0, 1), a2 + hstep, voffA);
            PG8_WAIT_V(8); PG8_WAIT_L(0); PG8_BAR; PG8_MMA(0, 0, At, B0); PG8_MMA(0, 1, At, B1); PG8_BAR; PG8_SCHED;
            PG8_LDA(At, 1, 1); PG8_STAGE(PG8_SB(1, 0), b3, voffB); PG8_STAGE(PG8_SB(1, 1), b3 + hstep, voffB); PG8_STAGE(PG8_SA(1, 0), a3, voffA);
            PG8_WAIT_V(8); PG8_WAIT_L(0); PG8_BAR; PG8_MMA(1, 0, At, B0); PG8_MMA(1, 1, At, B1); PG8_BAR; PG8_SCHED;
            } else {
            PG8_LDB(B0, 0, 0); PG8_SCHED; PG8_LDA(At, 0, 0); PG8_STAGE(PG8_SA(1, 1), a1 + hstep, voffA);
            PG8_WAIT_L(8); PG8_BAR; PG8_WAIT_L(0); PG8_MMA(0, 0, At, B0); PG8_BAR; PG8_SCHED;
            PG8_LDB(B1, 0, 1); PG8_STAGE(PG8_SB(0, 0), b2, voffB);
            PG8_BAR; PG8_WAIT_L(0); PG8_MMA(0, 1, At, B1); PG8_BAR;
            PG8_LDA(At, 0, 1); PG8_STAGE(PG8_SA(0, 0), a2, voffA);
            PG8_BAR; PG8_WAIT_L(0); PG8_MMA(1, 0, At, B0); PG8_BAR; PG8_SCHED;
            PG8_STAGE(PG8_SB(0, 1), b2 + hstep, voffB);
            PG8_WAIT_V(6); PG8_BAR; PG8_MMA(1, 1, At, B1); PG8_BAR;
            PG8_LDB(B0, 1, 0); PG8_SCHED; PG8_LDA(At, 1, 0); PG8_STAGE(PG8_SA(0, 1), a2 + hstep, voffA);
            PG8_WAIT_L(8); PG8_BAR; PG8_WAIT_L(0); PG8_MMA(0, 0, At, B0); PG8_BAR; PG8_SCHED;
            PG8_LDB(B1, 1, 1); PG8_STAGE(PG8_SB(1, 0), b3, voffB);
            PG8_BAR; PG8_WAIT_L(0); PG8_MMA(0, 1, At, B1); PG8_BAR;
            PG8_LDA(At, 1, 1); PG8_STAGE(PG8_SA(1, 0), a3, voffA);
            PG8_BAR; PG8_WAIT_L(0); PG8_MMA(1, 0, At, B0); PG8_BAR; PG8_SCHED;
            PG8_STAGE(PG8_SB(1, 1), b3 + hstep, voffB);
            PG8_WAIT_V(6); PG8_BAR; PG8_MMA(1, 1, At, B1); PG8_BAR;
            }
        }
        if constexpr (ALIGN_EPI) { if (wr == 0) PG8_BAR; }
        if constexpr (!Epi::AFTER_DRAIN) { E(acc, cur, wr, wc, fr, fq); S.done(cur); }
        if (!has_next) break;
#pragma unroll
        for (int a = 0; a < 2; ++a)
#pragma unroll
            for (int b = 0; b < 2; ++b)
#pragma unroll
                for (int m = 0; m < 4; ++m)
#pragma unroll
                    for (int n = 0; n < 2; ++n) acc[a][b][m][n] = (f32x4){0.f, 0.f, 0.f, 0.f};
        cur = nxt; cA = nA; cB = nB; ++ui;
        if constexpr (ALIGN_EPI) { if (wr == 1) PG8_BAR; }
    }
    PG8_WAIT_V(0);
    if constexpr (!ALIGN_EPI) { if (wr == 0) PG8_BAR; }
    PG8_BAR;
    if constexpr (Epi::AFTER_DRAIN) { E.fused(acc, cur, wr, wc, fr, fq, lds, wid, lane); S.done(cur); }
#undef PG8_SA
#undef PG8_SB
#undef PG8_STAGE
#undef PG8_LDA
#undef PG8_LDB
#undef PG8_MMA
#undef PG8_WAIT_V
#undef PG8_WAIT_L
#undef PG8_BAR
#undef PG8_SCHED
}
}
namespace epi {
using pg8::Unit;
#define EPI_V8(ai, bj, m) const float v[8] = {acc[ai][bj][m][0][0], acc[ai][bj][m][0][1], acc[ai][bj][m][0][2], acc[ai][bj][m][0][3], acc[ai][bj][m][1][0], acc[ai][bj][m][1][1], acc[ai][bj][m][1][2], acc[ai][bj][m][1][3]}
DI void st_bf16x8(bf16_t* p, const float* v) { u32x4 w; w.x = pk2(v[0], v[1]); w.y = pk2(v[2], v[3]); w.z = pk2(v[4], v[5]); w.w = pk2(v[6], v[7]); *(u32x4*)p = w; }
DI void st_bf16x4(bf16_t* p, float a, float b, float c, float d) { u32x2 w; w.x = pk2(a, b); w.y = pk2(c, d); *(u32x2*)p = w; }
DI void st_f32x4(float* p, float a, float b, float c, float d) { *(f32x4*)p = (f32x4){a, b, c, d}; }

struct EpiProj {
    static constexpr bool PERM = true, AFTER_DRAIN = false;
    float* out; unsigned char* ws; const float* a_log; const float* dt_bias;
    DI void operator()(const f32x4 (&acc)[2][2][4][2], const Unit& u, int wr, int wc, int fr, int fq) const {
        const int pn = u.pn;
        const float* cosT = (const float*)(ws + WS_ROPE); const float* sinT = cosT + 8193 * 32;
#pragma unroll
        for (int ai = 0; ai < 2; ++ai)
#pragma unroll
            for (int m = 0; m < 4; ++m) {
                const int row = u.pm * 256 + ai * 128 + wr * 64 + m * 16 + fr;
                if (row >= MP + NBS) continue;
                const bool samp = row >= MP; const int b = row >> 13, t = row & (TP - 1), bs = row - MP;
                const int pos = samp ? TP : t;
#pragma unroll
                for (int bj = 0; bj < 2; ++bj) {
                    EPI_V8(ai, bj, m);
                    const int cw = bj * 128 + wc * 32 + fq * 8;
                    if (pn < 2) {
                        const int head = (pn * 256 + cw) >> 6, i0 = (cw & 63) >> 1;
                        const f32x4 c4 = *(const f32x4*)(cosT + pos * 32 + i0), s4 = *(const f32x4*)(sinT + pos * 32 + i0);
                        float o1[4], o2[4];
#pragma unroll
                        for (int q = 0; q < 4; ++q) { const float x1 = v[2 * q], x2 = v[2 * q + 1]; o1[q] = (x1 * c4[q] - x2 * s4[q]) * QSCALE; o2[q] = (x2 * c4[q] + x1 * s4[q]) * QSCALE; }
                        bf16_t* qb = (bf16_t*)(ws + WS_QB) + (size_t)row * 512 + head * 64 + i0;
                        st_bf16x4(qb, o1[0], o1[1], o1[2], o1[3]); st_bf16x4(qb + 32, o2[0], o2[1], o2[2], o2[3]);
                    } else if (pn < 5) {
                        const int br = pn - 2, g = wc >> 1, cc = (wc & 1) * 32 + fq * 8;
                        float* dst;
                        if (!samp) dst = (br < 2) ? out + O_KVP + ((size_t)(b * TP + t) * 4 + 2 * br + bj) * 128 + g * 64
                                                  : (t >= TP - 512 ? out + O_WINP + ((size_t)(b * 512 + t - (TP - 512)) * 2 + bj) * 128 + g * 64 : nullptr);
                        else dst = (br < 2) ? out + O_KVS + ((size_t)bs * 4 + 2 * br + bj) * 128 + g * 64 : out + O_WINS + ((size_t)(bs * 512 + 511) * 2 + bj) * 128 + g * 64;
                        const size_t hb = ((size_t)(b * 2 + g) * TP + t) * 64;
                        if (bj == 0) {
                            const int i0 = cc >> 1;
                            const f32x4 c4 = *(const f32x4*)(cosT + pos * 32 + i0), s4 = *(const f32x4*)(sinT + pos * 32 + i0);
                            float o1[4], o2[4];
#pragma unroll
                            for (int q = 0; q < 4; ++q) { const float x1 = v[2 * q], x2 = v[2 * q + 1]; o1[q] = x1 * c4[q] - x2 * s4[q]; o2[q] = x2 * c4[q] + x1 * s4[q]; }
                            if (dst) { st_f32x4(dst + i0, o1[0], o1[1], o1[2], o1[3]); st_f32x4(dst + 32 + i0, o2[0], o2[1], o2[2], o2[3]); }
                            if (!samp) { bf16_t* kb = (bf16_t*)(ws + (br == 0 ? WS_KC : br == 1 ? WS_KSEL : WS_KWIN)) + hb + i0;
                                st_bf16x4(kb, o1[0], o1[1], o1[2], o1[3]); st_bf16x4(kb + 32, o2[0], o2[1], o2[2], o2[3]); }
                        } else {
                            if (dst) { st_f32x4(dst + cc, v[0], v[1], v[2], v[3]); st_f32x4(dst + cc + 4, v[4], v[5], v[6], v[7]); }
                            if (!samp) {
                                st_bf16x8((bf16_t*)(ws + (br == 0 ? WS_VC : br == 1 ? WS_VSEL : WS_VWIN)) + hb + cc, v);
                            }
                        }
                    } else if (pn < 11) {
                        const int ch0 = (pn - 5) * 256 + cw;
                        st_bf16x8((bf16_t*)(ws + WS_CI) + (size_t)row * CCH + ch0, v);
                        float* dst = nullptr;
                        if (!samp) { if (t >= TP - 3) dst = out + O_CONVP + (size_t)(b * 3 + t - (TP - 3)) * CCH + ch0; }
                        else dst = out + O_CONVS + (size_t)(bs * 3 + 2) * CCH + ch0;
                        if (dst) { st_f32x4(dst, v[0], v[1], v[2], v[3]); st_f32x4(dst + 4, v[4], v[5], v[6], v[7]); }
                    } else if (pn < 13) {
                        st_bf16x8((bf16_t*)(ws + WS_Z) + (size_t)row * 512 + (pn - 11) * 256 + cw, v);
                    } else {
                        if (bj == 0 && wc == 0) {
                            float o[8];
                            if (fq < 3) {
#pragma unroll
                                for (int j = 0; j < 8; ++j) o[j] = sigmoidf_(v[j]);
                            } else {
#pragma unroll
                                for (int j = 0; j < 4; ++j) { const float xx = v[j] + dt_bias[j]; const float sp = fmaxf(xx, 0.f) + log1pf(__expf(-fabsf(xx))); o[j] = -__expf(a_log[j]) * sp; }
#pragma unroll
                                for (int j = 4; j < 8; ++j) o[j] = sigmoidf_(v[j]);
                            }
                            float* gt = (float*)(ws + WS_GT) + (size_t)row * 32 + fq * 8;
                            st_f32x4(gt, o[0], o[1], o[2], o[3]); st_f32x4(gt + 4, o[4], o[5], o[6], o[7]);
                        }
                    }
                }
            }
    }
};

struct EpiOut {
    static constexpr bool PERM = true, AFTER_DRAIN = false;
    const float* xp; const float* xs; unsigned char* ws;
    DI void operator()(const f32x4 (&acc)[2][2][4][2], const Unit& u, int wr, int wc, int fr, int fq) const {
        float* hp = (float*)(ws + WS_HP); bf16_t* hpb = (bf16_t*)(ws + WS_HPB); float* ssq = (float*)(ws + WS_SSQ1);
#pragma unroll
        for (int ai = 0; ai < 2; ++ai)
#pragma unroll
            for (int m = 0; m < 4; ++m) {
                const int row = u.pm * 256 + ai * 128 + wr * 64 + m * 16 + fr;
                const float* xr = row < MP ? xp + (size_t)row * DM : (row < MP + NBS ? xs + (size_t)(row - MP) * DM : nullptr);
                float sq = 0.f;
#pragma unroll
                for (int bj = 0; bj < 2; ++bj) {
                    EPI_V8(ai, bj, m);
                    const int col = u.pn * 256 + bj * 128 + wc * 32 + fq * 8;
                    float h[8];
                    if (xr) { const f32x4 x0 = *(const f32x4*)(xr + col), x1 = *(const f32x4*)(xr + col + 4);
#pragma unroll
                        for (int j = 0; j < 4; ++j) { h[j] = x0[j] + v[j]; h[4 + j] = x1[j] + v[4 + j]; } }
                    else {
#pragma unroll
                        for (int j = 0; j < 8; ++j) h[j] = 0.f; }
#pragma unroll
                    for (int j = 0; j < 8; ++j) sq += h[j] * h[j];
                    st_f32x4(hp + (size_t)row * DM + col, h[0], h[1], h[2], h[3]); st_f32x4(hp + (size_t)row * DM + col + 4, h[4], h[5], h[6], h[7]);
                    st_bf16x8(hpb + (size_t)row * DM + col, h);
                }
                sq += __shfl_xor(sq, 16); sq += __shfl_xor(sq, 32);
                if (fq == 0) atomicAdd(ssq + row, sq);
            }
    }
};

struct EpiUp {
    static constexpr bool PERM = true, AFTER_DRAIN = false;
    unsigned char* ws;
    DI void operator()(const f32x4 (&acc)[2][2][4][2], const Unit& u, int wr, int wc, int fr, int fq) const {
        const float* ssq = (const float*)(ws + WS_SSQ1); bf16_t* hid = (bf16_t*)(ws + WS_HID);
#pragma unroll
        for (int ai = 0; ai < 2; ++ai)
#pragma unroll
            for (int m = 0; m < 4; ++m) {
                const int row = u.pm * 256 + ai * 128 + wr * 64 + m * 16 + fr;
                const float rs = rsqrtf(ssq[row] * (1.f / DM) + EPS);
#pragma unroll
                for (int bj = 0; bj < 2; ++bj) {
                    EPI_V8(ai, bj, m);
                    const int j0 = (u.pn * 256 + bj * 128 + wc * 32 + fq * 8) >> 1;
                    float h[4];
#pragma unroll
                    for (int q = 0; q < 4; ++q) { const float gte = v[2 * q] * rs, up = v[2 * q + 1] * rs; h[q] = siluf_(gte) * up; }
                    st_bf16x4(hid + (size_t)row * DFF + j0, h[0], h[1], h[2], h[3]);
                }
            }
    }
};

struct EpiDown {
    static constexpr bool PERM = true, AFTER_DRAIN = false;
    unsigned char* ws;
    DI void operator()(const f32x4 (&acc)[2][2][4][2], const Unit& u, int wr, int wc, int fr, int fq) const {
        float* hp = (float*)(ws + WS_HP); float* ssq = (float*)(ws + WS_SSQ2);
#pragma unroll
        for (int ai = 0; ai < 2; ++ai)
#pragma unroll
            for (int m = 0; m < 4; ++m) {
                const int row = u.pm * 256 + ai * 128 + wr * 64 + m * 16 + fr;
                float sq = 0.f;
#pragma unroll
                for (int bj = 0; bj < 2; ++bj) {
                    EPI_V8(ai, bj, m);
                    float* hr = hp + (size_t)row * DM + u.pn * 256 + bj * 128 + wc * 32 + fq * 8;
                    const f32x4 x0 = *(const f32x4*)hr, x1 = *(const f32x4*)(hr + 4);
                    float h[8];
#pragma unroll
                    for (int j = 0; j < 4; ++j) { h[j] = x0[j] + v[j]; h[4 + j] = x1[j] + v[4 + j]; }
#pragma unroll
                    for (int j = 0; j < 8; ++j) sq += h[j] * h[j];
                    st_f32x4(hr, h[0], h[1], h[2], h[3]); st_f32x4(hr + 4, h[4], h[5], h[6], h[7]);
                }
                (void)sq; (void)ssq;
            }
    }
};
}
namespace p0 {
DI int perm_in(int n) {
    if (n < 512) { const int cc = n & 63; return (n & ~63) + ((cc & 1) ? (cc >> 1) + 32 : (cc >> 1)); }
    if (n < 1280) { const int m = n - 512, grp = m >> 6, cc = m & 63, br = grp >> 2, kvi = (grp >> 1) & 1, g = grp & 1;
        const int d = kvi == 0 ? ((cc & 1) ? (cc >> 1) + 32 : (cc >> 1)) : cc; return 512 + br * 256 + kvi * 128 + g * 64 + d; }
    if (n < 2816) return 1304 + (n - 1280);
    if (n < 3328) return 2840 + (n - 2816);
    if (n < 3352) return 1280 + (n - 3328);
    if (n < 3360) return n;
    return -1;
}
template <int MODE> DI void wt_item(const float* W, int Nsrc, bf16_t* WT, int Kdst, int n0, int k0, const float* kscale, int lane) {
    const int n = n0 + lane;
    int src;
    if (MODE == 0) src = perm_in(n);
    else if (MODE == 1) src = n;
    else src = (n & 1) ? DFF + (n >> 1) : (n >> 1);
#pragma unroll
    for (int kk = 0; kk < 64; kk += 8) {
        float v[8];
#pragma unroll
        for (int i = 0; i < 8; ++i) { const int k = k0 + kk + i; float x = src >= 0 ? W[(size_t)k * Nsrc + src] : 0.f; if (kscale) x *= kscale[k]; v[i] = x; }
        epi::st_bf16x8(WT + (size_t)n * Kdst + k0 + kk, v);
    }
}
DI void run(const Params& p) {
    int tid_ = threadIdx.x; asm volatile("" : "+v"(tid_)); const int tid = tid_, lane = tid & 63, wave = tid >> 6;
    const int gw = blockIdx.x * 8 + wave, NGW = gridDim.x * 8;
    const int gt = blockIdx.x * 512 + tid, NGT = gridDim.x * 512;
    unsigned char* ws = p.ws;
    constexpr int I_IN = (INW_PAD / 64) * (DM / 64), I_OUT = (DM / 64) * (DM / 64), I_GU = (2 * DFF / 64) * (DM / 64), I_DN = (DM / 64) * (DFF / 64);
    constexpr int NIT = I_IN + I_OUT + I_GU + I_DN;
    for (int it = gw; it < NIT; it += NGW) {
        int r = it;
        if (r < I_IN) { wt_item<0>(p.w_in, INW, (bf16_t*)(ws + WS_WIN), DM, (r / 16) * 64, (r % 16) * 64, nullptr, lane); continue; } r -= I_IN;
        if (r < I_OUT) { wt_item<1>(p.w_out, DM, (bf16_t*)(ws + WS_WOUT), DM, (r / 16) * 64, (r % 16) * 64, nullptr, lane); continue; } r -= I_OUT;
        if (r < I_GU) { wt_item<2>(p.w_gate_up, 2 * DFF, (bf16_t*)(ws + WS_WGU), DM, (r / 16) * 64, (r % 16) * 64, p.norm_ffn, lane); continue; } r -= I_GU;
        wt_item<1>(p.w_down, DM, (bf16_t*)(ws + WS_WDN), DFF, (r / 44) * 64, (r % 44) * 64, nullptr, lane);
    }
    for (int i = gt; i < 2 * 128 * 2 * 64; i += NGT) {
        const int ln = i & 63, et = (i >> 6) & 1, ks = (i >> 7) & 127, kv = i >> 14;
        const float* w = p.cmp_w + ((size_t)kv * 2048 + ks * 16 + (ln >> 5) * 8) * 64 + et * 32 + (ln & 31);
        float v[8];
#pragma unroll
        for (int j = 0; j < 8; ++j) v[j] = w[j * 64];
        epi::st_bf16x8((bf16_t*)(ws + WS_WCMP) + (size_t)i * 8, v);
    }
    for (int o = gw; o < 128; o += NGW) {
        const int kv = o >> 6, e = o & 63; float s = 0.f;
        for (int k = lane; k < 2048; k += 64) s += p.cmp_pe[kv * 2048 + k] * p.cmp_w[((size_t)kv * 2048 + k) * 64 + e];
        s = wave_sum(s);
        if (lane == 0) ((float*)(ws + WS_CST))[o] = s;
    }
    { float* cosT = (float*)(ws + WS_ROPE); float* sinT = cosT + 8193 * 32;
      const double inv = exp2(-(double)(gt & 31) * (13.287712379549449 / 32.0));
      for (int i = gt; i < 8193 * 32; i += NGT) { const double a = (double)(i >> 5) * inv; const double k = rint(a * 0.15915494309189535);
          const double r = fma(-k, 1.2246467991473532e-16 * 2.0, fma(-k, 6.283185307179586, a)); float sn, cs; sincosf((float)r, &sn, &cs); cosT[i] = cs; sinT[i] = sn; } }
    { f32x4 gm[4];
#pragma unroll
      for (int j = 0; j < 4; ++j) gm[j] = *(const f32x4*)(p.norm_mix + (j * 64 + lane) * 4);
      for (int row0 = gw; row0 < MROWS; row0 += 2 * NGW) {
#pragma unroll
        for (int rr = 0; rr < 2; ++rr) { const int row = row0 + rr * NGW; if (row >= MP + NBS && row < MROWS) { bf16_t* o = (bf16_t*)(ws + WS_XN) + (size_t)row * DM; for (int j = 0; j < 4; ++j) *(u32x2*)(o + (j * 64 + lane) * 4) = (u32x2){0u, 0u}; } }
        const int rowa = row0, rowb = row0 + NGW; const bool va = rowa < MP + NBS, vb = rowb < MP + NBS;
        const float* xa = rowa < MP ? p.x_prompt + (size_t)rowa * DM : p.x_sample + (size_t)((va ? rowa : MP) - MP) * DM;
        const float* xb = rowb < MP ? p.x_prompt + (size_t)rowb * DM : p.x_sample + (size_t)((vb ? rowb : MP) - MP) * DM;
        f32x4 a[4], b[4]; float sa = 0.f, sb = 0.f;
#pragma unroll
        for (int j = 0; j < 4; ++j) { a[j] = __builtin_nontemporal_load((const f32x4*)(xa + (j * 64 + lane) * 4)); b[j] = __builtin_nontemporal_load((const f32x4*)(xb + (j * 64 + lane) * 4)); }
#pragma unroll
        for (int j = 0; j < 4; ++j) { sa += a[j][0] * a[j][0] + a[j][1] * a[j][1] + a[j][2] * a[j][2] + a[j][3] * a[j][3]; sb += b[j][0] * b[j][0] + b[j][1] * b[j][1] + b[j][2] * b[j][2] + b[j][3] * b[j][3]; }
        const float ra = rsqrtf(wave_sum(sa) * (1.f / DM) + EPS), rb = rsqrtf(wave_sum(sb) * (1.f / DM) + EPS);
        if (va) { bf16_t* o = (bf16_t*)(ws + WS_XN) + (size_t)rowa * DM;
#pragma unroll
            for (int j = 0; j < 4; ++j) epi::st_bf16x4(o + (j * 64 + lane) * 4, a[j][0] * ra * gm[j][0], a[j][1] * ra * gm[j][1], a[j][2] * ra * gm[j][2], a[j][3] * ra * gm[j][3]); }
        if (vb) { bf16_t* o = (bf16_t*)(ws + WS_XN) + (size_t)rowb * DM;
#pragma unroll
            for (int j = 0; j < 4; ++j) epi::st_bf16x4(o + (j * 64 + lane) * 4, b[j][0] * rb * gm[j][0], b[j][1] * rb * gm[j][1], b[j][2] * rb * gm[j][2], b[j][3] * rb * gm[j][3]); }
      } }
    { const f32x4* src = (const f32x4*)p.cache_win; f32x4* dst = (f32x4*)(p.out + O_WINS);
#pragma unroll 4
      for (int i = gt; i < NBS * 511 * 64; i += NGT) { const int bs = i / (511 * 64), r = i % (511 * 64); dst[(size_t)bs * 512 * 64 + r] = src[(size_t)bs * 512 * 64 + 64 + r]; } }
    { const f32x4* src = (const f32x4*)p.state_conv; f32x4* dst = (f32x4*)(p.out + O_CONVS);
      for (int i = gt; i < NBS * 2 * (CCH / 4); i += NGT) { const int bs = i / (2 * (CCH / 4)), r = i % (2 * (CCH / 4)); dst[(size_t)bs * 3 * (CCH / 4) + r] = src[(size_t)bs * 3 * (CCH / 4) + (CCH / 4) + r]; } }
}
}
namespace attn {
constexpr int KSTR = 72, VSTR = 68;
constexpr int KT_BYTES = 64 * KSTR * 2, VT_BYTES = 64 * VSTR * 2, TILE_BYTES = KT_BYTES + VT_BYTES;
constexpr int OFF_IMP = 4 * TILE_BYTES, IMP_STR = 132;
constexpr int OFF_C2S = OFF_IMP + 8 * 8 * IMP_STR * 4;
constexpr int LDS_NEED = OFF_C2S + 3 * 4 * 64 * 16;

DI void ld_tile(const bf16_t* kbase, const bf16_t* vtbase, size_t vts, u32x4& kr, u32x4& vr, int tid) {
    kr = *(const u32x4*)(kbase + (tid >> 3) * 64 + (tid & 7) * 8);
    vr = *(const u32x4*)(vtbase + (size_t)(tid >> 3) * vts + (tid & 7) * 8);
}
DI void st_tile(LAS unsigned char* buf, const u32x4& kr, const u32x4& vr, int tid) {
    *(LAS u32x4*)(buf + ((tid >> 3) * KSTR + (tid & 7) * 8) * 2) = kr;
    LAS u32x2* vp = (LAS u32x2*)(buf + KT_BYTES + ((tid >> 3) * VSTR + (tid & 7) * 8) * 2);
    vp[0] = (u32x2){vr.x, vr.y}; vp[1] = (u32x2){vr.z, vr.w};
}
DI void qk_tile(const LAS unsigned char* kb, const bf16x8 (&qf)[4], f32x16& s0, f32x16& s1, int lane) {
    const LAS unsigned char* p0 = kb + ((lane & 31) * KSTR + (lane >> 5) * 8) * 2;
    f32x16 z; for (int i = 0; i < 16; ++i) z[i] = 0.f;
    s0 = z; s1 = z;
#pragma unroll
    for (int kd = 0; kd < 4; ++kd) {
        const bf16x8 a0 = *(const LAS bf16x8*)(p0 + kd * 32), a1 = *(const LAS bf16x8*)(p0 + 32 * KSTR * 2 + kd * 32);
        s0 = MFMA32(a0, qf[kd], s0); s1 = MFMA32(a1, qf[kd], s1);
    }
}
DI bf16x8 pack8(const f32x16& p, int base) {
    u32x4 w; w.x = pk2(p[base], p[base + 1]); w.y = pk2(p[base + 2], p[base + 3]); w.z = pk2(p[base + 4], p[base + 5]); w.w = pk2(p[base + 6], p[base + 7]);
    return __builtin_bit_cast(bf16x8, w);
}
DI void pv_tile(const LAS unsigned char* vb, const f32x16& p0, const f32x16& p1, f32x16& o0, f32x16& o1, int lane) {
    const LAS unsigned char* v0 = vb + ((lane & 31) * VSTR + 4 * (lane >> 5)) * 2;
#pragma unroll
    for (int ks = 0; ks < 4; ++ks) {
        const bf16x8 pb = (ks < 2) ? pack8(p0, (ks & 1) * 8) : pack8(p1, (ks & 1) * 8);
#pragma unroll
        for (int dt = 0; dt < 2; ++dt) {
            const s16x4 lo = *(const LAS s16x4*)(v0 + (dt * 32 * VSTR + 16 * ks) * 2), hi = *(const LAS s16x4*)(v0 + (dt * 32 * VSTR + 16 * ks + 8) * 2);
            const bf16x8 a = __builtin_shufflevector(lo, hi, 0, 1, 2, 3, 4, 5, 6, 7);
            if (dt == 0) o0 = MFMA32(a, pb, o0); else o1 = MFMA32(a, pb, o1);
        }
    }
}
DI void pv_tile_pb(const LAS unsigned char* vb, const bf16x8 (&pb)[4], f32x16& o0, f32x16& o1, int lane) {
    const LAS unsigned char* v0 = vb + ((lane & 31) * VSTR + 4 * (lane >> 5)) * 2;
#pragma unroll
    for (int ks = 0; ks < 4; ++ks) {
#pragma unroll
        for (int dt = 0; dt < 2; ++dt) {
            const s16x4 lo = *(const LAS s16x4*)(v0 + (dt * 32 * VSTR + 16 * ks) * 2), hi = *(const LAS s16x4*)(v0 + (dt * 32 * VSTR + 16 * ks + 8) * 2);
            const bf16x8 a = __builtin_shufflevector(lo, hi, 0, 1, 2, 3, 4, 5, 6, 7);
            if (dt == 0) o0 = MFMA32(a, pb[ks], o0); else o1 = MFMA32(a, pb[ks], o1);
        }
    }
}
DI void softmax_step(f32x16& s0, f32x16& s1, float& m, float& l, f32x16& o0, f32x16& o1) {
    float mt = NEGBIG;
#pragma unroll
    for (int r = 0; r < 16; ++r) mt = fmaxf(mt, fmaxf(s0[r], s1[r]));
    mt = fmaxf(mt, __shfl_xor(mt, 32));
    const float mn = fmaxf(m, mt), alpha = __builtin_amdgcn_exp2f(m - mn);
    float sum = 0.f;
#pragma unroll
    for (int r = 0; r < 16; ++r) { s0[r] = __builtin_amdgcn_exp2f(s0[r] - mn); s1[r] = __builtin_amdgcn_exp2f(s1[r] - mn); sum += s0[r] + s1[r]; }
    l = l * alpha + sum; m = mn;
#pragma unroll
    for (int r = 0; r < 16; ++r) { o0[r] *= alpha; o1[r] *= alpha; }
}

DI float max3f(float a, float b, float c) { float r; asm("v_max3_f32 %0, %1, %2, %3" : "=v"(r) : "v"(a), "v"(b), "v"(c)); return r; }
template <bool ROWMASK> DI void softmax_step2(f32x16& s0, f32x16& s1, float& m, float& l, f32x16& o0, f32x16& o1, bool on) {
    float ma = max3f(s0[0], s0[1], s1[0]), mb = max3f(s0[2], s0[3], s1[1]);
    ma = max3f(ma, s1[2], s1[3]);
#pragma unroll
    for (int r = 4; r < 16; r += 4) { ma = max3f(ma, s0[r], s0[r + 1]); mb = max3f(mb, s0[r + 2], s0[r + 3]); ma = max3f(ma, s1[r], s1[r + 1]); mb = max3f(mb, s1[r + 2], s1[r + 3]); }
    float mt = max3f(ma, mb, ma);
    if (ROWMASK) mt = on ? mt : NEGBIG;
    mt = max3f(mt, __shfl_xor(mt, 32), mt);
    if (__any(mt > m)) {
        const float mn = max3f(m, mt, mt), alpha = __builtin_amdgcn_exp2f(m - mn);
        l *= alpha; m = mn;
        o0 = o0 * alpha; o1 = o1 * alpha;
    }
    const float mu = ROWMASK ? (on ? m : 1e30f) : m;
    s0 = s0 - mu; s1 = s1 - mu;
#pragma unroll
    for (int r = 0; r < 16; ++r) { s0[r] = __builtin_amdgcn_exp2f(s0[r]); s1[r] = __builtin_amdgcn_exp2f(s1[r]); }
    const f32x16 sv = s0 + s1;
    l += ((sv[0] + sv[1]) + (sv[2] + sv[3])) + ((sv[4] + sv[5]) + (sv[6] + sv[7])) + (((sv[8] + sv[9]) + (sv[10] + sv[11])) + ((sv[12] + sv[13]) + (sv[14] + sv[15])));
}

#define ATT_TBUF(i) (lds + (i) * TILE_BYTES)
#define ATT_STREAM_BEGIN(NT, KP, VP, VTS) { u32x4 kr_, vr_; const int nt_ = (NT); \
    { const int i_ = 0; ld_tile((KP), (VP), (VTS), kr_, vr_, tid); } st_tile(ATT_TBUF(0), kr_, vr_, tid); __syncthreads(); \
    for (int it_ = 0; it_ < nt_; ++it_) { \
        if (it_ + 1 < nt_) { const int i_ = it_ + 1; ld_tile((KP), (VP), (VTS), kr_, vr_, tid); } \
        { const LAS unsigned char* tb = ATT_TBUF(it_ & 1); const int i_ = it_;
#define ATT_STREAM_END() } \
        if (it_ + 1 < nt_) st_tile(ATT_TBUF((it_ + 1) & 1), kr_, vr_, tid); \
        __syncthreads(); } }

#define ATT_PBUF(i) (lds + (i) * 2 * TILE_BYTES)
#define ATT_PAIR_BEGIN(NP, KP, VP, VTS) { u32x4 ka_, va_, kb_, vb_; const int np_ = (NP); \
    { const int i_ = 0; ld_tile((KP), (VP), (VTS), ka_, va_, tid); } { const int i_ = 1; ld_tile((KP), (VP), (VTS), kb_, vb_, tid); } \
    st_tile(ATT_PBUF(0), ka_, va_, tid); st_tile(ATT_PBUF(0) + TILE_BYTES, kb_, vb_, tid); __syncthreads(); \
    for (int ip_ = 0; ip_ < np_; ++ip_) { \
        if (ip_ + 1 < np_) { { const int i_ = 2 * ip_ + 2; ld_tile((KP), (VP), (VTS), ka_, va_, tid); } { const int i_ = 2 * ip_ + 3; ld_tile((KP), (VP), (VTS), kb_, vb_, tid); } } \
        { const LAS unsigned char* tba = ATT_PBUF(ip_ & 1); const LAS unsigned char* tbb = tba + TILE_BYTES; const int ia_ = 2 * ip_, ib_ = 2 * ip_ + 1;
#define ATT_PAIR_END() } \
        if (ip_ + 1 < np_) { st_tile(ATT_PBUF((ip_ + 1) & 1), ka_, va_, tid); st_tile(ATT_PBUF((ip_ + 1) & 1) + TILE_BYTES, kb_, vb_, tid); } \
        __syncthreads(); } }

DI void unit(const Params& p, LAS unsigned char* lds, int b, int g, int tt) {
    TICK_INIT();
    int tid_ = threadIdx.x; asm volatile("" : "+v"(tid_)); const int tid = tid_, lane = tid & 63, wave = __builtin_amdgcn_readfirstlane(tid >> 6), hi = lane >> 5, col = lane & 31, tokl = col & 7, r = col >> 3;
    const int t = tt * 64 + wave * 8 + tokl;
    const size_t row = (size_t)b * TP + t;
    const unsigned char* ws = p.ws;
    const size_t slab = (size_t)(b * 2 + g);
    bf16x8 qf[4];
    { const bf16_t* q = (const bf16_t*)(ws + WS_QB) + row * 512 + (g * 4 + r) * 64 + hi * 8;
#pragma unroll
      for (int kd = 0; kd < 4; ++kd) qf[kd] = *(const bf16x8*)(q + kd * 16); }
    const float* gt = (const float*)(ws + WS_GT) + row * 32 + (g * 4 + r) * 3;
    const float gate0 = gt[0], gate1 = gt[1], gate2 = gt[2];
    LAS float* imp = (LAS float*)(lds + OFF_IMP) + wave * 8 * IMP_STR;
    for (int e = tid; e < 768; e += 512) { const int var = e >> 8, ks = (e >> 6) & 3, ln = e & 63, sl = ln & 31, hh = ln >> 5; unsigned w[4];
#pragma unroll
        for (int j2 = 0; j2 < 4; ++j2) { unsigned pk = 0u;
#pragma unroll
            for (int q = 0; q < 2; ++q) { const int j = 2 * j2 + q, nl = 16 * ks + 8 * (j >> 2) + 4 * hh + (j & 3);
                const int c = var == 0 ? nl - 4 * sl : var == 1 ? nl + 64 - 4 * sl : nl - 64 - 4 * sl;
                if (c >= -1 && c <= 3) pk |= 0x3F80u << (16 * q); }
            w[j2] = pk; }
        *(LAS u32x4*)(lds + OFF_C2S + e * 16) = (u32x4){w[0], w[1], w[2], w[3]}; }
    f32x16 of0, of1; for (int i = 0; i < 16; ++i) { of0[i] = 0.f; of1[i] = 0.f; }

    TICK(0);
    const int nv = t >= 31 ? ((t - 31) >> 4) + 1 : 0;
    {
        const int ntile = (4 * tt + 3 + 63) >> 6;
        const bf16_t* ck = (const bf16_t*)(ws + WS_CKP) + slab * 512 * 64;
        const bf16_t* cvt = (const bf16_t*)(ws + WS_CVTP) + slab * 64 * 512;
        float m = NEGBIG, l = 0.f;
        ATT_STREAM_BEGIN(ntile, ck + (size_t)i_ * 64 * 64, cvt + i_ * 64, 512)
            f32x16 s0, s1; qk_tile(tb, qf, s0, s1, lane);
            float mt = NEGBIG;
#pragma unroll
            for (int rr = 0; rr < 16; ++rr) { const int n0 = i_ * 64 + crow(rr, hi); s0[rr] = n0 < nv ? s0[rr] : NEGBIG; s1[rr] = n0 + 32 < nv ? s1[rr] : NEGBIG; mt = fmaxf(mt, fmaxf(s0[rr], s1[rr])); }
            const float mn = fmaxf(m, mt); float sum = 0.f;
#pragma unroll
            for (int rr = 0; rr < 16; ++rr) sum += __builtin_amdgcn_exp2f(s0[rr] - mn) + __builtin_amdgcn_exp2f(s1[rr] - mn);
            l = l * __builtin_amdgcn_exp2f(m - mn) + sum; m = mn;
        ATT_STREAM_END()
        TICK(1);
        const float mo = __shfl_xor(m, 32), lo = __shfl_xor(l, 32);
        const float M = fmaxf(m, mo), L = l * __builtin_amdgcn_exp2f(m - M) + lo * __builtin_amdgcn_exp2f(mo - M);
        const float invL = M > -1e29f ? 1.f / L : 0.f;
        f32x16 o0, o1; for (int i = 0; i < 16; ++i) { o0[i] = 0.f; o1[i] = 0.f; }
        f32x16 dimp[4]; for (int k = 0; k < 4; ++k) for (int i = 0; i < 16; ++i) dimp[k][i] = 0.f;
        ATT_STREAM_BEGIN(ntile, ck + (size_t)i_ * 64 * 64, cvt + i_ * 64, 512)
            f32x16 s0, s1; qk_tile(tb, qf, s0, s1, lane);
#pragma unroll
            for (int rr = 0; rr < 16; ++rr) { const int n0 = i_ * 64 + crow(rr, hi);
                s0[rr] = n0 < nv ? __builtin_amdgcn_exp2f(s0[rr] - M) * invL : 0.f; s1[rr] = n0 + 32 < nv ? __builtin_amdgcn_exp2f(s1[rr] - M) * invL : 0.f; }
            bf16x8 pb[4] = {pack8(s0, 0), pack8(s0, 8), pack8(s1, 0), pack8(s1, 8)};
            pv_tile_pb(tb + KT_BYTES, pb, o0, o1, lane);
            { const LAS unsigned char* ct = lds + OFF_C2S + lane * 16;
#define C2S_ACC(ST, VAR) do { _Pragma("unroll") for (int ks = 0; ks < 4; ++ks) dimp[ST] = MFMA32(*(const LAS bf16x8*)(ct + ((VAR) * 4 + ks) * 1024), pb[ks], dimp[ST]); } while (0)
              switch (i_) {
                case 0: C2S_ACC(0, 0); break;
                case 1: C2S_ACC(0, 1); C2S_ACC(1, 2); break;
                case 2: C2S_ACC(1, 0); break;
                case 3: C2S_ACC(1, 1); C2S_ACC(2, 2); break;
                case 4: C2S_ACC(2, 0); break;
                case 5: C2S_ACC(2, 1); C2S_ACC(3, 2); break;
                case 6: C2S_ACC(3, 0); break;
                default: C2S_ACC(3, 1); break;
              } }
        ATT_STREAM_END()
        TICK(2);
#pragma unroll
        for (int i = 0; i < 16; ++i) { of0[i] = gate0 * o0[i]; of1[i] = gate0 * o1[i]; }
#pragma unroll
        for (int st = 0; st < 4; ++st)
            if (st * 32 <= tt) {
#pragma unroll
                for (int rr = 0; rr < 16; ++rr) { float v = dimp[st][rr]; v += __shfl_xor(v, 8); v += __shfl_xor(v, 16);
                    if (r == 0) imp[tokl * IMP_STR + st * 32 + crow(rr, hi)] = v; } }
    }
    TICK(3);
    unsigned long long sel_lo = 0ull, sel_hi = 0ull;
    {
        const unsigned long long lt = (1ull << lane) - 1ull;
#pragma unroll 1
        for (int j = 0; j < 8; ++j) {
            const float i0 = imp[j * IMP_STR + lane], i1 = imp[j * IMP_STR + 64 + lane];
            const int sA = lane, sB = lane + 64;
            const bool vA = sA <= tt, vB = sB <= tt;
            const bool fA = sA == 0 || sA == tt || sA == tt - 1, fB = sB == tt || sB == tt - 1;
            const int xA = vA ? __float_as_int(i0 + (fA ? 1e4f : 0.f)) : -1, xB = vB ? __float_as_int(i1 + (fB ? 1e4f : 0.f)) : -1;
            int T = 0;
#pragma unroll 1
            for (int bit = 30; bit >= 0; --bit) { const int T2 = T | (1 << bit);
                const int c = __popcll(__ballot(xA >= T2)) + __popcll(__ballot(xB >= T2)); T = __builtin_amdgcn_readfirstlane(c >= 16 ? T2 : T); }
            const bool gA = xA > T, gB = xB > T, eA = xA == T, eB = xB == T;
            const int need = 16 - (__popcll(__ballot(gA)) + __popcll(__ballot(gB)));
            const unsigned long long beA = __ballot(eA), beB = __ballot(eB);
            const int preA = __popcll(beA & lt), preB = __popcll(beA) + __popcll(beB & lt);
            const unsigned long long mA = __ballot(gA || (eA && preA < need)), mB = __ballot(gB || (eB && preB < need));
            if (tokl == j) { sel_lo = mA; sel_hi = mB; }
        }
    }
    TICK(4);
    {
        const bf16_t* kb = (const bf16_t*)(ws + WS_KSEL) + slab * TP * 64;
        const bf16_t* vt = (const bf16_t*)(ws + WS_VSELT) + slab * 64 * TP;
        float m = NEGBIG, l = 0.f; f32x16 o0, o1; for (int i = 0; i < 16; ++i) { o0[i] = 0.f; o1[i] = 0.f; }
#define SELBLK(j) ((j) == 0 ? tt : ((j) <= tt ? (j) - 1 : 0))
        ATT_PAIR_BEGIN((tt + 2) >> 1, kb + (size_t)SELBLK(i_) * 64 * 64, vt + (size_t)SELBLK(i_) * 64, TP)
            const int sA = SELBLK(ia_), sB = SELBLK(ib_);
            const bool onA = ((sA < 64 ? (sel_lo >> sA) : (sel_hi >> (sA - 64))) & 1ull) != 0ull;
            const bool onB = ib_ <= tt && ((sB < 64 ? (sel_lo >> sB) : (sel_hi >> (sB - 64))) & 1ull) != 0ull;
            if (__any(onA)) {
                f32x16 a0, a1; qk_tile(tba, qf, a0, a1, lane);
                if (ia_ == 0) {
                    const int lim = t - tt * 64;
#pragma unroll
                    for (int rr = 0; rr < 16; ++rr) { const int kk = crow(rr, hi); a0[rr] = kk <= lim ? a0[rr] : NEGBIG; a1[rr] = kk + 32 <= lim ? a1[rr] : NEGBIG; }
                }
                softmax_step2<true>(a0, a1, m, l, o0, o1, onA);
                pv_tile(tba + KT_BYTES, a0, a1, o0, o1, lane);
            }
            if (__any(onB)) {
                f32x16 b0, b1; qk_tile(tbb, qf, b0, b1, lane);
                softmax_step2<true>(b0, b1, m, l, o0, o1, onB);
                pv_tile(tbb + KT_BYTES, b0, b1, o0, o1, lane);
            }
        ATT_PAIR_END()
        const float sc = gate1 / (l + __shfl_xor(l, 32));
#pragma unroll
        for (int i = 0; i < 16; ++i) { of0[i] += sc * o0[i]; of1[i] += sc * o1[i]; }
    }
    TICK(5);
    {
        const bf16_t* kb = (const bf16_t*)(ws + WS_KWIN) + slab * TP * 64;
        const bf16_t* vt = (const bf16_t*)(ws + WS_VWINT) + slab * 64 * TP;
        const int ntile = (tt < 8 ? tt : 8) + 1;
        float m = NEGBIG, l = 0.f; f32x16 o0, o1; for (int i = 0; i < 16; ++i) { o0[i] = 0.f; o1[i] = 0.f; }
#define WINTILE(j) ((j) < ntile ? tt - (j) : tt)
        ATT_PAIR_BEGIN((ntile + 1) >> 1, kb + (size_t)WINTILE(i_) * 64 * 64, vt + (size_t)WINTILE(i_) * 64, TP)
            f32x16 a0, a1, b0, b1; qk_tile(tba, qf, a0, a1, lane); qk_tile(tbb, qf, b0, b1, lane);
            if (ia_ == 0 || ia_ == 8) {
                const int k0 = (tt - ia_) * 64;
#pragma unroll
                for (int rr = 0; rr < 16; ++rr) { const int kp = k0 + crow(rr, hi);
                    a0[rr] = (kp <= t && kp >= t - 512) ? a0[rr] : NEGBIG; a1[rr] = (kp + 32 <= t && kp + 32 >= t - 512) ? a1[rr] : NEGBIG; }
            }
            softmax_step2<false>(a0, a1, m, l, o0, o1, true);
            pv_tile(tba + KT_BYTES, a0, a1, o0, o1, lane);
            softmax_step2<true>(b0, b1, m, l, o0, o1, ib_ < ntile);
            pv_tile(tbb + KT_BYTES, b0, b1, o0, o1, lane);
        ATT_PAIR_END()
        const float sc = gate2 / (l + __shfl_xor(l, 32));
#pragma unroll
        for (int i = 0; i < 16; ++i) { of0[i] += sc * o0[i]; of1[i] += sc * o1[i]; }
    }
    TICK(6);
    { bf16_t* o = (bf16_t*)(p.ws + WS_MIX) + row * DM + (g * 4 + r) * 64 + 4 * hi;
#pragma unroll
      for (int i = 0; i < 4; ++i) { epi::st_bf16x4(o + 8 * i, of0[4 * i], of0[4 * i + 1], of0[4 * i + 2], of0[4 * i + 3]);
                                    epi::st_bf16x4(o + 32 + 8 * i, of1[4 * i], of1[4 * i + 1], of1[4 * i + 2], of1[4 * i + 3]); } }
    TICK(7);
}
}
namespace gdn {
template <int I> struct SolveRow {
    static DI void run(float (&x)[64], const LAS float* LM, const LAS float* VF, const LAS float* KF, const LAS float* GC, bool isu, int col) {
        SolveRow<I - 1>::run(x, LM, VF, KF, GC, isu, col);
        float acc = isu ? VF[I * 128 + col] * GC[64 + I] : KF[I * 128 + col] * GC[64 + I] * GC[128 + I];
        float a1 = 0.f, a2 = 0.f, a3 = 0.f;
#pragma unroll
        for (int j = 0; j < I; ++j) { const float t = LM[I * 64 + j] * x[j]; if ((j & 3) == 0) acc -= t; else if ((j & 3) == 1) a1 -= t; else if ((j & 3) == 2) a2 -= t; else a3 -= t; }
        x[I] = (acc + a1) + (a2 + a3);
        asm volatile("" : "+v"(x[I]) :: "memory");
    }
};
template <> struct SolveRow<-1> { static DI void run(float (&)[64], const LAS float*, const LAS float*, const LAS float*, const LAS float*, bool, int) {} };
constexpr int P_KF = 0, P_VF = 32768, P_QB = 65536, P_KB = 82944, P_LM = 100352, P_GC = 116736, P_AQ = 117760  , PSTR = 136;
DI void prep_unit(const Params& p, LAS unsigned char* lds, int b, int h, int n) {
    int tid_ = threadIdx.x; asm volatile("" : "+v"(tid_)); const int tid = tid_, lane = tid & 63, wave = __builtin_amdgcn_readfirstlane(tid >> 6);
    const unsigned char* ws = p.ws;
    LAS float* KF = (LAS float*)(lds + P_KF); LAS float* VF = (LAS float*)(lds + P_VF);
    LAS bf16_t* QB = (LAS bf16_t*)(lds + P_QB); LAS bf16_t* KB = (LAS bf16_t*)(lds + P_KB);
    LAS float* LM = (LAS float*)(lds + P_LM); LAS float* GC = (LAS float*)(lds + P_GC);
    const int chunk = (b * GH + h) * NCHUNK + n;
    const size_t row0 = (size_t)b * TP + (size_t)n * 64;
    __syncthreads();
    if (wave == 0) {
        const float* gt = (const float*)(ws + WS_GT) + (row0 + lane) * 32;
        float g = gt[24 + h]; const float be = gt[28 + h];
#pragma unroll
        for (int o = 1; o < 64; o <<= 1) { const float x = __shfl_up(g, o); if (lane >= o) g += x; }
        GC[lane] = g; GC[64 + lane] = be; GC[128 + lane] = __expf(g);
    }
    __syncthreads();
    {
        const int dd = (tid & 15) * 8;
        const float* cw = p.conv_w;
        const bf16_t* ci = (const bf16_t*)(ws + WS_CI);
#pragma unroll 1
        for (int cc = 0; cc < 2; ++cc) {
            const int c = (tid >> 4) + cc * 32; const int t = n * 64 + c;
            float val[3][8];
#pragma unroll
            for (int part = 0; part < 3; ++part) {
                const int ch = part * 512 + h * 128 + dd;
                float a[8]; for (int i = 0; i < 8; ++i) a[i] = 0.f;
#pragma unroll
                for (int j = 0; j < 4; ++j) {
                    const int tj = t - 3 + j;
                    if (tj >= 0) {
                        const u32x4 xv = *(const u32x4*)(ci + ((size_t)b * TP + tj) * CCH + ch);
                        const f32x4 w0 = *(const f32x4*)(cw + j * CCH + ch), w1 = *(const f32x4*)(cw + j * CCH + ch + 4);
                        const unsigned xs[4] = {xv.x, xv.y, xv.z, xv.w};
#pragma unroll
                        for (int i = 0; i < 4; ++i) { a[2 * i] += __uint_as_float(xs[i] << 16) * (i < 2 ? w0[2 * i] : w1[2 * i - 4]); a[2 * i + 1] += __uint_as_float(xs[i] & 0xffff0000u) * (i < 2 ? w0[2 * i + 1] : w1[2 * i - 3]); }
                    }
                }
#pragma unroll
                for (int i = 0; i < 8; ++i) val[part][i] = siluf_(a[i]);
            }
            float sq = 0.f, sk = 0.f;
#pragma unroll
            for (int i = 0; i < 8; ++i) { sq += val[0][i] * val[0][i]; sk += val[1][i] * val[1][i]; }
#pragma unroll
            for (int o = 1; o < 16; o <<= 1) { sq += __shfl_xor(sq, o); sk += __shfl_xor(sk, o); }
            const float rq = rsqrtf(sq + EPS) * 0.08838834764831845f, rk = rsqrtf(sk + EPS), eg = GC[128 + c];
            float qn[8], qg[8], kn[8];
#pragma unroll
            for (int i = 0; i < 8; ++i) { qn[i] = val[0][i] * rq; qg[i] = qn[i] * eg; kn[i] = val[1][i] * rk; }
            {
              bf16_t* qf = (bf16_t*)(ws + WS_GQG) + (size_t)chunk * 8192 + (size_t)(((c >> 5) * 8 + (dd >> 4)) * 64 + (c & 31)) * 8 + ((dd >> 3) & 1) * 4;
              epi::st_bf16x4(qf, qg[0], qg[1], qg[2], qg[3]); epi::st_bf16x4(qf + 32 * 8, qg[4], qg[5], qg[6], qg[7]); }
            { u32x4 w; w.x = pk2(qn[0], qn[1]); w.y = pk2(qn[2], qn[3]); w.z = pk2(qn[4], qn[5]); w.w = pk2(qn[6], qn[7]); *(LAS u32x4*)(QB + c * PSTR + dd) = w; }
            { u32x4 w; w.x = pk2(kn[0], kn[1]); w.y = pk2(kn[2], kn[3]); w.z = pk2(kn[4], kn[5]); w.w = pk2(kn[6], kn[7]); *(LAS u32x4*)(KB + c * PSTR + dd) = w; }
            *(LAS f32x4*)(KF + c * 128 + dd) = (f32x4){kn[0], kn[1], kn[2], kn[3]}; *(LAS f32x4*)(KF + c * 128 + dd + 4) = (f32x4){kn[4], kn[5], kn[6], kn[7]};
            *(LAS f32x4*)(VF + c * 128 + dd) = (f32x4){val[2][0], val[2][1], val[2][2], val[2][3]}; *(LAS f32x4*)(VF + c * 128 + dd + 4) = (f32x4){val[2][4], val[2][5], val[2][6], val[2][7]};
        }
    }
    __syncthreads();
    {
        const int mat = wave >> 2, ti = (wave >> 1) & 1, tj = wave & 1, hi = lane >> 5, cl = lane & 31;
        const LAS bf16_t* A = (mat == 0 ? KB : QB) + (ti * 32 + cl) * PSTR + hi * 8;
        const LAS bf16_t* B = KB + (tj * 32 + cl) * PSTR + hi * 8;
        f32x16 acc; for (int i = 0; i < 16; ++i) acc[i] = 0.f;
#pragma unroll
        for (int ks = 0; ks < 8; ++ks) acc = MFMA32(*(const LAS bf16x8*)(A + ks * 16), *(const LAS bf16x8*)(B + ks * 16), acc);
        const int j = tj * 32 + cl; const float gj = GC[j];
#pragma unroll
        for (int r = 0; r < 16; ++r) {
            const int i = ti * 32 + crow(r, hi);
            const float dec = __expf(fminf(GC[i] - gj, 0.f));
            if (mat == 0) LM[i * 64 + j] = i > j ? GC[64 + i] * acc[r] * dec : 0.f;
            else ((LAS bf16_t*)(lds + P_AQ))[(((i >> 5) * 4 + (j >> 4)) * 64 + (i & 31) + 32 * ((j >> 2) & 1)) * 8 + ((j >> 3) & 1) * 4 + (j & 3)] = f2bf(i >= j ? acc[r] * dec : 0.f);
        }
    }
    __syncthreads();
    if (wave < 4) {
        const int cc = tid; const bool isu = cc < 128; const int col = cc & 127;
        float x[64];
        int zoff = 0; asm volatile("" : "+v"(zoff));
        SolveRow<63>::run(x, LM + zoff, VF, KF, GC + zoff, isu, col);
        if (isu) {
            float* gu = (float*)(ws + WS_GU) + (size_t)chunk * 8192 + (size_t)(col >> 5) * 2048;
#pragma unroll
            for (int ct = 0; ct < 2; ++ct)
#pragma unroll
                for (int i4 = 0; i4 < 4; ++i4)
#pragma unroll
                    for (int hh = 0; hh < 2; ++hh) { const int c0 = 32 * ct + 8 * i4 + 4 * hh;
                        *(f32x4*)(gu + ((ct * 4 + i4) * 64 + (col & 31) + 32 * hh) * 4) = (f32x4){x[c0], x[c0 + 1], x[c0 + 2], x[c0 + 3]}; }
        } else {
            LAS bf16_t* gw = (LAS bf16_t*)(lds + P_QB) + ((col >> 4) * 64 + 32 * ((col >> 2) & 1)) * 8 + ((col >> 3) & 1) * 4 + (col & 3);
#pragma unroll
            for (int i = 0; i < 64; ++i) gw[((i >> 5) * 8 * 64 + (i & 31)) * 8] = f2bf(-x[i]);
        }
    } else {
        const int t2 = tid - 256, dk = t2 & 127, c0 = (t2 >> 7) * 32; const float glast = GC[63];
        bf16_t* kg = (bf16_t*)(ws + WS_GKGT) + (size_t)chunk * 8192;
#pragma unroll
        for (int q = 0; q < 4; ++q) { const int kc = (c0 >> 4) + (q >> 1), hh = q & 1; float v[8];
#pragma unroll
            for (int e = 0; e < 8; ++e) { const int c = 16 * kc + 8 * (e >> 2) + 4 * hh + (e & 3); v[e] = KF[c * 128 + dk] * __expf(glast - GC[c]); }
            epi::st_bf16x8(kg + (size_t)(((dk >> 5) * 4 + kc) * 64 + (dk & 31) + 32 * hh) * 8, v); }
        if (t2 == 0) ((float*)(ws + WS_GGL))[chunk] = __expf(glast);
    }
    __syncthreads();
    { const LAS u32x4* sw = (const LAS u32x4*)(lds + P_QB); u32x4* dw = (u32x4*)(p.ws + WS_GW + (size_t)chunk * 16384);
      dw[tid] = sw[tid]; dw[512 + tid] = sw[512 + tid];
      ((u32x4*)(p.ws + WS_GAQK + (size_t)chunk * 8192))[tid] = ((const LAS u32x4*)(lds + P_AQ))[tid]; }
}

constexpr int SC_STAGE = 40960  , SC_X = 2 * SC_STAGE, SC_XB = 12288  ;
DI void scan_unit(const Params& p, LAS unsigned char* lds, int b, int h, int dvs) {
    int tid_ = threadIdx.x; asm volatile("" : "+v"(tid_)); const int tid = tid_, lane = tid & 63, wave = __builtin_amdgcn_readfirstlane(tid >> 6), hi = lane >> 5, cl = lane & 31;
    const unsigned char* ws = p.ws;
    const int chunk0 = (b * GH + h) * NCHUNK;
    __syncthreads();
    if (wave == 0) {
        f32x16 S[4]; for (int k = 0; k < 4; ++k) for (int i = 0; i < 16; ++i) S[k][i] = 0.f;
        float gl = ((const float*)(ws + WS_GGL))[chunk0];
        __syncthreads();
        for (int n = 0; n < NCHUNK; ++n) {
            const LAS unsigned char* st = lds + (n & 1) * SC_STAGE; LAS unsigned char* xb = lds + SC_X + (n & 1) * SC_XB;
            const float gln = n + 1 < NCHUNK ? ((const float*)(ws + WS_GGL))[chunk0 + n + 1] : 0.f;
            bf16x8 Sb[8];
#pragma unroll
            for (int ks = 0; ks < 8; ++ks) { Sb[ks] = attn::pack8(S[ks >> 1], (ks & 1) * 8); *(LAS bf16x8*)(xb + ks * 1024 + lane * 16) = Sb[ks]; }
            bf16x8 vb[4];
#pragma unroll
            for (int ct = 0; ct < 2; ++ct) { f32x16 vn;
#pragma unroll
                for (int i4 = 0; i4 < 4; ++i4) { const f32x4 u4 = *(const LAS f32x4*)(st + 32768 + (ct * 4 + i4) * 1024 + lane * 16); vn[4 * i4] = u4[0]; vn[4 * i4 + 1] = u4[1]; vn[4 * i4 + 2] = u4[2]; vn[4 * i4 + 3] = u4[3]; }
#pragma unroll
                for (int ks = 0; ks < 8; ++ks) vn = MFMA32(*(const LAS bf16x8*)(st + (ct * 8 + ks) * 1024 + lane * 16), Sb[ks], vn);
                vb[2 * ct] = attn::pack8(vn, 0); vb[2 * ct + 1] = attn::pack8(vn, 8);
                *(LAS bf16x8*)(xb + 8192 + (2 * ct) * 1024 + lane * 16) = vb[2 * ct]; *(LAS bf16x8*)(xb + 8192 + (2 * ct + 1) * 1024 + lane * 16) = vb[2 * ct + 1]; }
#pragma unroll
            for (int dkt = 0; dkt < 4; ++dkt) {
#pragma unroll
                for (int i = 0; i < 16; ++i) S[dkt][i] *= gl;
#pragma unroll
                for (int kc = 0; kc < 4; ++kc) S[dkt] = MFMA32(*(const LAS bf16x8*)(st + 16384 + (dkt * 4 + kc) * 1024 + lane * 16), vb[kc], S[dkt]); }
            gl = gln;
            __syncthreads();
        }
        __syncthreads();
        float* so = p.out + O_SP + (size_t)(b * GH + h) * 16384 + dvs * 32 + cl;
#pragma unroll
        for (int dkt = 0; dkt < 4; ++dkt)
#pragma unroll
            for (int r = 0; r < 16; ++r) so[(size_t)(dkt * 32 + crow(r, hi)) * 128] = S[dkt][r];
    } else if (wave <= 2) {
        const int par = wave - 1;
        bf16x8 qf[16], af[8];
#define SCAN_LDF(n_) do { const bf16_t* q_ = (const bf16_t*)(ws + WS_GQG) + (size_t)(chunk0 + (n_)) * 8192 + lane * 8; const bf16_t* a_ = (const bf16_t*)(ws + WS_GAQK) + (size_t)(chunk0 + (n_)) * 4096 + lane * 8; \
            _Pragma("unroll") for (int f = 0; f < 16; ++f) qf[f] = *(const bf16x8*)(q_ + f * 512); _Pragma("unroll") for (int f = 0; f < 8; ++f) af[f] = *(const bf16x8*)(a_ + f * 512); } while (0)
        SCAN_LDF(par);
        __syncthreads();
        for (int n = 0; n <= NCHUNK; ++n) {
            const int m = n - 1;
            if (m >= 0 && (m & 1) == par) {
                const LAS unsigned char* xb = lds + SC_X + (m & 1) * SC_XB;
                bf16x8 Sb[8], vb[4];
#pragma unroll
                for (int ks = 0; ks < 8; ++ks) Sb[ks] = *(const LAS bf16x8*)(xb + ks * 1024 + lane * 16);
#pragma unroll
                for (int kc = 0; kc < 4; ++kc) vb[kc] = *(const LAS bf16x8*)(xb + 8192 + kc * 1024 + lane * 16);
                float* og = (float*)(p.ws + WS_OG) + ((size_t)(b * GH + h) * TP + (size_t)m * 64) * 128 + dvs * 32 + cl;
#pragma unroll
                for (int ct = 0; ct < 2; ++ct) { f32x16 o; for (int i = 0; i < 16; ++i) o[i] = 0.f;
#pragma unroll
                    for (int ks = 0; ks < 8; ++ks) o = MFMA32(qf[ct * 8 + ks], Sb[ks], o);
#pragma unroll
                    for (int kc = 0; kc < 4; ++kc) o = MFMA32(af[ct * 4 + kc], vb[kc], o);
#pragma unroll
                    for (int r = 0; r < 16; ++r) og[(size_t)(ct * 32 + crow(r, hi)) * 128] = o[r]; }
                if (m + 2 < NCHUNK) SCAN_LDF(m + 2);
            }
            __syncthreads();
        }
    } else {
        const int t3 = tid - 192;
        u32x4 r0[8], r1[8], r2[8], r3[8];
#define SCAN_SRC(n_, q_) ({ const int pc_ = (q_) * 320 + t3; const unsigned char* s_ = pc_ < 1024 ? ws + WS_GW + (size_t)(chunk0 + (n_)) * 16384 + (size_t)pc_ * 16 \
            : pc_ < 2048 ? ws + WS_GKGT + (size_t)(chunk0 + (n_)) * 16384 + (size_t)(pc_ - 1024) * 16 : ws + WS_GU + (size_t)(chunk0 + (n_)) * 32768 + (size_t)dvs * 8192 + (size_t)(pc_ - 2048) * 16; s_; })
#define SCAN_ISSUE(R, n_) do { if ((n_) < NCHUNK) { _Pragma("unroll") for (int q = 0; q < 8; ++q) R[q] = *(const u32x4*)SCAN_SRC(n_, q); } } while (0)
#define SCAN_COMMIT(R, n_) do { if ((n_) < NCHUNK) { LAS unsigned char* d_ = lds + ((n_) & 1) * SC_STAGE; _Pragma("unroll") for (int q = 0; q < 8; ++q) *(LAS u32x4*)(d_ + (q * 320 + t3) * 16) = R[q]; } } while (0)
        SCAN_ISSUE(r0, 0); SCAN_ISSUE(r1, 1); SCAN_ISSUE(r2, 2); SCAN_ISSUE(r3, 3); SCAN_COMMIT(r0, 0);
        __syncthreads();
        for (int n = 0; n < NCHUNK; n += 4) {
            SCAN_COMMIT(r1, n + 1); SCAN_ISSUE(r0, n + 4); __syncthreads();
            SCAN_COMMIT(r2, n + 2); SCAN_ISSUE(r1, n + 5); __syncthreads();
            SCAN_COMMIT(r3, n + 3); SCAN_ISSUE(r2, n + 6); __syncthreads();
            SCAN_COMMIT(r0, n + 4); SCAN_ISSUE(r3, n + 7); __syncthreads();
        }
        __syncthreads();
    }
}

DI void post(const Params& p) {
    int tid_ = threadIdx.x; asm volatile("" : "+v"(tid_)); const int tid = tid_, lane = tid & 63;
    const int gh = (blockIdx.x * 512 + tid) >> 5, NGH = (gridDim.x * 512) >> 5, l32 = lane & 31;
    const f32x4 nw = *(const f32x4*)(p.gdn_norm + l32 * 4);
#pragma unroll 2
    for (int it = gh; it < MP * GH; it += NGH) {
        const int row = it >> 2, h = it & 3, b = row >> 13, t = row & (TP - 1);
        const f32x4 o = *(const f32x4*)((const float*)(p.ws + WS_OG) + ((size_t)(b * GH + h) * TP + t) * 128 + l32 * 4);
        float s = o[0] * o[0] + o[1] * o[1] + o[2] * o[2] + o[3] * o[3];
#pragma unroll
        for (int x = 1; x < 32; x <<= 1) s += __shfl_xor(s, x);
        const float rs = rsqrtf(s * (1.f / 128.f) + EPS);
        const u32x2 zz = *(const u32x2*)((const bf16_t*)(p.ws + WS_Z) + (size_t)row * 512 + h * 128 + l32 * 4);
        const float z0 = __uint_as_float(zz.x << 16), z1 = __uint_as_float(zz.x & 0xffff0000u), z2 = __uint_as_float(zz.y << 16), z3 = __uint_as_float(zz.y & 0xffff0000u);
        epi::st_bf16x4((bf16_t*)(p.ws + WS_MIX) + (size_t)row * DM + 512 + h * 128 + l32 * 4, o[0] * rs * nw[0] * siluf_(z0), o[1] * rs * nw[1] * siluf_(z1), o[2] * rs * nw[2] * siluf_(z2), o[3] * rs * nw[3] * siluf_(z3));
    }
}
}
namespace cmp {
constexpr int TSTR = 72, C_TOK = 0, C_PART = 76032, C_LDS = C_PART + 8 * 32 * 64 * 4;
constexpr int NSLAB = 8 + 128, NUNIT = NSLAB * 16;
DI void unit(const Params& p, LAS unsigned char* lds, int u) {
    int tid_ = threadIdx.x; asm volatile("" : "+v"(tid_)); const int tid = tid_, lane = tid & 63, wave = __builtin_amdgcn_readfirstlane(tid >> 6), hi = lane >> 5, cl = lane & 31;
    const unsigned char* ws = p.ws;
    const int sl = u >> 4, n0 = (u & 15) * 32;
    const bool samp = sl >= 8;
    int kv, bb, g;
    if (!samp) { kv = sl >> 2; bb = (sl >> 1) & 1; g = sl & 1; } else { const int s2 = sl - 8; kv = s2 >> 6; bb = (s2 >> 1) & 31; g = s2 & 1; }
    LAS bf16_t* TOK = (LAS bf16_t*)(lds + C_TOK); LAS float* PART = (LAS float*)(lds + C_PART);
    __syncthreads();
    if (!samp) {
        u32x4 w[9];
        const bf16_t* src = (const bf16_t*)(ws + (kv ? WS_VC : WS_KC)) + (size_t)(bb * 2 + g) * TP * 64;
#pragma unroll
        for (int q = 0; q < 9; ++q) { const int i = q * 512 + tid, tok = i >> 3, ch = i & 7, tk = n0 * 16 + tok;
            w[q] = (i < 528 * 8 && tk < TP) ? *(const u32x4*)(src + (size_t)tk * 64 + ch * 8) : (u32x4){0u, 0u, 0u, 0u}; }
#pragma unroll
        for (int q = 0; q < 9; ++q) { const int i = q * 512 + tid, tok = i >> 3, ch = i & 7;
            if (i < 528 * 8) *(LAS u32x4*)(TOK + ((tok & 15) * 33 + (tok >> 4)) * TSTR + ch * 8) = w[q]; }
    } else {
        int pg[9];
#pragma unroll
        for (int q = 0; q < 9; ++q) { const int i = q * 512 + tid, tok = i >> 3, tk = n0 * 16 + tok;
            pg[q] = (i < 528 * 8 && tk < TP) ? p.page_table[bb * NPAGES + (tk >> 7)] : -1; }
        f32x4 a[9], c[9];
#pragma unroll
        for (int q = 0; q < 9; ++q) { const int i = q * 512 + tid, tok = i >> 3, ch = i & 7, tk = n0 * 16 + tok;
            if (pg[q] >= 0) { const float* src = p.cache_kv + (((size_t)pg[q] * PAGE + (tk & 127)) * 4 + kv) * 128 + g * 64 + ch * 8;
                a[q] = __builtin_nontemporal_load((const f32x4*)src); c[q] = __builtin_nontemporal_load((const f32x4*)(src + 4)); }
            else { a[q] = (f32x4){0.f, 0.f, 0.f, 0.f}; c[q] = a[q]; } }
#pragma unroll
        for (int q = 0; q < 9; ++q) { const int i = q * 512 + tid, tok = i >> 3, ch = i & 7;
            u32x4 w; w.x = pk2(a[q][0], a[q][1]); w.y = pk2(a[q][2], a[q][3]); w.z = pk2(c[q][0], c[q][1]); w.w = pk2(c[q][2], c[q][3]);
            if (i < 528 * 8) *(LAS u32x4*)(TOK + ((tok & 15) * 33 + (tok >> 4)) * TSTR + ch * 8) = w; }
    }
    __syncthreads();
    f32x16 acc[2]; for (int i = 0; i < 16; ++i) { acc[0][i] = 0.f; acc[1][i] = 0.f; }
    const bf16_t* wt = (const bf16_t*)(ws + WS_WCMP) + (size_t)kv * 64 * 2048 + lane * 8;
#pragma unroll
    for (int k = 0; k < 16; ++k) {
        const int ks = wave * 16 + k, l = ks >> 2, d0 = (ks & 3) * 16;
        const bf16x8 a = *(const LAS bf16x8*)(TOK + ((l & 15) * 33 + cl + (l >> 4)) * TSTR + d0 + hi * 8);
        const bf16x8 b0 = *(const bf16x8*)(wt + (size_t)ks * 1024), b1 = *(const bf16x8*)(wt + (size_t)ks * 1024 + 512);
        acc[0] = MFMA32(a, b0, acc[0]); acc[1] = MFMA32(a, b1, acc[1]);
    }
#pragma unroll
    for (int et = 0; et < 2; ++et)
#pragma unroll
        for (int r = 0; r < 16; ++r) PART[(wave * 32 + crow(r, hi)) * 64 + et * 32 + cl] = acc[et][r];
    __syncthreads();
    const float* cst = (const float*)(ws + WS_CST) + kv * 64;
    for (int i = tid; i < 32 * 64; i += 512) {
        const int n = i >> 6, e = i & 63;
        float s = cst[e];
#pragma unroll
        for (int w = 0; w < 8; ++w) s += PART[(w * 32 + n) * 64 + e];
        const int ng = n0 + n;
        if (ng >= NCMP) s = 0.f;
        if (!samp) { if (kv == 0) ((bf16_t*)(p.ws + WS_CKP))[((size_t)(bb * 2 + g) * 512 + ng) * 64 + e] = f2bf(s);
                     else ((bf16_t*)(p.ws + WS_CVTP))[((size_t)(bb * 2 + g) * 64 + e) * 512 + ng] = f2bf(s); }
        else ((float*)(p.ws + (kv == 0 ? WS_CKS : WS_CVS)))[((size_t)(bb * 2 + g) * 512 + ng) * 64 + e] = s;
    }
}
constexpr int NTRUNIT = 2 * 4 * 128;
DI void tr_unit(const Params& p, LAS unsigned char* lds, int u) {
    int tid_ = threadIdx.x; asm volatile("" : "+v"(tid_)); const int tid = tid_;
    const int br = u >> 9, slab = (u >> 7) & 3, tile = u & 127;
    const bf16_t* src = (const bf16_t*)(p.ws + (br == 0 ? WS_VSEL : WS_VWIN)) + ((size_t)slab * TP + (size_t)tile * 64) * 64;
    bf16_t* dst = (bf16_t*)(p.ws + (br == 0 ? WS_VSELT : WS_VWINT)) + (size_t)slab * 64 * TP + (size_t)tile * 64;
    LAS bf16_t* T = (LAS bf16_t*)lds;
    __syncthreads();
    { const u32x4 w = *(const u32x4*)(src + (size_t)tid * 8); const int key = tid >> 3, d0 = (tid & 7) * 8; const unsigned ws4[4] = {w.x, w.y, w.z, w.w};
#pragma unroll
      for (int j = 0; j < 4; ++j) { T[(d0 + 2 * j) * 66 + key] = (bf16_t)(ws4[j] & 0xffffu); T[(d0 + 2 * j + 1) * 66 + key] = (bf16_t)(ws4[j] >> 16); } }
    __syncthreads();
    { const int d = tid >> 3, k0 = (tid & 7) * 8; unsigned o[4];
#pragma unroll
      for (int j = 0; j < 4; ++j) o[j] = (unsigned)T[d * 66 + k0 + 2 * j] | ((unsigned)T[d * 66 + k0 + 2 * j + 1] << 16);
      *(u32x4*)(dst + (size_t)d * TP + k0) = (u32x4){o[0], o[1], o[2], o[3]}; }
}
}
namespace samp {
constexpr int L_KP = 0, L_VP = 8192, L_SC = 16384, L_RED = 32768, L_QS = 34816, L_IMP = 35840, L_SELB = 36400, L_STAT = 36480;
constexpr int L_RED2 = 40960;
DI float attend(LAS unsigned char* lds, int nk) {
    int tid_ = threadIdx.x; asm volatile("" : "+v"(tid_)); const int tid = tid_, lane = tid & 63, wave = tid >> 6, kq = tid >> 4, dq = tid & 15;
    const float* const LAS* KP = (const float* const LAS*)(lds + L_KP); const float* const LAS* VP = (const float* const LAS*)(lds + L_VP);
    LAS float* SC = (LAS float*)(lds + L_SC); LAS float* RED2 = (LAS float*)(lds + L_RED2); const LAS float* QS = (const LAS float*)(lds + L_QS);
    __syncthreads();
    {
        f32x4 q[4];
#pragma unroll
        for (int r = 0; r < 4; ++r) q[r] = *(const LAS f32x4*)(QS + r * 64 + dq * 4);
        for (int j0 = 0; j0 < nk; j0 += 128) {
            f32x4 kv[4];
#pragma unroll
            for (int u = 0; u < 4; ++u) { const int j = j0 + u * 32 + kq; kv[u] = j < nk ? ((const f32x4*)KP[j])[dq] : (f32x4){0.f, 0.f, 0.f, 0.f}; }
#pragma unroll
            for (int u = 0; u < 4; ++u) { const int j = j0 + u * 32 + kq;
                float pr[4];
#pragma unroll
                for (int r = 0; r < 4; ++r) { float a = (kv[u][0] * q[r][0] + kv[u][1] * q[r][1]) + (kv[u][2] * q[r][2] + kv[u][3] * q[r][3]);
                    a += __shfl_xor(a, 1); a += __shfl_xor(a, 2); a += __shfl_xor(a, 4); a += __shfl_xor(a, 8); pr[r] = a; }
                if (j < nk && dq < 4) SC[dq * 1024 + j] = dq == 0 ? pr[0] : dq == 1 ? pr[1] : dq == 2 ? pr[2] : pr[3]; }
        }
    }
    __syncthreads();
    if (wave < 4) {
        LAS float* sc = SC + wave * 1024;
        float m = NEGBIG; for (int j = lane; j < nk; j += 64) m = fmaxf(m, sc[j]);
#pragma unroll
        for (int o = 1; o < 64; o <<= 1) m = fmaxf(m, __shfl_xor(m, o));
        float l = 0.f; for (int j = lane; j < nk; j += 64) { const float e = __builtin_amdgcn_exp2f(sc[j] - m); sc[j] = e; l += e; }
        l = wave_sum(l); const float inv = 1.f / l;
        for (int j = lane; j < nk; j += 64) sc[j] *= inv;
    }
    __syncthreads();
    {
        f32x4 acc[4]; for (int r = 0; r < 4; ++r) acc[r] = (f32x4){0.f, 0.f, 0.f, 0.f};
        for (int j0 = 0; j0 < nk; j0 += 128) {
            f32x4 vv[4];
#pragma unroll
            for (int u = 0; u < 4; ++u) { const int j = j0 + u * 32 + kq; vv[u] = j < nk ? ((const f32x4*)VP[j])[dq] : (f32x4){0.f, 0.f, 0.f, 0.f}; }
#pragma unroll
            for (int u = 0; u < 4; ++u) { const int j = j0 + u * 32 + kq;
                if (j < nk) {
#pragma unroll
                    for (int r = 0; r < 4; ++r) acc[r] += SC[r * 1024 + j] * vv[u]; } }
        }
#pragma unroll
        for (int r = 0; r < 4; ++r) *(LAS f32x4*)(RED2 + kq * 256 + r * 64 + dq * 4) = acc[r];
    }
    __syncthreads();
    float o = 0.f;
    if (tid < 256) {
#pragma unroll 8
        for (int k = 0; k < 32; ++k) o += RED2[k * 256 + tid];
    }
    return o;
}

DI void attn_unit(const Params& p, LAS unsigned char* lds, int bs, int g) {
    int tid_ = threadIdx.x; asm volatile("" : "+v"(tid_)); const int tid = tid_, lane = tid & 63, wave = tid >> 6;
    const unsigned char* ws = p.ws;
    const float* LAS* KP = (const float* LAS*)(lds + L_KP); const float* LAS* VP = (const float* LAS*)(lds + L_VP);
    LAS float* SC = (LAS float*)(lds + L_SC); LAS float* QS = (LAS float*)(lds + L_QS); LAS float* IMP = (LAS float*)(lds + L_IMP); LAS int* SELB = (LAS int*)(lds + L_SELB);
    const size_t row = (size_t)MP + bs;
    __syncthreads();
    if (tid < 256) QS[tid] = bf2f(((const bf16_t*)(ws + WS_QB))[row * 512 + g * 256 + tid]);
    float gate[3] = {0.f, 0.f, 0.f};
    if (tid < 256) { const float* gt = (const float*)(ws + WS_GT) + row * 32 + (g * 4 + (tid >> 6)) * 3; gate[0] = gt[0]; gate[1] = gt[1]; gate[2] = gt[2]; }
    { const float* ck = (const float*)(ws + WS_CKS) + (size_t)(bs * 2 + g) * 512 * 64; const float* cv = (const float*)(ws + WS_CVS) + (size_t)(bs * 2 + g) * 512 * 64;
      for (int j = tid; j < NCMP; j += 512) { KP[j] = ck + j * 64; VP[j] = cv + j * 64; } }
    float ofin = gate[0] * attend(lds, NCMP);
    if (tid < 128) { const int s = tid; float a = 0.f;
        for (int n = 4 * s - 1; n <= 4 * s + 3; ++n) if (n >= 0 && n < NCMP) a += (SC[n] + SC[1024 + n]) + (SC[2048 + n] + SC[3072 + n]);
        IMP[s] = a; }
    __syncthreads();
    if (wave == 0) {
        const unsigned long long lt = (1ull << lane) - 1ull;
        const int xA = __float_as_int(IMP[lane] + (lane == 0 ? 1e4f : 0.f)), xB = __float_as_int(IMP[64 + lane] + (lane == 63 ? 1e4f : 0.f));
        int T = 0;
        for (int bit = 30; bit >= 0; --bit) { const int T2 = T | (1 << bit); const int c = __popcll(__ballot(xA >= T2)) + __popcll(__ballot(xB >= T2)); if (c >= 15) T = T2; }
        const bool gA = xA > T, gB = xB > T, eA = xA == T, eB = xB == T;
        const int need = 15 - (__popcll(__ballot(gA)) + __popcll(__ballot(gB)));
        const unsigned long long beA = __ballot(eA), beB = __ballot(eB);
        const bool sA = gA || (eA && __popcll(beA & lt) < need), sB = gB || (eB && __popcll(beA) + __popcll(beB & lt) < need);
        const unsigned long long mA = __ballot(sA), mB = __ballot(sB);
        if (sA) SELB[__popcll(mA & lt)] = lane;
        if (sB) SELB[__popcll(mA) + __popcll(mB & lt)] = 64 + lane;
    }
    __syncthreads();
    for (int j = tid; j < 961; j += 512) {
        if (j < 960) { const int tp = SELB[j >> 6] * 64 + (j & 63); const int page = p.page_table[bs * NPAGES + (tp >> 7)];
            const float* rb = p.cache_kv + ((size_t)page * PAGE + (tp & 127)) * 512 + g * 64; KP[j] = rb + 256; VP[j] = rb + 384; }
        else { const float* rb = p.out + O_KVS + (size_t)bs * 512 + g * 64; KP[j] = rb + 256; VP[j] = rb + 384; }
    }
    ofin += gate[1] * attend(lds, 961);
    for (int j = tid; j < 513; j += 512) {
        const float* rb = j < 512 ? p.cache_win + ((size_t)bs * 512 + j) * 256 + g * 64 : p.out + O_WINS + ((size_t)bs * 512 + 511) * 256 + g * 64;
        KP[j] = rb; VP[j] = rb + 128; }
    ofin += gate[2] * attend(lds, 513);
    if (tid < 256) ((bf16_t*)(p.ws + WS_MIX))[row * DM + g * 256 + tid] = f2bf(ofin);
}

DI void gdn_unit(const Params& p, LAS unsigned char* lds, int bs, int h) {
    int tid_ = threadIdx.x; asm volatile("" : "+v"(tid_)); const int tid = tid_, lane = tid & 63;
    const unsigned char* ws = p.ws;
    LAS float* QKV = (LAS float*)lds;
    LAS float* RED = QKV + 384;
    LAS float* VN = RED + 1024;
    LAS float* ST = VN + 128;
    const size_t row = (size_t)MP + bs;
    __syncthreads();
    if (tid < 384) {
        const int part = tid >> 7, dd = tid & 127, ch = part * 512 + h * 128 + dd;
        const float* st = p.state_conv + (size_t)bs * 3 * CCH + ch;
        const float xn = p.out[O_CONVS + (size_t)(bs * 3 + 2) * CCH + ch];
        const float a = st[0] * p.conv_w[ch] + st[CCH] * p.conv_w[CCH + ch] + st[2 * CCH] * p.conv_w[2 * CCH + ch] + xn * p.conv_w[3 * CCH + ch];
        const float c = siluf_(a);
        QKV[tid] = c;
        float s = wave_sum(c * c);
        if (lane == 0) ST[tid >> 6] = s;
    }
    __syncthreads();
    const float rq = rsqrtf(ST[0] + ST[1] + EPS) * 0.08838834764831845f, rk = rsqrtf(ST[2] + ST[3] + EPS);
    const float* gt = (const float*)(ws + WS_GT) + row * 32;
    const float eg = __expf(gt[24 + h]), beta = gt[28 + h];
    const int dv = tid & 127, qd = tid >> 7;
    const float* S0 = p.state_S + (size_t)(bs * GH + h) * 16384;
    float sreg[32], ks = 0.f, qs = 0.f, qk = 0.f;
#pragma unroll
    for (int i = 0; i < 32; ++i) { const int dk = qd * 32 + i; const float s = S0[dk * 128 + dv]; sreg[i] = s; const float kk = QKV[128 + dk] * rk, qq = QKV[dk] * rq; ks += kk * s; qs += qq * s; qk += kk * qq; }
    RED[(qd * 2 + 0) * 128 + dv] = ks; RED[(qd * 2 + 1) * 128 + dv] = qs;
    if (dv == 0) ST[8 + qd] = qk;
    __syncthreads();
    const float kS = (RED[dv] + RED[256 + dv]) + (RED[512 + dv] + RED[768 + dv]);
    const float qS = (RED[128 + dv] + RED[384 + dv]) + (RED[640 + dv] + RED[896 + dv]);
    const float qkd = (ST[8] + ST[9]) + (ST[10] + ST[11]);
    const float vn = beta * (QKV[256 + dv] - eg * kS);
    const float o = eg * qS + qkd * vn;
    float* Sn = p.out + O_SS + (size_t)(bs * GH + h) * 16384;
#pragma unroll
    for (int i = 0; i < 32; ++i) { const int dk = qd * 32 + i; Sn[dk * 128 + dv] = eg * sreg[i] + QKV[128 + dk] * rk * vn; }
    if (tid < 128) {
        float s = wave_sum(o * o); if (lane == 0) ST[16 + (tid >> 6)] = s;
    }
    __syncthreads();
    if (tid < 128) {
        const float rs = rsqrtf((ST[16] + ST[17]) * (1.f / 128.f) + EPS);
        const float z = bf2f(((const bf16_t*)(ws + WS_Z))[row * 512 + h * 128 + tid]);
        ((bf16_t*)(p.ws + WS_MIX))[row * DM + 512 + h * 128 + tid] = f2bf(o * rs * p.gdn_norm[tid] * siluf_(z));
    }
}
}
#define RLX_AGENT __ATOMIC_RELAXED, __HIP_MEMORY_SCOPE_AGENT
#define XB_TMO      128
#define XB_XCNT(j)  (256  + 64 * (j))
#define XB_XSUB(j)  (1280 + 64 * (j))
#define XB_XGEN(j)  (2304 + 64 * (j))
#define XB_TOP      3328
#define XB_TOPGEN   3392
#define XCD_BAR_WORDS 3456
#define XB_SPIN_CAP (1u << 18)

__device__ __forceinline__ unsigned xb_ld(unsigned* p)              { return __hip_atomic_load(p, __ATOMIC_RELAXED, __HIP_MEMORY_SCOPE_AGENT); }
__device__ __forceinline__ unsigned xb_add(unsigned* p, unsigned v) { return __hip_atomic_fetch_add(p, v, __ATOMIC_RELAXED, __HIP_MEMORY_SCOPE_AGENT); }
__device__ __forceinline__ unsigned xb_xcc_id() { return (unsigned)__builtin_amdgcn_s_getreg((3 << 11) | 20) & 0xFu; }
#define XB_SPIN(cond, bar) do { unsigned _sp = 0; while (cond) { __builtin_amdgcn_s_sleep(1); \
    if ((++_sp & 255u) == 0u) { if (xb_ld(&(bar)[XB_TMO])) break; if (_sp > XB_SPIN_CAP) { atomicAdd(&(bar)[XB_TMO], 1u); break; } } } } while (0)

struct XcdBarrier {
    unsigned* bar; unsigned x;
    volatile LAS unsigned* st;
};

__device__ __forceinline__ XcdBarrier xcd_barrier_post(unsigned* bar, volatile LAS unsigned* st) {
    XcdBarrier b; b.bar = bar; b.x = xb_xcc_id(); b.st = st;
    if (threadIdx.x == 0) (void)xb_add(&bar[XB_XCNT(b.x)], 1u);
    return b;
}
__device__ __forceinline__ void xcd_barrier_complete(unsigned* bar, unsigned x, unsigned& nloc, unsigned& nx) {
    const unsigned G = gridDim.x * gridDim.y * gridDim.z;
    unsigned sum, cnt, mine, sp = 0u;
    for (;;) {
        sum = 0u; cnt = 0u; mine = 0u;
#pragma unroll
        for (unsigned j = 0; j < 16; ++j) { const unsigned c = xb_ld(&bar[XB_XCNT(j)]); sum += c; cnt += (c > 0u) ? 1u : 0u; mine = (j == x) ? c : mine; }
        if (sum == G) break;
        __builtin_amdgcn_s_sleep(1);
        if ((++sp & 255u) == 0u) { if (xb_ld(&bar[XB_TMO])) break; if (sp > XB_SPIN_CAP) { atomicAdd(&bar[XB_TMO], 1u); break; } }
    }
    nloc = mine > 0u ? mine : 1u; nx = cnt > 0u ? cnt : 1u;
}

__device__ __forceinline__ void xcd_barrier(const XcdBarrier& b) {
    asm volatile("s_waitcnt vmcnt(0)" ::: "memory");
    __syncthreads();
    if (threadIdx.x == 0) {
        unsigned* bar = b.bar;
        __builtin_amdgcn_s_waitcnt(0);
        unsigned nloc = b.st[0], nx = b.st[1];
        if (nloc == 0u) { xcd_barrier_complete(bar, b.x, nloc, nx); b.st[0] = nloc; b.st[1] = nx; }
        const unsigned old = xb_add(&bar[XB_XSUB(b.x)], 1u);
        const unsigned gen = old / nloc;
        if (old + 1u == (gen + 1u) * nloc) {
            __builtin_amdgcn_fence(__ATOMIC_RELEASE, "agent");
            asm volatile("s_waitcnt vmcnt(0)" ::: "memory");
            const unsigned og = xb_add(&bar[XB_TOP], 1u);
            const unsigned tg = og / nx;
            if (og + 1u == (tg + 1u) * nx) xb_add(&bar[XB_TOPGEN], 1u);
            else XB_SPIN(xb_ld(&bar[XB_TOPGEN]) == tg, bar);
            __builtin_amdgcn_fence(__ATOMIC_ACQUIRE, "agent");
            xb_add(&bar[XB_XGEN(b.x)], 1u);
            asm volatile("s_waitcnt vmcnt(0)" ::: "memory");
        } else {
            XB_SPIN(xb_ld(&bar[XB_XGEN(b.x)]) == gen, bar);
            __builtin_amdgcn_fence(__ATOMIC_ACQUIRE, "agent");
            asm volatile("s_waitcnt vmcnt(0)" ::: "memory");
        }
    }
    __syncthreads();
}
constexpr int NTHREADS = 512;
constexpr int LDS_BYTES = 147456;
constexpr int LDS_SLOT = LDS_BYTES - 16, LDS_BARW = LDS_BYTES - 32;
constexpr int CW_BAR = 4096;

DI int next_unit(unsigned* ctr, LAS unsigned char* lds) {
    LAS int* slot = (LAS int*)(lds + LDS_SLOT);
    __syncthreads();
    if (threadIdx.x == 0) *slot = (int)atomicAdd(ctr, 1u);
    __syncthreads();
    return *slot;
}

DI void phase_proj(const Params& p, LAS unsigned char* lds) {
    pg8::Gemm g{(const bf16_t*)(p.ws + WS_XN), (const bf16_t*)(p.ws + WS_WIN), MROWS, INW_PAD, DM};
    pg8::StaticOrder S; S.init(MROWS, INW_PAD, gridDim.x, blockIdx.x);
    epi::EpiProj E{p.out, p.ws, p.a_log, p.dt_bias};
    pg8::gemm_phase<epi::EpiProj, pg8::StaticOrder, true, true>(lds, g, S, E);
}
#if MK_PROBE == 2
DI void probe_prep_part(const Params& p, LAS unsigned char* lds, int part) {
    unsigned* ctr = (unsigned*)(p.ws + WS_CTL) + 512 + 16 * part;
    const int nu = part == 0 ? cmp::NUNIT : part == 1 ? NBP * GH * NCHUNK : cmp::NTRUNIT;
    for (;;) { const int u = next_unit(ctr, lds); if (u >= nu) break; Params q = p; asm volatile("" : "+s"(q.ws), "+s"(q.out));
        if (part == 0) cmp::unit(q, lds, cmp::NUNIT - 1 - u); else if (part == 1) gdn::prep_unit(q, lds, u >> 9, (u >> 7) & 3, u & 127); else cmp::tr_unit(q, lds, u); }
}
DI void probe_mix_part(const Params& p, LAS unsigned char* lds, int part) {
    unsigned* ctr = (unsigned*)(p.ws + WS_CTL) + 640 + 16 * part;
    const int nu = part == 0 ? 32 : part == 1 ? 192 : 512;
    for (;;) { const int u = next_unit(ctr, lds); if (u >= nu) break; Params q = p; asm volatile("" : "+s"(q.ws), "+s"(q.out));
        if (part == 0) gdn::scan_unit(q, lds, u >> 4, (u >> 2) & 3, u & 3);
        else if (part == 1) { if (u < 64) samp::attn_unit(q, lds, u >> 1, u & 1); else { const int v = u - 64; samp::gdn_unit(q, lds, v >> 2, v & 3); } }
        else attn::unit(q, lds, (u >> 1) & 1, u & 1, 127 - (u >> 2)); }
}
#endif
DI void phase_prep(const Params& p, LAS unsigned char* lds, int rep = 0) {
    unsigned* ctr = (unsigned*)(p.ws + WS_CTL) + 64 + 256 * rep;
    constexpr int NU = cmp::NUNIT + NBP * GH * NCHUNK + cmp::NTRUNIT;
    for (;;) {
        const int u = next_unit(ctr, lds); if (u >= NU) break;
        Params q = p; asm volatile("" : "+s"(q.ws), "+s"(q.out));
        if (u < cmp::NUNIT) { const int v = cmp::NUNIT - 1 - u; cmp::unit(q, lds, v); }
        else if (u < cmp::NUNIT + NBP * GH * NCHUNK) { const int v = u - cmp::NUNIT; gdn::prep_unit(q, lds, v >> 9, (v >> 7) & 3, v & 127); }
        else cmp::tr_unit(q, lds, u - cmp::NUNIT - NBP * GH * NCHUNK);
    }
}
DI void phase_mix(const Params& p, LAS unsigned char* lds, int rep = 0) {
    unsigned* ctr = (unsigned*)(p.ws + WS_CTL) + 128 + 256 * rep;
    for (;;) {
        const int u = next_unit(ctr, lds); if (u >= 224) break;
        Params q = p; asm volatile("" : "+s"(q.ws), "+s"(q.out));
        if (u < 32) gdn::scan_unit(q, lds, u >> 4, (u >> 2) & 3, u & 3);
        else if (u < 96) { const int v = u - 32; samp::attn_unit(q, lds, v >> 1, v & 1); }
        else { const int v = u - 96; samp::gdn_unit(q, lds, v >> 2, v & 3); }
    }
    const int myq = (int)((xb_xcc_id() >> 1) & 3u);
    for (int k = 0; k < 4; ++k) {
        const int qq = (myq + k) & 3;
        for (;;) {
            const int v = next_unit(ctr + 16 * (1 + qq), lds); if (v >= 128) break;
            Params q = p; asm volatile("" : "+s"(q.ws), "+s"(q.out));
            attn::unit(q, lds, qq >> 1, qq & 1, 127 - v);
        }
    }
}
template <int MODE> DI void skinny_rows(const Params& p, LAS unsigned char* lds, const bf16_t* A, const bf16_t* Bt, int K, int N) {
    int tid_ = threadIdx.x; asm volatile("" : "+v"(tid_)); const int tid = tid_, lane = tid & 63, wave = __builtin_amdgcn_readfirstlane(tid >> 6), hi = lane >> 5, cl = lane & 31;
    const int tile = blockIdx.x; if (tile >= N / 32) return;
    const int nks = K / 16, per = (nks + 7) / 8, k0 = wave * per, k1 = (k0 + per < nks) ? k0 + per : nks;
    const bf16_t* a = A + (size_t)(MP + cl) * K + hi * 8; const bf16_t* b = Bt + (size_t)(tile * 32 + cl) * K + hi * 8;
    f32x16 acc; for (int i = 0; i < 16; ++i) acc[i] = 0.f;
#pragma unroll 4
    for (int ks = k0; ks < k1; ++ks) acc = MFMA32(*(const bf16x8*)(a + ks * 16), *(const bf16x8*)(b + ks * 16), acc);
    LAS float* PART = (LAS float*)lds;
    __syncthreads();
#pragma unroll
    for (int r = 0; r < 16; ++r) PART[(wave * 32 + crow(r, hi)) * 32 + cl] = acc[r];
    __syncthreads();
    for (int i = tid; i < 1024; i += NTHREADS) {
        const int row = i >> 5, col = tile * 32 + (i & 31); float s = 0.f;
#pragma unroll
        for (int w = 0; w < 8; ++w) s += PART[(w * 32 + row) * 32 + (i & 31)];
        float* hp = (float*)(p.ws + WS_HP) + (size_t)(MP + row) * DM + col;
        if (MODE == 0) { const float h = p.x_sample[(size_t)row * DM + col] + s; *hp = h; ((bf16_t*)(p.ws + WS_HPB))[(size_t)(MP + row) * DM + col] = f2bf(h);
            float sq = h * h; sq += __shfl_xor(sq, 1); sq += __shfl_xor(sq, 2); sq += __shfl_xor(sq, 4); sq += __shfl_xor(sq, 8); sq += __shfl_xor(sq, 16);
            if ((i & 31) == 0) atomicAdd((float*)(p.ws + WS_SSQ1) + MP + row, sq); }
        else *hp += s;
    }
    __syncthreads();
}

DI void phase_out(const Params& p, LAS unsigned char* lds) {
    pg8::Gemm g{(const bf16_t*)(p.ws + WS_MIX), (const bf16_t*)(p.ws + WS_WOUT), MP, DM, DM};
    pg8::StaticOrder S; S.init(MP, DM, gridDim.x, blockIdx.x);
    epi::EpiOut E{p.x_prompt, p.x_sample, p.ws};
    pg8::gemm_phase<epi::EpiOut, pg8::StaticOrder, true, true>(lds, g, S, E);
    skinny_rows<0>(p, lds, (const bf16_t*)(p.ws + WS_MIX), (const bf16_t*)(p.ws + WS_WOUT), DM, DM);
}
DI void phase_up(const Params& p, LAS unsigned char* lds) {
    pg8::Gemm g{(const bf16_t*)(p.ws + WS_HPB), (const bf16_t*)(p.ws + WS_WGU), MROWS, 2 * DFF, DM};
    pg8::StaticOrder S; S.init(MROWS, 2 * DFF, gridDim.x, blockIdx.x);
    epi::EpiUp E{p.ws};
    pg8::gemm_phase<epi::EpiUp, pg8::StaticOrder, true, true>(lds, g, S, E);
}
DI void phase_down(const Params& p, LAS unsigned char* lds) {
    pg8::Gemm g{(const bf16_t*)(p.ws + WS_HID), (const bf16_t*)(p.ws + WS_WDN), MP, DM, DFF};
    pg8::StaticOrder S; S.init(MP, DM, gridDim.x, blockIdx.x);
    epi::EpiDown E{p.ws};
    pg8::gemm_phase<epi::EpiDown, pg8::StaticOrder, true, true>(lds, g, S, E);
    skinny_rows<1>(p, lds, (const bf16_t*)(p.ws + WS_HID), (const bf16_t*)(p.ws + WS_WDN), DFF, DM);
}
DI void phase_final(const Params& p) {
    int tid_ = threadIdx.x; asm volatile("" : "+v"(tid_)); const int tid = tid_, lane = tid & 63, gw = blockIdx.x * 8 + (tid >> 6), NGW = gridDim.x * 8;
    f32x4 g[4];
#pragma unroll
    for (int j = 0; j < 4; ++j) g[j] = *(const f32x4*)(p.norm_final + (j * 64 + lane) * 4);
    for (int row0 = gw; row0 < MP + NBS; row0 += 2 * NGW) {
        const int row1 = row0 + NGW; const bool has1 = row1 < MP + NBS;
        const float* h0 = (const float*)(p.ws + WS_HP) + (size_t)row0 * DM; const float* h1 = (const float*)(p.ws + WS_HP) + (size_t)(has1 ? row1 : row0) * DM;
        f32x4 v0[4], v1[4]; float s0 = 0.f, s1 = 0.f;
#pragma unroll
        for (int j = 0; j < 4; ++j) { v0[j] = __builtin_nontemporal_load((const f32x4*)(h0 + (j * 64 + lane) * 4)); v1[j] = __builtin_nontemporal_load((const f32x4*)(h1 + (j * 64 + lane) * 4)); }
#pragma unroll
        for (int j = 0; j < 4; ++j) { s0 += v0[j][0] * v0[j][0] + v0[j][1] * v0[j][1] + v0[j][2] * v0[j][2] + v0[j][3] * v0[j][3]; s1 += v1[j][0] * v1[j][0] + v1[j][1] * v1[j][1] + v1[j][2] * v1[j][2] + v1[j][3] * v1[j][3]; }
        const float r0 = rsqrtf(wave_sum(s0) * (1.f / DM) + EPS), r1 = rsqrtf(wave_sum(s1) * (1.f / DM) + EPS);
        float* o0 = row0 < MP ? p.out + O_YP + (size_t)row0 * DM : p.out + O_YS + (size_t)(row0 - MP) * DM;
#pragma unroll
        for (int j = 0; j < 4; ++j) __builtin_nontemporal_store((f32x4){v0[j][0] * r0 * g[j][0], v0[j][1] * r0 * g[j][1], v0[j][2] * r0 * g[j][2], v0[j][3] * r0 * g[j][3]}, (f32x4*)(o0 + (j * 64 + lane) * 4));
        if (has1) { float* o1 = row1 < MP ? p.out + O_YP + (size_t)row1 * DM : p.out + O_YS + (size_t)(row1 - MP) * DM;
#pragma unroll
            for (int j = 0; j < 4; ++j) __builtin_nontemporal_store((f32x4){v1[j][0] * r1 * g[j][0], v1[j][1] * r1 * g[j][1], v1[j][2] * r1 * g[j][2], v1[j][3] * r1 * g[j][3]}, (f32x4*)(o1 + (j * 64 + lane) * 4)); }
    }
}

#define LDS_DECL extern __shared__ __attribute__((aligned(16))) unsigned char lds_raw[]; LAS unsigned char* lds = (LAS unsigned char*)lds_raw
#ifndef MK_MULTI
#define MK_MULTI 0
#endif
#ifndef MK_DUP
#define MK_DUP 0
#endif
#if MK_MULTI
__global__ void __launch_bounds__(NTHREADS, 2) k_p0(Params p) { p0::run(p); }
__global__ void __launch_bounds__(NTHREADS, 2) k_p1(Params p) { LDS_DECL; phase_proj(p, lds); }
__global__ void __launch_bounds__(NTHREADS, 2) k_p2(Params p) { LDS_DECL; phase_prep(p, lds); }
__global__ void __launch_bounds__(NTHREADS, 2) k_p3(Params p) { LDS_DECL; phase_mix(p, lds); }
__global__ void __launch_bounds__(NTHREADS, 2) k_p4(Params p) { gdn::post(p); }
__global__ void __launch_bounds__(NTHREADS, 2) k_p5(Params p) { LDS_DECL; phase_out(p, lds); }
__global__ void __launch_bounds__(NTHREADS, 2) k_p6(Params p) { LDS_DECL; phase_up(p, lds); }
__global__ void __launch_bounds__(NTHREADS, 2) k_p7(Params p) { LDS_DECL; phase_down(p, lds); }
__global__ void __launch_bounds__(NTHREADS, 2) k_p8(Params p) { phase_final(p); }
#else
__global__ void __launch_bounds__(NTHREADS, 2) k_mega(Params p) {
    LDS_DECL;
    cg::grid_group grid = cg::this_grid();
    if (threadIdx.x < 2) ((LAS unsigned*)(lds + LDS_BARW))[threadIdx.x] = 0u;
    __syncthreads();
    const XcdBarrier xbar = xcd_barrier_post((unsigned*)(p.ws + WS_CTL) + CW_BAR, (volatile LAS unsigned*)(lds + LDS_BARW));
#define SEAM() xcd_barrier(xbar)
#define PHASE(call) do { Params q = p; asm volatile("" : "+s"(q.ws), "+s"(q.out)); call; } while (0)
#if MK_PROBE
    unsigned long long* ts = (unsigned long long*)(p.ws + WS_CTL) + 1024;
#define STAMP(k) do { if (blockIdx.x == 0 && threadIdx.x == 0) ts[k] = __builtin_amdgcn_s_memrealtime(); } while (0)
#else
#define STAMP(k) do { } while (0)
#endif
    STAMP(0);
#if MK_PROBE == 2
    if (blockIdx.x == 0 && threadIdx.x < 8) g_acc[threadIdx.x] = 0ull;
#endif
    PHASE(p0::run(q));            grid.sync(); STAMP(1);
#if MK_DUP & 1
    PHASE(p0::run(q));            SEAM();
#endif
    PHASE(phase_proj(q, lds));    SEAM();      STAMP(2);
#if MK_DUP & 16
    PHASE(phase_proj(q, lds));    SEAM();
#endif
#if MK_PROBE == 2
    PHASE(probe_prep_part(q, lds, 0)); SEAM(); STAMP(10);
    PHASE(probe_prep_part(q, lds, 1)); SEAM(); STAMP(11);
    PHASE(probe_prep_part(q, lds, 2)); SEAM(); STAMP(3);
#else
    PHASE(phase_prep(q, lds));    SEAM();      STAMP(3);
#endif
#if MK_DUP & 2
    PHASE(phase_prep(q, lds, 1)); SEAM();
#endif
#if MK_PROBE == 2
    PHASE(probe_mix_part(q, lds, 0)); SEAM(); STAMP(12);
    PHASE(probe_mix_part(q, lds, 1)); SEAM(); STAMP(13);
    PHASE(probe_mix_part(q, lds, 2)); SEAM(); STAMP(4);
#else
    PHASE(phase_mix(q, lds));     SEAM();      STAMP(4);
#endif
#if MK_DUP & 4
    PHASE(phase_mix(q, lds, 1));  SEAM();
#endif
#if MK_DUP & 8
    SEAM(); SEAM(); SEAM(); SEAM(); SEAM(); SEAM(); SEAM(); SEAM();
#endif
    PHASE(gdn::post(q));          SEAM();      STAMP(5);
#if MK_DUP & 64
    PHASE(gdn::post(q));          SEAM();
#endif
    PHASE(phase_out(q, lds));     SEAM();      STAMP(6);
    PHASE(phase_up(q, lds));      SEAM();      STAMP(7);
#if MK_DUP & 32
    PHASE(phase_up(q, lds));      SEAM();
#endif
    PHASE(phase_down(q, lds));    SEAM();      STAMP(8);
    PHASE(phase_final(q));
#if MK_PROBE
    grid.sync(); STAMP(9);
    if (blockIdx.x == 0) {
        __syncthreads();
        const size_t offs[10] = {O_YP, O_YS, O_KVP, O_WINP, O_SP, O_CONVP, O_KVS, O_WINS, O_SS, O_CONVS};
#if MK_PROBE == 2
        const unsigned long long dur[10] = {ts[4] - ts[13], g_acc[0], g_acc[1], g_acc[2], g_acc[3], g_acc[4], g_acc[5], g_acc[6], g_acc[7], ts[12] - ts[3]};
        for (int k = 0; k < 10; ++k) { int n = (int)(dur[k] / 500ull); if (n > 9000) n = 9000; if (n < 1) n = 1;
            unsigned* o = (unsigned*)(p.out + offs[k]); for (int i = threadIdx.x; i < n; i += NTHREADS) o[i] = 0xAAAAAAAAu; }
        if (false)
#endif
        for (int k = 0; k < 10; ++k) {
            const unsigned long long t0 = k < 9 ? ts[k] : ts[0], t1 = k < 9 ? ts[k + 1] : ts[9];
            int n = (int)((t1 - t0) / 500ull); if (k == 9) n = (int)((t1 - t0) / 2000ull);
            if (n > 9000) n = 9000; if (n < 1) n = 1;
            unsigned* o = (unsigned*)(p.out + offs[k]);
            for (int i = threadIdx.x; i < n; i += NTHREADS) o[i] = 0xAAAAAAAAu;
        }
    }
#endif
}
#endif

extern "C" void kernel_launch(void* const* d_in, const int* in_sizes, int n_in, void* d_out, int out_size, void* d_ws, size_t ws_size, hipStream_t stream) {
    static int grid = 0;
    if (grid == 0) {
        if (n_in != 20 || out_size != (int)O_END || ws_size < WS_END) { fprintf(stderr, "kernel_launch: unexpected shapes n_in %d out %d ws %zu\n", n_in, out_size, ws_size); grid = -1; return; }
        int dev = 0, cus = 0;
        (void)hipGetDevice(&dev); (void)hipDeviceGetAttribute(&cus, hipDeviceAttributeMultiprocessorCount, dev);
#if MK_MULTI
        const void* ks[] = {(const void*)k_p1, (const void*)k_p2, (const void*)k_p3, (const void*)k_p5, (const void*)k_p6, (const void*)k_p7};
        for (auto k : ks) (void)hipFuncSetAttribute(k, hipFuncAttributeMaxDynamicSharedMemorySize, LDS_BYTES);
        grid = cus > 0 ? cus : 256;
#else
        (void)hipFuncSetAttribute((const void*)k_mega, hipFuncAttributeMaxDynamicSharedMemorySize, LDS_BYTES);
        int per_cu = 0;
        if (hipOccupancyMaxActiveBlocksPerMultiprocessor(&per_cu, (const void*)k_mega, NTHREADS, LDS_BYTES) != hipSuccess || per_cu < 1) { fprintf(stderr, "kernel_launch: occupancy query failed (%d)\n", per_cu); (void)hipGetLastError(); per_cu = 1; }
        if (per_cu > 1) per_cu = 1;
        grid = (cus > 0 ? cus : 256) * per_cu;
#endif
    }
    if (grid < 0) return;
    Params p{};
    p.x_prompt = (const float*)d_in[0]; p.x_sample = (const float*)d_in[1]; p.cache_kv = (const float*)d_in[2]; p.cache_win = (const float*)d_in[3];
    p.state_S = (const float*)d_in[4]; p.state_conv = (const float*)d_in[5]; p.page_table = (const int*)d_in[6]; p.norm_mix = (const float*)d_in[7];
    p.w_in = (const float*)d_in[8]; p.cmp_pe = (const float*)d_in[9]; p.cmp_w = (const float*)d_in[10]; p.conv_w = (const float*)d_in[11];
    p.a_log = (const float*)d_in[12]; p.dt_bias = (const float*)d_in[13]; p.gdn_norm = (const float*)d_in[14]; p.w_out = (const float*)d_in[15];
    p.norm_ffn = (const float*)d_in[16]; p.w_gate_up = (const float*)d_in[17]; p.w_down = (const float*)d_in[18]; p.norm_final = (const float*)d_in[19];
    p.out = (float*)d_out; p.ws = (unsigned char*)d_ws;
    (void)hipMemsetAsync((char*)d_ws + WS_CTL, 0, WS_ZERO_BYTES, stream);
#if MK_MULTI
    hipLaunchKernelGGL(k_p0, dim3(grid), dim3(NTHREADS), 0, stream, p);
    hipLaunchKernelGGL(k_p1, dim3(grid), dim3(NTHREADS), LDS_BYTES, stream, p);
    hipLaunchKernelGGL(k_p2, dim3(grid), dim3(NTHREADS), LDS_BYTES, stream, p);
    hipLaunchKernelGGL(k_p3, dim3(grid), dim3(NTHREADS), LDS_BYTES, stream, p);
    hipLaunchKernelGGL(k_p4, dim3(grid), dim3(NTHREADS), 0, stream, p);
    hipLaunchKernelGGL(k_p5, dim3(grid), dim3(NTHREADS), LDS_BYTES, stream, p);
    hipLaunchKernelGGL(k_p6, dim3(grid), dim3(NTHREADS), LDS_BYTES, stream, p);
    hipLaunchKernelGGL(k_p7, dim3(grid), dim3(NTHREADS), LDS_BYTES, stream, p);
    hipLaunchKernelGGL(k_p8, dim3(grid), dim3(NTHREADS), 0, stream, p);
#else
    void* args[] = {&p};
    hipError_t e = hipLaunchCooperativeKernel((const void*)k_mega, dim3(grid), dim3(NTHREADS), args, LDS_BYTES, stream);
    if (e != hipSuccess) fprintf(stderr, "kernel_launch: cooperative launch failed: %s (grid %d)\n", hipGetErrorString(e), grid);
#endif
}
```

```cpp
#include <hip/hip_runtime.h>
#include <hip/hip_cooperative_groups.h>
#include <cstdio>
#include <cstdint>
namespace cg = cooperative_groups;
#ifndef MK_PROBE
#define MK_PROBE 0
#endif

#define DI __device__ __forceinline__
#define LAS __attribute__((address_space(3)))
typedef unsigned short bf16_t;
typedef short bf16x8 __attribute__((ext_vector_type(8)));
typedef short s16x4 __attribute__((ext_vector_type(4)));
typedef float f32x4 __attribute__((ext_vector_type(4)));
typedef float f32x2 __attribute__((ext_vector_type(2)));
typedef float f32x16 __attribute__((ext_vector_type(16)));
typedef unsigned u32x4 __attribute__((ext_vector_type(4)));
typedef unsigned u32x2 __attribute__((ext_vector_type(2)));
typedef __bf16 bf16x2_t __attribute__((ext_vector_type(2)));

constexpr int DM = 1024, TP = 8192, NBP = 2, MP = NBP * TP, NBS = 32, MROWS = 16640  ;
constexpr int HD = 64, NQH = 8, NG = 2, NREP = 4;
constexpr int NPAGES = 64, PAGE = 128, NPOOL = 2560;
constexpr int GH = 4, GDK = 128, GDV = 128, CCH = 1536, NCHUNK = 128;
constexpr int INW = 3360, INW_PAD = 3584, DFF = 2816;
constexpr int NCMP = 511;
constexpr float EPS = 1e-6f, LOG2E = 1.4426950408889634f, QSCALE = 0.125f * LOG2E, NEGBIG = -1e30f;

constexpr size_t O_YP = 0, O_YS = 16777216, O_KVP = 16809984, O_WINP = 25198592, O_SP = 25460736, O_CONVP = 25591808,
                 O_KVS = 25601024, O_WINS = 25617408, O_SS = 29811712, O_CONVS = 31908864, O_END = 32056320;

constexpr size_t MiB = 1u << 20;
constexpr size_t WS_CTL = 0;
constexpr size_t WS_SSQ1 = 1 * MiB, WS_SSQ2 = WS_SSQ1 + 128 * 1024;
constexpr size_t WS_ZERO_BYTES = 2 * MiB;
constexpr size_t WS_WIN = 2 * MiB;
constexpr size_t WS_WOUT = 10 * MiB;
constexpr size_t WS_WGU = 12 * MiB;
constexpr size_t WS_WDN = 24 * MiB;
constexpr size_t WS_WCMP = 30 * MiB;
constexpr size_t WS_CST = 31 * MiB;
constexpr size_t WS_ROPE = 32 * MiB;
constexpr size_t WS_XN = 36 * MiB;
constexpr size_t WS_QB = 70 * MiB;
constexpr size_t WS_KC = 88 * MiB, WS_VC = 93 * MiB;
constexpr size_t WS_KSEL = 98 * MiB, WS_VSELT = 103 * MiB;
constexpr size_t WS_KWIN = 108 * MiB, WS_VWINT = 113 * MiB;
constexpr size_t WS_CI = 118 * MiB;
constexpr size_t WS_Z = 168 * MiB;
constexpr size_t WS_GT = 186 * MiB;
constexpr size_t WS_CKP = 190 * MiB, WS_CVTP = 191 * MiB;
constexpr size_t WS_CKS = 192 * MiB, WS_CVS = 200 * MiB;
constexpr size_t WS_MIX = 208 * MiB;
constexpr size_t WS_HP = 242 * MiB;
constexpr size_t WS_HPB = 308 * MiB;
constexpr size_t WS_HID = 342 * MiB;
constexpr size_t WS_VSEL = 553 * MiB, WS_VWIN = 557 * MiB;
constexpr size_t WS_GW = 432 * MiB;
constexpr size_t WS_GQG = 448 * MiB;
constexpr size_t WS_GKGT = 464 * MiB;
constexpr size_t WS_GAQK = 480 * MiB;
constexpr size_t WS_GU = 488 * MiB;
constexpr size_t WS_GGL = 520 * MiB;
constexpr size_t WS_OG = 521 * MiB;
constexpr size_t WS_END = 562 * MiB;
constexpr int CW_Q3 = 64;

struct Params {
    const float *x_prompt, *x_sample, *cache_kv, *cache_win, *state_S, *state_conv;
    const int* page_table;
    const float *norm_mix, *w_in, *cmp_pe, *cmp_w, *conv_w, *a_log, *dt_bias, *gdn_norm, *w_out, *norm_ffn, *w_gate_up, *w_down, *norm_final;
    float* out;
    unsigned char* ws;
};

DI unsigned pk2(float lo, float hi) { f32x2 v = {lo, hi}; bf16x2_t b = __builtin_convertvector(v, bf16x2_t); return __builtin_bit_cast(unsigned, b); }
DI bf16_t f2bf(float f) { return (bf16_t)(pk2(f, 0.f) & 0xffffu); }
DI float bf2f(bf16_t h) { return __uint_as_float(((unsigned)h) << 16); }
DI float sigmoidf_(float x) { return 1.f / (1.f + __expf(-x)); }
DI float siluf_(float x) { return x / (1.f + __expf(-x)); }
DI float wave_sum(float v) {
#pragma unroll
    for (int o = 1; o < 64; o <<= 1) v += __shfl_xor(v, o);
    return v;
}
#define MFMA32(a, b, c) __builtin_amdgcn_mfma_f32_32x32x16_bf16((a), (b), (c), 0, 0, 0)
DI int crow(int r, int hi) { return (r & 3) + 8 * (r >> 2) + 4 * hi; }
#define LDS_FADD(ptr, v) (void)__hip_atomic_fetch_add((ptr), (v), __ATOMIC_RELAXED, __HIP_MEMORY_SCOPE_WORKGROUP)
#if MK_PROBE >= 2
__device__ unsigned long long g_acc[16];
#define TICK_INIT() unsigned long long tk_ = __builtin_amdgcn_s_memrealtime()
#define TICK(k) do { const unsigned long long now_ = __builtin_amdgcn_s_memrealtime(); if (blockIdx.x == 0 && threadIdx.x == 0) g_acc[k] += now_ - tk_; tk_ = now_; } while (0)
#else
#define TICK_INIT() do { } while (0)
#define TICK(k) do { } while (0)
#endif
#if MK_PROBE == 3
#define TICK3_INIT() unsigned long long tk3_ = __builtin_amdgcn_s_memrealtime()
#define TICK3(k) do { const unsigned long long now_ = __builtin_amdgcn_s_memrealtime(); if (blockIdx.x == 0 && threadIdx.x == 0) g_acc[k] += now_ - tk3_; tk3_ = now_; } while (0)
#else
#define TICK3_INIT() do { } while (0)
#define TICK3(k) do { } while (0)
#endif
namespace pg8 {
#define PG8_LAS __attribute__((address_space(3)))
typedef ::bf16_t bf16_t;
typedef ::bf16x8 bf16x8;
typedef ::f32x4 f32x4;
typedef ::u32x4 u32x4;
constexpr int BM = 256, BK = 64, HALF = 128, HTB = HALF * BK * 2  , STAGE_BYTES = 8 * HTB, NXCD = 8, WGM = 8;

__host__ __device__ __forceinline__ int lds_byte(int r, int c) { const int st = (r >> 4) * 2 + (c >> 5), rr = r & 15, cc = c & 31, ob = rr * 64 + cc * 2; return st * 1024 + (ob ^ (((ob >> 9) & 1) << 5)); }
__host__ __device__ __forceinline__ void stage_rc(int b, int& R, int& C) { const int st = b / 1024, sb = b % 1024, swz = sb ^ (((sb >> 9) & 1) << 5); R = (st >> 1) * 16 + swz / 64; C = (st & 1) * 32 + (swz % 64) / 2; }
__host__ __device__ __forceinline__ int perm32(int rho) { const int n = rho >> 4, i = rho & 15; return 8 * (i >> 2) + 4 * n + (i & 3); }

struct Unit { int pm, pn; };
struct Gemm { const bf16_t* A; const bf16_t* Bt; int M, N, K; };

struct StaticOrder {
    int nM, nN, nwg, G, c;
    __host__ __device__ void init(int M, int N, int G_, int c_) { nM = M / BM; nN = N / BM; nwg = nM * nN; G = G_; c = c_; }
    __host__ __device__ bool next(int i, Unit& u) const {
        const long L = (long)i * G + c; if (L >= nwg) return false;
        int wgid = (int)L; { const int q = nwg / NXCD, r = nwg % NXCD, xcd = wgid % NXCD, off = wgid / NXCD; wgid = (xcd < r ? xcd * (q + 1) : r * (q + 1) + (xcd - r) * q) + off; }
        const int nig = WGM * nN, gid = wgid / nig, fm = gid * WGM, gsz = (nM - fm) < WGM ? (nM - fm) : WGM;
        u.pm = fm + ((wgid % nig) % gsz); u.pn = (wgid % nig) / gsz; return true;
    }
    __device__ __forceinline__ void a_ready(const Unit&) const {}
    __device__ __forceinline__ void done(const Unit&) const {}
};


template <class Epi, class Sched, bool ALIGN_EPI = false, bool SP2 = false>
__device__ __forceinline__ void gemm_phase(PG8_LAS unsigned char* lds, const Gemm g, const Sched& S, const Epi& E) {
    int tid_ = threadIdx.x; asm volatile("" : "+v"(tid_)); const int tid = tid_, wid = __builtin_amdgcn_readfirstlane(tid >> 6), lane = tid & 63, wr = wid >> 2, wc = wid & 3, fr = lane & 15, fq = lane >> 4;
    const int K = g.K, nt = K / BK;
    unsigned voffA[2], voffB[2];
#pragma unroll
    for (int i = 0; i < 2; ++i) { int R, C; stage_rc(tid * 16 + i * 8192, R, C); const int Rb = Epi::PERM ? ((R & ~31) + perm32(R & 31)) : R;
        voffA[i] = (unsigned)(R * K + C) * 2u; voffB[i] = (unsigned)(Rb * K + C) * 2u; }
    const size_t kstep = (size_t)(BK * 2);
    const size_t hstep = (size_t)HALF * K * 2;
    const size_t tstep = 2 * hstep;
    const unsigned ldsw = (unsigned)wid * 1024u;
    const int aoff = lds_byte(wr * 64 + fr, fq * 8), boff = lds_byte(wc * 32 + fr, fq * 8);
#define PG8_SA(b, h) (((b) * 2 + (h)) * HTB)
#define PG8_SB(b, h) ((4 + (b) * 2 + (h)) * HTB)
#define PG8_STAGE(bufoff, gbase, voff) do { _Pragma("unroll") for (int _i = 0; _i < 2; ++_i) \
        __builtin_amdgcn_global_load_lds((const unsigned*)((const char*)(gbase) + (voff)[_i]), (PG8_LAS unsigned*)(lds + (bufoff) + ldsw + _i * 8192), 16, 0, 0); } while (0)
#define PG8_LDA(dst, b, h) do { _Pragma("unroll") for (int m = 0; m < 4; ++m) _Pragma("unroll") for (int k = 0; k < 2; ++k) dst[m][k] = *(const PG8_LAS bf16x8*)(lds + PG8_SA(b, h) + aoff + m * 2048 + k * 1024); } while (0)
#define PG8_LDB(dst, b, h) do { _Pragma("unroll") for (int n = 0; n < 2; ++n) _Pragma("unroll") for (int k = 0; k < 2; ++k) dst[n][k] = *(const PG8_LAS bf16x8*)(lds + PG8_SB(b, h) + boff + n * 2048 + k * 1024); } while (0)
#define PG8_MMA(ai, bj, At, Bt) do { __builtin_amdgcn_s_setprio(1); _Pragma("unroll") for (int m = 0; m < 4; ++m) _Pragma("unroll") for (int n = 0; n < 2; ++n) _Pragma("unroll") for (int k = 0; k < 2; ++k) \
        acc[ai][bj][m][n] = __builtin_amdgcn_mfma_f32_16x16x32_bf16(Bt[n][k], At[m][k], acc[ai][bj][m][n], 0, 0, 0); __builtin_amdgcn_s_setprio(0); } while (0)
#define PG8_WAIT_V(n) asm volatile("s_waitcnt vmcnt(" #n ")" ::: "memory")
#define PG8_WAIT_L(n) asm volatile("s_waitcnt lgkmcnt(" #n ")" ::: "memory")
#define PG8_BAR __builtin_amdgcn_s_barrier()
#define PG8_SCHED __builtin_amdgcn_sched_barrier(0)
    Unit cur, nxt; int ui = 0;
    if (!S.next(0, cur)) return;
    f32x4 acc[2][2][4][2];
#pragma unroll
    for (int a = 0; a < 2; ++a)
#pragma unroll
        for (int b = 0; b < 2; ++b)
#pragma unroll
            for (int m = 0; m < 4; ++m)
#pragma unroll
                for (int n = 0; n < 2; ++n) acc[a][b][m][n] = (f32x4){0.f, 0.f, 0.f, 0.f};
    bf16x8 At[4][2], B0[2][2], B1[2][2];
    const char* cA = (const char*)g.A + (size_t)cur.pm * tstep; const char* cB = (const char*)g.Bt + (size_t)cur.pn * tstep;
    S.a_ready(cur);
    if constexpr (SP2) {
        PG8_STAGE(PG8_SB(0, 0), cB, voffB); PG8_STAGE(PG8_SB(0, 1), cB + hstep, voffB); PG8_STAGE(PG8_SA(0, 0), cA, voffA); PG8_STAGE(PG8_SA(0, 1), cA + hstep, voffA);
        if (wr == 1) PG8_BAR;
        PG8_WAIT_V(2); PG8_BAR;
        PG8_STAGE(PG8_SB(1, 0), cB + kstep, voffB); PG8_STAGE(PG8_SA(1, 0), cA + kstep, voffA); PG8_STAGE(PG8_SB(1, 1), cB + hstep + kstep, voffB);
        PG8_WAIT_V(6); PG8_BAR;
    } else {
        PG8_STAGE(PG8_SB(0, 0), cB, voffB); PG8_STAGE(PG8_SA(0, 0), cA, voffA); PG8_STAGE(PG8_SB(0, 1), cB + hstep, voffB); PG8_STAGE(PG8_SA(0, 1), cA + hstep, voffA);
        if (wr == 1) PG8_BAR;
        PG8_WAIT_V(4); PG8_BAR;
        PG8_STAGE(PG8_SB(1, 0), cB + kstep, voffB); PG8_STAGE(PG8_SA(1, 0), cA + kstep, voffA); PG8_STAGE(PG8_SB(1, 1), cB + hstep + kstep, voffB);
        PG8_WAIT_V(6); PG8_BAR;
    }
    for (;;) {
        const bool has_next = S.next(ui + 1, nxt);
        const char* nA = has_next ? (const char*)g.A + (size_t)nxt.pm * tstep : cA; const char* nB = has_next ? (const char*)g.Bt + (size_t)nxt.pn * tstep : cB;
        for (int t = 0; t < nt; t += 2) {
            const bool last = (t == nt - 2);
            const char* a1 = cA + (size_t)(t + 1) * kstep;
            const char* a2 = last ? nA : cA + (size_t)(t + 2) * kstep; const char* b2 = last ? nB : cB + (size_t)(t + 2) * kstep;
            const char* a3 = a2 + kstep; const char* b3 = b2 + kstep;
            if (last && has_next) S.a_ready(nxt);
            if constexpr (SP2) {
            PG8_LDB(B0, 0, 0); PG8_LDB(B1, 0, 1); PG8_SCHED; PG8_LDA(At, 0, 0); PG8_STAGE(PG8_SA(1, 1), a1 + hstep, voffA);
            PG8_WAIT_V(8); PG8_WAIT_L(0); PG8_BAR; PG8_MMA(0, 0, At, B0); PG8_MMA(0, 1, At, B1); PG8_BAR; PG8_SCHED;
            PG8_LDA(At, 0, 1); PG8_STAGE(PG8_SB(0, 0), b2, voffB); PG8_STAGE(PG8_SB(0, 1), b2 + hstep, voffB); PG8_STAGE(PG8_SA(0, 0), a2, voffA);
            PG8_WAIT_V(8); PG8_WAIT_L(0); PG8_BAR; PG8_MMA(1, 0, At, B0); PG8_MMA(1, 1, At, B1); PG8_BAR; PG8_SCHED;
            PG8_LDB(B0, 1, 0); PG8_LDB(B1, 1, 1); PG8_SCHED; PG8_LDA(At, 1, 0); PG8_STAGE(PG8_SA(0, 1), a2 + hstep, voffA);
            PG8_WAIT_V(8); PG8_WAIT_L(0); PG8_BAR; PG8_MMA(0, 0, At, B0); PG8_MMA(0, 1, At, B1); PG8_BAR; PG8_SCHED;
            PG8_LDA(At, 1, 1); PG8_STAGE(PG8_SB(1, 0), b3, voffB); PG8_STAGE(PG8_SB(1, 1), b3 + hstep, voffB); PG8_STAGE(PG8_SA(1, 0), a3, voffA);
            PG8_WAIT_V(8); PG8_WAIT_L(0); PG8_BAR; PG8_MMA(1, 0, At, B0); PG8_MMA(1, 1, At, B1); PG8_BAR; PG8_SCHED;
            } else {
            PG8_LDB(B0, 0, 0); PG8_SCHED; PG8_LDA(At, 0, 0); PG8_STAGE(PG8_SA(1, 1), a1 + hstep, voffA);
            PG8_WAIT_L(8); PG8_BAR; PG8_WAIT_L(0); PG8_MMA(0, 0, At, B0); PG8_BAR; PG8_SCHED;
            PG8_LDB(B1, 0, 1); PG8_STAGE(PG8_SB(0, 0), b2, voffB);
            PG8_BAR; PG8_WAIT_L(0); PG8_MMA(0, 1, At, B1); PG8_BAR;
            PG8_LDA(At, 0, 1); PG8_STAGE(PG8_SA(0, 0), a2, voffA);
            PG8_BAR; PG8_WAIT_L(0); PG8_MMA(1, 0, At, B0); PG8_BAR; PG8_SCHED;
            PG8_STAGE(PG8_SB(0, 1), b2 + hstep, voffB);
            PG8_WAIT_V(6); PG8_BAR; PG8_MMA(1, 1, At, B1); PG8_BAR;
            PG8_LDB(B0, 1, 0); PG8_SCHED; PG8_LDA(At, 1, 0); PG8_STAGE(PG8_SA(0, 1), a2 + hstep, voffA);
            PG8_WAIT_L(8); PG8_BAR; PG8_WAIT_L(0); PG8_MMA(0, 0, At, B0); PG8_BAR; PG8_SCHED;
            PG8_LDB(B1, 1, 1); PG8_STAGE(PG8_SB(1, 0), b3, voffB);
            PG8_BAR; PG8_WAIT_L(0); PG8_MMA(0, 1, At, B1); PG8_BAR;
            PG8_LDA(At, 1, 1); PG8_STAGE(PG8_SA(1, 0), a3, voffA);
            PG8_BAR; PG8_WAIT_L(0); PG8_MMA(1, 0, At, B0); PG8_BAR; PG8_SCHED;
            PG8_STAGE(PG8_SB(1, 1), b3 + hstep, voffB);
            PG8_WAIT_V(6); PG8_BAR; PG8_MMA(1, 1, At, B1); PG8_BAR;
            }
        }
        if constexpr (ALIGN_EPI) { if (wr == 0) PG8_BAR; }
        if constexpr (!Epi::AFTER_DRAIN) { E(acc, cur, wr, wc, fr, fq); S.done(cur); }
        if (!has_next) break;
#pragma unroll
        for (int a = 0; a < 2; ++a)
#pragma unroll
            for (int b = 0; b < 2; ++b)
#pragma unroll
                for (int m = 0; m < 4; ++m)
#pragma unroll
                    for (int n = 0; n < 2; ++n) acc[a][b][m][n] = (f32x4){0.f, 0.f, 0.f, 0.f};
        cur = nxt; cA = nA; cB = nB; ++ui;
        if constexpr (ALIGN_EPI) { if (wr == 1) PG8_BAR; }
    }
    PG8_WAIT_V(0);
    if constexpr (!ALIGN_EPI) { if (wr == 0) PG8_BAR; }
    PG8_BAR;
    if constexpr (Epi::AFTER_DRAIN) { E.fused(acc, cur, wr, wc, fr, fq, lds, wid, lane); S.done(cur); }
#undef PG8_SA
#undef PG8_SB
#undef PG8_STAGE
#undef PG8_LDA
#undef PG8_LDB
#undef PG8_MMA
#undef PG8_WAIT_V
#undef PG8_WAIT_L
#undef PG8_BAR
#undef PG8_SCHED
}
}
namespace epi {
using pg8::Unit;
#define EPI_V8(ai, bj, m) const float v[8] = {acc[ai][bj][m][0][0], acc[ai][bj][m][0][1], acc[ai][bj][m][0][2], acc[ai][bj][m][0][3], acc[ai][bj][m][1][0], acc[ai][bj][m][1][1], acc[ai][bj][m][1][2], acc[ai][bj][m][1][3]}
DI void st_bf16x8(bf16_t* p, const float* v) { u32x4 w; w.x = pk2(v[0], v[1]); w.y = pk2(v[2], v[3]); w.z = pk2(v[4], v[5]); w.w = pk2(v[6], v[7]); *(u32x4*)p = w; }
DI void st_bf16x4(bf16_t* p, float a, float b, float c, float d) { u32x2 w; w.x = pk2(a, b); w.y = pk2(c, d); *(u32x2*)p = w; }
DI void st_f32x4(float* p, float a, float b, float c, float d) { *(f32x4*)p = (f32x4){a, b, c, d}; }

struct EpiProj {
    static constexpr bool PERM = true, AFTER_DRAIN = false;
    float* out; unsigned char* ws; const float* a_log; const float* dt_bias;
    DI void operator()(const f32x4 (&acc)[2][2][4][2], const Unit& u, int wr, int wc, int fr, int fq) const {
        const int pn = u.pn;
        const float* cosT = (const float*)(ws + WS_ROPE); const float* sinT = cosT + 8193 * 32;
#pragma unroll
        for (int ai = 0; ai < 2; ++ai)
#pragma unroll
            for (int m = 0; m < 4; ++m) {
                const int row = u.pm * 256 + ai * 128 + wr * 64 + m * 16 + fr;
                if (row >= MP + NBS) continue;
                const bool samp = row >= MP; const int b = row >> 13, t = row & (TP - 1), bs = row - MP;
                const int pos = samp ? TP : t;
#pragma unroll
                for (int bj = 0; bj < 2; ++bj) {
                    EPI_V8(ai, bj, m);
                    const int cw = bj * 128 + wc * 32 + fq * 8;
                    if (pn < 2) {
                        const int head = (pn * 256 + cw) >> 6, i0 = (cw & 63) >> 1;
                        const f32x4 c4 = *(const f32x4*)(cosT + pos * 32 + i0), s4 = *(const f32x4*)(sinT + pos * 32 + i0);
                        float o1[4], o2[4];
#pragma unroll
                        for (int q = 0; q < 4; ++q) { const float x1 = v[2 * q], x2 = v[2 * q + 1]; o1[q] = (x1 * c4[q] - x2 * s4[q]) * QSCALE; o2[q] = (x2 * c4[q] + x1 * s4[q]) * QSCALE; }
                        bf16_t* qb = (bf16_t*)(ws + WS_QB) + (size_t)row * 512 + head * 64 + i0;
                        st_bf16x4(qb, o1[0], o1[1], o1[2], o1[3]); st_bf16x4(qb + 32, o2[0], o2[1], o2[2], o2[3]);
                    } else if (pn < 5) {
                        const int br = pn - 2, g = wc >> 1, cc = (wc & 1) * 32 + fq * 8;
                        float* dst;
                        if (!samp) dst = (br < 2) ? out + O_KVP + ((size_t)(b * TP + t) * 4 + 2 * br + bj) * 128 + g * 64
                                                  : (t >= TP - 512 ? out + O_WINP + ((size_t)(b * 512 + t - (TP - 512)) * 2 + bj) * 128 + g * 64 : nullptr);
                        else dst = (br < 2) ? out + O_KVS + ((size_t)bs * 4 + 2 * br + bj) * 128 + g * 64 : out + O_WINS + ((size_t)(bs * 512 + 511) * 2 + bj) * 128 + g * 64;
                        const size_t hb = ((size_t)(b * 2 + g) * TP + t) * 64;
                        if (bj == 0) {
                            const int i0 = cc >> 1;
                            const f32x4 c4 = *(const f32x4*)(cosT + pos * 32 + i0), s4 = *(const f32x4*)(sinT + pos * 32 + i0);
                            float o1[4], o2[4];
#pragma unroll
                            for (int q = 0; q < 4; ++q) { const float x1 = v[2 * q], x2 = v[2 * q + 1]; o1[q] = x1 * c4[q] - x2 * s4[q]; o2[q] = x2 * c4[q] + x1 * s4[q]; }
                            if (dst) { st_f32x4(dst + i0, o1[0], o1[1], o1[2], o1[3]); st_f32x4(dst + 32 + i0, o2[0], o2[1], o2[2], o2[3]); }
                            if (!samp) { bf16_t* kb = (bf16_t*)(ws + (br == 0 ? WS_KC : br == 1 ? WS_KSEL : WS_KWIN)) + hb + i0;
                                st_bf16x4(kb, o1[0], o1[1], o1[2], o1[3]); st_bf16x4(kb + 32, o2[0], o2[1], o2[2], o2[3]); }
                        } else {
                            if (dst) { st_f32x4(dst + cc, v[0], v[1], v[2], v[3]); st_f32x4(dst + cc + 4, v[4], v[5], v[6], v[7]); }
                            if (!samp) {
                                st_bf16x8((bf16_t*)(ws + (br == 0 ? WS_VC : br == 1 ? WS_VSEL : WS_VWIN)) + hb + cc, v);
                            }
                        }
                    } else if (pn < 11) {
                        const int ch0 = (pn - 5) * 256 + cw;
                        st_bf16x8((bf16_t*)(ws + WS_CI) + (size_t)row * CCH + ch0, v);
                        float* dst = nullptr;
                        if (!samp) { if (t >= TP - 3) dst = out + O_CONVP + (size_t)(b * 3 + t - (TP - 3)) * CCH + ch0; }
                        else dst = out + O_CONVS + (size_t)(bs * 3 + 2) * CCH + ch0;
                        if (dst) { st_f32x4(dst, v[0], v[1], v[2], v[3]); st_f32x4(dst + 4, v[4], v[5], v[6], v[7]); }
                    } else if (pn < 13) {
                        st_bf16x8((bf16_t*)(ws + WS_Z) + (size_t)row * 512 + (pn - 11) * 256 + cw, v);
                    } else {
                        if (bj == 0 && wc == 0) {
                            float o[8];
                            if (fq < 3) {
#pragma unroll
                                for (int j = 0; j < 8; ++j) o[j] = sigmoidf_(v[j]);
                            } else {
#pragma unroll
                                for (int j = 0; j < 4; ++j) { const float xx = v[j] + dt_bias[j]; const float sp = fmaxf(xx, 0.f) + log1pf(__expf(-fabsf(xx))); o[j] = -__expf(a_log[j]) * sp; }
#pragma unroll
                                for (int j = 4; j < 8; ++j) o[j] = sigmoidf_(v[j]);
                            }
                            float* gt = (float*)(ws + WS_GT) + (size_t)row * 32 + fq * 8;
                            st_f32x4(gt, o[0], o[1], o[2], o[3]); st_f32x4(gt + 4, o[4], o[5], o[6], o[7]);
                        }
                    }
                }
            }
    }
};

struct EpiOut {
    static constexpr bool PERM = true, AFTER_DRAIN = false;
    const float* xp; const float* xs; unsigned char* ws;
    DI void operator()(const f32x4 (&acc)[2][2][4][2], const Unit& u, int wr, int wc, int fr, int fq) const {
        float* hp = (float*)(ws + WS_HP); bf16_t* hpb = (bf16_t*)(ws + WS_HPB); float* ssq = (float*)(ws + WS_SSQ1);
#pragma unroll
        for (int ai = 0; ai < 2; ++ai)
#pragma unroll
            for (int m = 0; m < 4; ++m) {
                const int row = u.pm * 256 + ai * 128 + wr * 64 + m * 16 + fr;
                const float* xr = row < MP ? xp + (size_t)row * DM : (row < MP + NBS ? xs + (size_t)(row - MP) * DM : nullptr);
                float sq = 0.f;
#pragma unroll
                for (int bj = 0; bj < 2; ++bj) {
                    EPI_V8(ai, bj, m);
                    const int col = u.pn * 256 + bj * 128 + wc * 32 + fq * 8;
                    float h[8];
                    if (xr) { const f32x4 x0 = *(const f32x4*)(xr + col), x1 = *(const f32x4*)(xr + col + 4);
#pragma unroll
                        for (int j = 0; j < 4; ++j) { h[j] = x0[j] + v[j]; h[4 + j] = x1[j] + v[4 + j]; } }
                    else {
#pragma unroll
                        for (int j = 0; j < 8; ++j) h[j] = 0.f; }
#pragma unroll
                    for (int j = 0; j < 8; ++j) sq += h[j] * h[j];
                    st_f32x4(hp + (size_t)row * DM + col, h[0], h[1], h[2], h[3]); st_f32x4(hp + (size_t)row * DM + col + 4, h[4], h[5], h[6], h[7]);
                    st_bf16x8(hpb + (size_t)row * DM + col, h);
                }
                sq += __shfl_xor(sq, 16); sq += __shfl_xor(sq, 32);
                if (fq == 0) atomicAdd(ssq + row, sq);
            }
    }
};

struct EpiUp {
    static constexpr bool PERM = true, AFTER_DRAIN = false;
    unsigned char* ws;
    DI void operator()(const f32x4 (&acc)[2][2][4][2], const Unit& u, int wr, int wc, int fr, int fq) const {
        const float* ssq = (const float*)(ws + WS_SSQ1); bf16_t* hid = (bf16_t*)(ws + WS_HID);
#pragma unroll
        for (int ai = 0; ai < 2; ++ai)
#pragma unroll
            for (int m = 0; m < 4; ++m) {
                const int row = u.pm * 256 + ai * 128 + wr * 64 + m * 16 + fr;
                const float rs = rsqrtf(ssq[row] * (1.f / DM) + EPS);
#pragma unroll
                for (int bj = 0; bj < 2; ++bj) {
                    EPI_V8(ai, bj, m);
                    const int j0 = (u.pn * 256 + bj * 128 + wc * 32 + fq * 8) >> 1;
                    float h[4];
#pragma unroll
                    for (int q = 0; q < 4; ++q) { const float gte = v[2 * q] * rs, up = v[2 * q + 1] * rs; h[q] = siluf_(gte) * up; }
                    st_bf16x4(hid + (size_t)row * DFF + j0, h[0], h[1], h[2], h[3]);
                }
            }
    }
};

struct EpiDown {
    static constexpr bool PERM = true, AFTER_DRAIN = false;
    unsigned char* ws;
    DI void operator()(const f32x4 (&acc)[2][2][4][2], const Unit& u, int wr, int wc, int fr, int fq) const {
        float* hp = (float*)(ws + WS_HP); float* ssq = (float*)(ws + WS_SSQ2);
#pragma unroll
        for (int ai = 0; ai < 2; ++ai)
#pragma unroll
            for (int m = 0; m < 4; ++m) {
                const int row = u.pm * 256 + ai * 128 + wr * 64 + m * 16 + fr;
                float sq = 0.f;
#pragma unroll
                for (int bj = 0; bj < 2; ++bj) {
                    EPI_V8(ai, bj, m);
                    float* hr = hp + (size_t)row * DM + u.pn * 256 + bj * 128 + wc * 32 + fq * 8;
                    const f32x4 x0 = *(const f32x4*)hr, x1 = *(const f32x4*)(hr + 4);
                    float h[8];
#pragma unroll
                    for (int j = 0; j < 4; ++j) { h[j] = x0[j] + v[j]; h[4 + j] = x1[j] + v[4 + j]; }
#pragma unroll
                    for (int j = 0; j < 8; ++j) sq += h[j] * h[j];
                    st_f32x4(hr, h[0], h[1], h[2], h[3]); st_f32x4(hr + 4, h[4], h[5], h[6], h[7]);
                }
                (void)sq; (void)ssq;
            }
    }
};
}
namespace p0 {
DI int perm_in(int n) {
    if (n < 512) { const int cc = n & 63; return (n & ~63) + ((cc & 1) ? (cc >> 1) + 32 : (cc >> 1)); }
    if (n < 1280) { const int m = n - 512, grp = m >> 6, cc = m & 63, br = grp >> 2, kvi = (grp >> 1) & 1, g = grp & 1;
        const int d = kvi == 0 ? ((cc & 1) ? (cc >> 1) + 32 : (cc >> 1)) : cc; return 512 + br * 256 + kvi * 128 + g * 64 + d; }
    if (n < 2816) return 1304 + (n - 1280);
    if (n < 3328) return 2840 + (n - 2816);
    if (n < 3352) return 1280 + (n - 3328);
    if (n < 3360) return n;
    return -1;
}
template <int MODE> DI void wt_item(const float* W, int Nsrc, bf16_t* WT, int Kdst, int n0, int k0, const float* kscale, int lane, LAS bf16_t* T) {
    const int n = n0 + lane;
    int src;
    if (MODE == 0) src = perm_in(n);
    else if (MODE == 1) src = n;
    else src = (n & 1) ? DFF + (n >> 1) : (n >> 1);
#pragma unroll
    for (int kk = 0; kk < 64; kk += 8) {
        float v[8];
#pragma unroll
        for (int i = 0; i < 8; ++i) { const int k = k0 + kk + i; float x = src >= 0 ? W[(size_t)k * Nsrc + src] : 0.f; if (kscale) x *= kscale[k]; v[i] = x; }
        u32x4 w; w.x = pk2(v[0], v[1]); w.y = pk2(v[2], v[3]); w.z = pk2(v[4], v[5]); w.w = pk2(v[6], v[7]);
        *(LAS u32x4*)(T + lane * 72 + kk) = w;
    }
    asm volatile("s_waitcnt lgkmcnt(0)" ::: "memory");
#pragma unroll
    for (int q = 0; q < 8; ++q) { const int row = q * 8 + (lane >> 3), ch = lane & 7;
        *(u32x4*)(WT + (size_t)(n0 + row) * Kdst + k0 + ch * 8) = *(const LAS u32x4*)(T + row * 72 + ch * 8); }
    asm volatile("s_waitcnt lgkmcnt(0)" ::: "memory");
}
DI void run(const Params& p, LAS unsigned char* lds) {
    int tid_ = threadIdx.x; asm volatile("" : "+v"(tid_)); const int tid = tid_, lane = tid & 63, wave = tid >> 6;
    const int gw = blockIdx.x * 8 + wave, NGW = gridDim.x * 8;
    const int gt = blockIdx.x * 512 + tid, NGT = gridDim.x * 512;
    unsigned char* ws = p.ws;
    LAS bf16_t* T = (LAS bf16_t*)(lds + wave * (64 * 72 * 2));
    TICK3_INIT();
    constexpr int I_IN = (INW_PAD / 64) * (DM / 64), I_OUT = (DM / 64) * (DM / 64), I_GU = (2 * DFF / 64) * (DM / 64), I_DN = (DM / 64) * (DFF / 64);
    constexpr int NIT = I_IN + I_OUT + I_GU + I_DN;
    for (int it = gw; it < NIT; it += NGW) {
        int r = it;
        if (r < I_IN) { wt_item<0>(p.w_in, INW, (bf16_t*)(ws + WS_WIN), DM, (r / 16) * 64, (r % 16) * 64, nullptr, lane, T); continue; } r -= I_IN;
        if (r < I_OUT) { wt_item<1>(p.w_out, DM, (bf16_t*)(ws + WS_WOUT), DM, (r / 16) * 64, (r % 16) * 64, nullptr, lane, T); continue; } r -= I_OUT;
        if (r < I_GU) { wt_item<2>(p.w_gate_up, 2 * DFF, (bf16_t*)(ws + WS_WGU), DM, (r / 16) * 64, (r % 16) * 64, p.norm_ffn, lane, T); continue; } r -= I_GU;
        wt_item<1>(p.w_down, DM, (bf16_t*)(ws + WS_WDN), DFF, (r / 44) * 64, (r % 44) * 64, nullptr, lane, T);
    }
    TICK3(8);
    for (int i = gt; i < 2 * 128 * 2 * 64; i += NGT) {
        const int ln = i & 63, et = (i >> 6) & 1, ks = (i >> 7) & 127, kv = i >> 14;
        const float* w = p.cmp_w + ((size_t)kv * 2048 + ks * 16 + (ln >> 5) * 8) * 64 + et * 32 + (ln & 31);
        float v[8];
#pragma unroll
        for (int j = 0; j < 8; ++j) v[j] = w[j * 64];
        epi::st_bf16x8((bf16_t*)(ws + WS_WCMP) + (size_t)i * 8, v);
    }
    for (int o = gw; o < 128; o += NGW) {
        const int kv = o >> 6, e = o & 63; float s = 0.f;
        for (int k = lane; k < 2048; k += 64) s += p.cmp_pe[kv * 2048 + k] * p.cmp_w[((size_t)kv * 2048 + k) * 64 + e];
        s = wave_sum(s);
        if (lane == 0) ((float*)(ws + WS_CST))[o] = s;
    }
    { float* cosT = (float*)(ws + WS_ROPE); float* sinT = cosT + 8193 * 32;
      const double inv = exp2(-(double)(gt & 31) * (13.287712379549449 / 32.0));
      for (int i = gt; i < 8193 * 32; i += NGT) { const double a = (double)(i >> 5) * inv; const double k = rint(a * 0.15915494309189535);
          const double r = fma(-k, 1.2246467991473532e-16 * 2.0, fma(-k, 6.283185307179586, a)); float sn, cs; sincosf((float)r, &sn, &cs); cosT[i] = cs; sinT[i] = sn; } }
    TICK3(9);
    { f32x4 gm[4];
#pragma unroll
      for (int j = 0; j < 4; ++j) gm[j] = *(const f32x4*)(p.norm_mix + (j * 64 + lane) * 4);
      for (int row0 = gw; row0 < MROWS; row0 += 2 * NGW) {
#pragma unroll
        for (int rr = 0; rr < 2; ++rr) { const int row = row0 + rr * NGW; if (row >= MP + NBS && row < MROWS) { bf16_t* o = (bf16_t*)(ws + WS_XN) + (size_t)row * DM; for (int j = 0; j < 4; ++j) *(u32x2*)(o + (j * 64 + lane) * 4) = (u32x2){0u, 0u}; } }
        const int rowa = row0, rowb = row0 + NGW; const bool va = rowa < MP + NBS, vb = rowb < MP + NBS;
        const float* xa = rowa < MP ? p.x_prompt + (size_t)rowa * DM : p.x_sample + (size_t)((va ? rowa : MP) - MP) * DM;
        const float* xb = rowb < MP ? p.x_prompt + (size_t)rowb * DM : p.x_sample + (size_t)((vb ? rowb : MP) - MP) * DM;
        f32x4 a[4], b[4]; float sa = 0.f, sb = 0.f;
#pragma unroll
        for (int j = 0; j < 4; ++j) { a[j] = __builtin_nontemporal_load((const f32x4*)(xa + (j * 64 + lane) * 4)); b[j] = __builtin_nontemporal_load((const f32x4*)(xb + (j * 64 + lane) * 4)); }
#pragma unroll
        for (int j = 0; j < 4; ++j) { sa += a[j][0] * a[j][0] + a[j][1] * a[j][1] + a[j][2] * a[j][2] + a[j][3] * a[j][3]; sb += b[j][0] * b[j][0] + b[j][1] * b[j][1] + b[j][2] * b[j][2] + b[j][3] * b[j][3]; }
        const float ra = rsqrtf(wave_sum(sa) * (1.f / DM) + EPS), rb = rsqrtf(wave_sum(sb) * (1.f / DM) + EPS);
        if (va) { bf16_t* o = (bf16_t*)(ws + WS_XN) + (size_t)rowa * DM;
#pragma unroll
            for (int j = 0; j < 4; ++j) epi::st_bf16x4(o + (j * 64 + lane) * 4, a[j][0] * ra * gm[j][0], a[j][1] * ra * gm[j][1], a[j][2] * ra * gm[j][2], a[j][3] * ra * gm[j][3]); }
        if (vb) { bf16_t* o = (bf16_t*)(ws + WS_XN) + (size_t)rowb * DM;
#pragma unroll
            for (int j = 0; j < 4; ++j) epi::st_bf16x4(o + (j * 64 + lane) * 4, b[j][0] * rb * gm[j][0], b[j][1] * rb * gm[j][1], b[j][2] * rb * gm[j][2], b[j][3] * rb * gm[j][3]); }
      } }
    TICK3(10);
    { const f32x4* src = (const f32x4*)p.cache_win; f32x4* dst = (f32x4*)(p.out + O_WINS);
#pragma unroll 4
      for (int i = gt; i < NBS * 511 * 64; i += NGT) { const int bs = i / (511 * 64), r = i % (511 * 64); dst[(size_t)bs * 512 * 64 + r] = src[(size_t)bs * 512 * 64 + 64 + r]; } }
    { const f32x4* src = (const f32x4*)p.state_conv; f32x4* dst = (f32x4*)(p.out + O_CONVS);
      for (int i = gt; i < NBS * 2 * (CCH / 4); i += NGT) { const int bs = i / (2 * (CCH / 4)), r = i % (2 * (CCH / 4)); dst[(size_t)bs * 3 * (CCH / 4) + r] = src[(size_t)bs * 3 * (CCH / 4) + (CCH / 4) + r]; } }
    TICK3(11);
}
}
namespace attn {
constexpr int KSTR = 72, VSTR = 68;
constexpr int KT_BYTES = 64 * KSTR * 2, VT_BYTES = 64 * VSTR * 2, TILE_BYTES = KT_BYTES + VT_BYTES;
constexpr int OFF_IMP = 4 * TILE_BYTES, IMP_STR = 132;
constexpr int OFF_C2S = OFF_IMP + 8 * 8 * IMP_STR * 4;
constexpr int LDS_NEED = OFF_C2S + 3 * 4 * 64 * 16;

DI void ld_tile(const bf16_t* kbase, const bf16_t* vtbase, size_t vts, u32x4& kr, u32x4& vr, int tid) {
    kr = *(const u32x4*)(kbase + (tid >> 3) * 64 + (tid & 7) * 8);
    vr = *(const u32x4*)(vtbase + (size_t)(tid >> 3) * vts + (tid & 7) * 8);
}
DI void st_tile(LAS unsigned char* buf, const u32x4& kr, const u32x4& vr, int tid) {
    *(LAS u32x4*)(buf + ((tid >> 3) * KSTR + (tid & 7) * 8) * 2) = kr;
    LAS u32x2* vp = (LAS u32x2*)(buf + KT_BYTES + ((tid >> 3) * VSTR + (tid & 7) * 8) * 2);
    vp[0] = (u32x2){vr.x, vr.y}; vp[1] = (u32x2){vr.z, vr.w};
}
DI void qk_tile(const LAS unsigned char* kb, const bf16x8 (&qf)[4], f32x16& s0, f32x16& s1, int lane) {
    const LAS unsigned char* p0 = kb + ((lane & 31) * KSTR + (lane >> 5) * 8) * 2;
    f32x16 z; for (int i = 0; i < 16; ++i) z[i] = 0.f;
    s0 = z; s1 = z;
#pragma unroll
    for (int kd = 0; kd < 4; ++kd) {
        const bf16x8 a0 = *(const LAS bf16x8*)(p0 + kd * 32), a1 = *(const LAS bf16x8*)(p0 + 32 * KSTR * 2 + kd * 32);
        s0 = MFMA32(a0, qf[kd], s0); s1 = MFMA32(a1, qf[kd], s1);
    }
}
DI bf16x8 pack8(const f32x16& p, int base) {
    u32x4 w; w.x = pk2(p[base], p[base + 1]); w.y = pk2(p[base + 2], p[base + 3]); w.z = pk2(p[base + 4], p[base + 5]); w.w = pk2(p[base + 6], p[base + 7]);
    return __builtin_bit_cast(bf16x8, w);
}
DI void pv_tile(const LAS unsigned char* vb, const f32x16& p0, const f32x16& p1, f32x16& o0, f32x16& o1, int lane) {
    const LAS unsigned char* v0 = vb + ((lane & 31) * VSTR + 4 * (lane >> 5)) * 2;
#pragma unroll
    for (int ks = 0; ks < 4; ++ks) {
        const bf16x8 pb = (ks < 2) ? pack8(p0, (ks & 1) * 8) : pack8(p1, (ks & 1) * 8);
#pragma unroll
        for (int dt = 0; dt < 2; ++dt) {
            const s16x4 lo = *(const LAS s16x4*)(v0 + (dt * 32 * VSTR + 16 * ks) * 2), hi = *(const LAS s16x4*)(v0 + (dt * 32 * VSTR + 16 * ks + 8) * 2);
            const bf16x8 a = __builtin_shufflevector(lo, hi, 0, 1, 2, 3, 4, 5, 6, 7);
            if (dt == 0) o0 = MFMA32(a, pb, o0); else o1 = MFMA32(a, pb, o1);
        }
    }
}
DI void pv_tile_pb(const LAS unsigned char* vb, const bf16x8 (&pb)[4], f32x16& o0, f32x16& o1, int lane) {
    const LAS unsigned char* v0 = vb + ((lane & 31) * VSTR + 4 * (lane >> 5)) * 2;
#pragma unroll
    for (int ks = 0; ks < 4; ++ks) {
#pragma unroll
        for (int dt = 0; dt < 2; ++dt) {
            const s16x4 lo = *(const LAS s16x4*)(v0 + (dt * 32 * VSTR + 16 * ks) * 2), hi = *(const LAS s16x4*)(v0 + (dt * 32 * VSTR + 16 * ks + 8) * 2);
            const bf16x8 a = __builtin_shufflevector(lo, hi, 0, 1, 2, 3, 4, 5, 6, 7);
            if (dt == 0) o0 = MFMA32(a, pb[ks], o0); else o1 = MFMA32(a, pb[ks], o1);
        }
    }
}
DI void softmax_step(f32x16& s0, f32x16& s1, float& m, float& l, f32x16& o0, f32x16& o1) {
    float mt = NEGBIG;
#pragma unroll
    for (int r = 0; r < 16; ++r) mt = fmaxf(mt, fmaxf(s0[r], s1[r]));
    mt = fmaxf(mt, __shfl_xor(mt, 32));
    const float mn = fmaxf(m, mt), alpha = __builtin_amdgcn_exp2f(m - mn);
    float sum = 0.f;
#pragma unroll
    for (int r = 0; r < 16; ++r) { s0[r] = __builtin_amdgcn_exp2f(s0[r] - mn); s1[r] = __builtin_amdgcn_exp2f(s1[r] - mn); sum += s0[r] + s1[r]; }
    l = l * alpha + sum; m = mn;
#pragma unroll
    for (int r = 0; r < 16; ++r) { o0[r] *= alpha; o1[r] *= alpha; }
}

DI float max3f(float a, float b, float c) { float r; asm("v_max3_f32 %0, %1, %2, %3" : "=v"(r) : "v"(a), "v"(b), "v"(c)); return r; }
template <bool ROWMASK> DI void softmax_step2(f32x16& s0, f32x16& s1, float& m, float& l, f32x16& o0, f32x16& o1, bool on) {
    float ma = max3f(s0[0], s0[1], s1[0]), mb = max3f(s0[2], s0[3], s1[1]);
    ma = max3f(ma, s1[2], s1[3]);
#pragma unroll
    for (int r = 4; r < 16; r += 4) { ma = max3f(ma, s0[r], s0[r + 1]); mb = max3f(mb, s0[r + 2], s0[r + 3]); ma = max3f(ma, s1[r], s1[r + 1]); mb = max3f(mb, s1[r + 2], s1[r + 3]); }
    float mt = max3f(ma, mb, ma);
    if (ROWMASK) mt = on ? mt : NEGBIG;
    mt = max3f(mt, __shfl_xor(mt, 32), mt);
    if (__any(mt > m)) {
        const float mn = max3f(m, mt, mt), alpha = __builtin_amdgcn_exp2f(m - mn);
        l *= alpha; m = mn;
        o0 = o0 * alpha; o1 = o1 * alpha;
    }
    const float mu = ROWMASK ? (on ? m : 1e30f) : m;
    s0 = s0 - mu; s1 = s1 - mu;
#pragma unroll
    for (int r = 0; r < 16; ++r) { s0[r] = __builtin_amdgcn_exp2f(s0[r]); s1[r] = __builtin_amdgcn_exp2f(s1[r]); }
    const f32x16 sv = s0 + s1;
    l += ((sv[0] + sv[1]) + (sv[2] + sv[3])) + ((sv[4] + sv[5]) + (sv[6] + sv[7])) + (((sv[8] + sv[9]) + (sv[10] + sv[11])) + ((sv[12] + sv[13]) + (sv[14] + sv[15])));
}

#define ATT_TBUF(i) (lds + (i) * TILE_BYTES)
#define ATT_STREAM_BEGIN(NT, KP, VP, VTS) { u32x4 kr_, vr_; const int nt_ = (NT); \
    { const int i_ = 0; ld_tile((KP), (VP), (VTS), kr_, vr_, tid); } st_tile(ATT_TBUF(0), kr_, vr_, tid); __syncthreads(); \
    for (int it_ = 0; it_ < nt_; ++it_) { \
        if (it_ + 1 < nt_) { const int i_ = it_ + 1; ld_tile((KP), (VP), (VTS), kr_, vr_, tid); } \
        { const LAS unsigned char* tb = ATT_TBUF(it_ & 1); const int i_ = it_;
#define ATT_STREAM_END() } \
        if (it_ + 1 < nt_) st_tile(ATT_TBUF((it_ + 1) & 1), kr_, vr_, tid); \
        __syncthreads(); } }

#define ATT_PBUF(i) (lds + (i) * 2 * TILE_BYTES)
#define ATT_PAIR_BEGIN(NP, KP, VP, VTS) { u32x4 ka_, va_, kb_, vb_; const int np_ = (NP); \
    { const int i_ = 0; ld_tile((KP), (VP), (VTS), ka_, va_, tid); } { const int i_ = 1; ld_tile((KP), (VP), (VTS), kb_, vb_, tid); } \
    st_tile(ATT_PBUF(0), ka_, va_, tid); st_tile(ATT_PBUF(0) + TILE_BYTES, kb_, vb_, tid); __syncthreads(); \
    for (int ip_ = 0; ip_ < np_; ++ip_) { \
        if (ip_ + 1 < np_) { { const int i_ = 2 * ip_ + 2; ld_tile((KP), (VP), (VTS), ka_, va_, tid); } { const int i_ = 2 * ip_ + 3; ld_tile((KP), (VP), (VTS), kb_, vb_, tid); } } \
        { const LAS unsigned char* tba = ATT_PBUF(ip_ & 1); const LAS unsigned char* tbb = tba + TILE_BYTES; const int ia_ = 2 * ip_, ib_ = 2 * ip_ + 1;
#define ATT_PAIR_END() } \
        if (ip_ + 1 < np_) { st_tile(ATT_PBUF((ip_ + 1) & 1), ka_, va_, tid); st_tile(ATT_PBUF((ip_ + 1) & 1) + TILE_BYTES, kb_, vb_, tid); } \
        __syncthreads(); } }

DI void unit(const Params& p, LAS unsigned char* lds, int b, int g, int tt) {
    TICK_INIT();
    int tid_ = threadIdx.x; asm volatile("" : "+v"(tid_)); const int tid = tid_, lane = tid & 63, wave = __builtin_amdgcn_readfirstlane(tid >> 6), hi = lane >> 5, col = lane & 31, tokl = col & 7, r = col >> 3;
    const int t = tt * 64 + wave * 8 + tokl;
    const size_t row = (size_t)b * TP + t;
    const unsigned char* ws = p.ws;
    const size_t slab = (size_t)(b * 2 + g);
    bf16x8 qf[4];
    { const bf16_t* q = (const bf16_t*)(ws + WS_QB) + row * 512 + (g * 4 + r) * 64 + hi * 8;
#pragma unroll
      for (int kd = 0; kd < 4; ++kd) qf[kd] = *(const bf16x8*)(q + kd * 16); }
    const float* gt = (const float*)(ws + WS_GT) + row * 32 + (g * 4 + r) * 3;
    const float gate0 = gt[0], gate1 = gt[1], gate2 = gt[2];
    LAS float* imp = (LAS float*)(lds + OFF_IMP) + wave * 8 * IMP_STR;
    for (int e = tid; e < 768; e += 512) { const int var = e >> 8, ks = (e >> 6) & 3, ln = e & 63, sl = ln & 31, hh = ln >> 5; unsigned w[4];
#pragma unroll
        for (int j2 = 0; j2 < 4; ++j2) { unsigned pk = 0u;
#pragma unroll
            for (int q = 0; q < 2; ++q) { const int j = 2 * j2 + q, nl = 16 * ks + 8 * (j >> 2) + 4 * hh + (j & 3);
                const int c = var == 0 ? nl - 4 * sl : var == 1 ? nl + 64 - 4 * sl : nl - 64 - 4 * sl;
                if (c >= -1 && c <= 3) pk |= 0x3F80u << (16 * q); }
            w[j2] = pk; }
        *(LAS u32x4*)(lds + OFF_C2S + e * 16) = (u32x4){w[0], w[1], w[2], w[3]}; }
    f32x16 of0, of1; for (int i = 0; i < 16; ++i) { of0[i] = 0.f; of1[i] = 0.f; }

    TICK(0);
    const int nv = t >= 31 ? ((t - 31) >> 4) + 1 : 0;
    {
        const int ntile = (4 * tt + 3 + 63) >> 6;
        const bf16_t* ck = (const bf16_t*)(ws + WS_CKP) + slab * 512 * 64;
        const bf16_t* cvt = (const bf16_t*)(ws + WS_CVTP) + slab * 64 * 512;
        float m = NEGBIG, l = 0.f;
        ATT_STREAM_BEGIN(ntile, ck + (size_t)i_ * 64 * 64, cvt + i_ * 64, 512)
            f32x16 s0, s1; qk_tile(tb, qf, s0, s1, lane);
            float mt = NEGBIG;
#pragma unroll
            for (int rr = 0; rr < 16; ++rr) { const int n0 = i_ * 64 + crow(rr, hi); s0[rr] = n0 < nv ? s0[rr] : NEGBIG; s1[rr] = n0 + 32 < nv ? s1[rr] : NEGBIG; mt = fmaxf(mt, fmaxf(s0[rr], s1[rr])); }
            const float mn = fmaxf(m, mt); float sum = 0.f;
#pragma unroll
            for (int rr = 0; rr < 16; ++rr) sum += __builtin_amdgcn_exp2f(s0[rr] - mn) + __builtin_amdgcn_exp2f(s1[rr] - mn);
            l = l * __builtin_amdgcn_exp2f(m - mn) + sum; m = mn;
        ATT_STREAM_END()
        TICK(1);
        const float mo = __shfl_xor(m, 32), lo = __shfl_xor(l, 32);
        const float M = fmaxf(m, mo), L = l * __builtin_amdgcn_exp2f(m - M) + lo * __builtin_amdgcn_exp2f(mo - M);
        const float invL = M > -1e29f ? 1.f / L : 0.f;
        f32x16 o0, o1; for (int i = 0; i < 16; ++i) { o0[i] = 0.f; o1[i] = 0.f; }
        f32x16 dimp[4]; for (int k = 0; k < 4; ++k) for (int i = 0; i < 16; ++i) dimp[k][i] = 0.f;
        ATT_STREAM_BEGIN(ntile, ck + (size_t)i_ * 64 * 64, cvt + i_ * 64, 512)
            f32x16 s0, s1; qk_tile(tb, qf, s0, s1, lane);
#pragma unroll
            for (int rr = 0; rr < 16; ++rr) { const int n0 = i_ * 64 + crow(rr, hi);
                s0[rr] = n0 < nv ? __builtin_amdgcn_exp2f(s0[rr] - M) * invL : 0.f; s1[rr] = n0 + 32 < nv ? __builtin_amdgcn_exp2f(s1[rr] - M) * invL : 0.f; }
            bf16x8 pb[4] = {pack8(s0, 0), pack8(s0, 8), pack8(s1, 0), pack8(s1, 8)};
            pv_tile_pb(tb + KT_BYTES, pb, o0, o1, lane);
            { const LAS unsigned char* ct = lds + OFF_C2S + lane * 16;
#define C2S_ACC(ST, VAR) do { _Pragma("unroll") for (int ks = 0; ks < 4; ++ks) dimp[ST] = MFMA32(*(const LAS bf16x8*)(ct + ((VAR) * 4 + ks) * 1024), pb[ks], dimp[ST]); } while (0)
              switch (i_) {
                case 0: C2S_ACC(0, 0); break;
                case 1: C2S_ACC(0, 1); C2S_ACC(1, 2); break;
                case 2: C2S_ACC(1, 0); break;
                case 3: C2S_ACC(1, 1); C2S_ACC(2, 2); break;
                case 4: C2S_ACC(2, 0); break;
                case 5: C2S_ACC(2, 1); C2S_ACC(3, 2); break;
                case 6: C2S_ACC(3, 0); break;
                default: C2S_ACC(3, 1); break;
              } }
        ATT_STREAM_END()
        TICK(2);
#pragma unroll
        for (int i = 0; i < 16; ++i) { of0[i] = gate0 * o0[i]; of1[i] = gate0 * o1[i]; }
#pragma unroll
        for (int st = 0; st < 4; ++st)
            if (st * 32 <= tt) {
#pragma unroll
                for (int rr = 0; rr < 16; ++rr) { float v = dimp[st][rr]; v += __shfl_xor(v, 8); v += __shfl_xor(v, 16);
                    if (r == 0) imp[tokl * IMP_STR + st * 32 + crow(rr, hi)] = v; } }
    }
    TICK(3);
    unsigned long long sel_lo = 0ull, sel_hi = 0ull;
    {
        const unsigned long long lt = (1ull << lane) - 1ull;
#pragma unroll 1
        for (int j = 0; j < 8; ++j) {
            const float i0 = imp[j * IMP_STR + lane], i1 = imp[j * IMP_STR + 64 + lane];
            const int sA = lane, sB = lane + 64;
            const bool vA = sA <= tt, vB = sB <= tt;
            const bool fA = sA == 0 || sA == tt || sA == tt - 1, fB = sB == tt || sB == tt - 1;
            const int xA = vA ? __float_as_int(i0 + (fA ? 1e4f : 0.f)) : -1, xB = vB ? __float_as_int(i1 + (fB ? 1e4f : 0.f)) : -1;
            int T = 0;
#pragma unroll 1
            for (int bit = 30; bit >= 0; --bit) { const int T2 = T | (1 << bit);
                const int c = __popcll(__ballot(xA >= T2)) + __popcll(__ballot(xB >= T2)); T = __builtin_amdgcn_readfirstlane(c >= 16 ? T2 : T); }
            const bool gA = xA > T, gB = xB > T, eA = xA == T, eB = xB == T;
            const int need = 16 - (__popcll(__ballot(gA)) + __popcll(__ballot(gB)));
            const unsigned long long beA = __ballot(eA), beB = __ballot(eB);
            const int preA = __popcll(beA & lt), preB = __popcll(beA) + __popcll(beB & lt);
            const unsigned long long mA = __ballot(gA || (eA && preA < need)), mB = __ballot(gB || (eB && preB < need));
            if (tokl == j) { sel_lo = mA; sel_hi = mB; }
        }
    }
    TICK(4);
    {
        const bf16_t* kb = (const bf16_t*)(ws + WS_KSEL) + slab * TP * 64;
        const bf16_t* vt = (const bf16_t*)(ws + WS_VSELT) + slab * 64 * TP;
        float m = NEGBIG, l = 0.f; f32x16 o0, o1; for (int i = 0; i < 16; ++i) { o0[i] = 0.f; o1[i] = 0.f; }
#define SELBLK(j) ((j) == 0 ? tt : ((j) <= tt ? (j) - 1 : 0))
        ATT_PAIR_BEGIN((tt + 2) >> 1, kb + (size_t)SELBLK(i_) * 64 * 64, vt + (size_t)SELBLK(i_) * 64, TP)
            const int sA = SELBLK(ia_), sB = SELBLK(ib_);
            const bool onA = ((sA < 64 ? (sel_lo >> sA) : (sel_hi >> (sA - 64))) & 1ull) != 0ull;
            const bool onB = ib_ <= tt && ((sB < 64 ? (sel_lo >> sB) : (sel_hi >> (sB - 64))) & 1ull) != 0ull;
            if (__any(onA)) {
                f32x16 a0, a1; qk_tile(tba, qf, a0, a1, lane);
                if (ia_ == 0) {
                    const int lim = t - tt * 64;
#pragma unroll
                    for (int rr = 0; rr < 16; ++rr) { const int kk = crow(rr, hi); a0[rr] = kk <= lim ? a0[rr] : NEGBIG; a1[rr] = kk + 32 <= lim ? a1[rr] : NEGBIG; }
                }
                softmax_step2<true>(a0, a1, m, l, o0, o1, onA);
                pv_tile(tba + KT_BYTES, a0, a1, o0, o1, lane);
            }
            if (__any(onB)) {
                f32x16 b0, b1; qk_tile(tbb, qf, b0, b1, lane);
                softmax_step2<true>(b0, b1, m, l, o0, o1, onB);
                pv_tile(tbb + KT_BYTES, b0, b1, o0, o1, lane);
            }
        ATT_PAIR_END()
        const float sc = gate1 / (l + __shfl_xor(l, 32));
#pragma unroll
        for (int i = 0; i < 16; ++i) { of0[i] += sc * o0[i]; of1[i] += sc * o1[i]; }
    }
    TICK(5);
    {
        const bf16_t* kb = (const bf16_t*)(ws + WS_KWIN) + slab * TP * 64;
        const bf16_t* vt = (const bf16_t*)(ws + WS_VWINT) + slab * 64 * TP;
        const int ntile = (tt < 8 ? tt : 8) + 1;
        float m = NEGBIG, l = 0.f; f32x16 o0, o1; for (int i = 0; i < 16; ++i) { o0[i] = 0.f; o1[i] = 0.f; }
#define WINTILE(j) ((j) < ntile ? tt - (j) : tt)
        ATT_PAIR_BEGIN((ntile + 1) >> 1, kb + (size_t)WINTILE(i_) * 64 * 64, vt + (size_t)WINTILE(i_) * 64, TP)
            f32x16 a0, a1, b0, b1; qk_tile(tba, qf, a0, a1, lane); qk_tile(tbb, qf, b0, b1, lane);
            if (ia_ == 0 || ia_ == 8) {
                const int k0 = (tt - ia_) * 64;
#pragma unroll
                for (int rr = 0; rr < 16; ++rr) { const int kp = k0 + crow(rr, hi);
                    a0[rr] = (kp <= t && kp >= t - 512) ? a0[rr] : NEGBIG; a1[rr] = (kp + 32 <= t && kp + 32 >= t - 512) ? a1[rr] : NEGBIG; }
            }
            softmax_step2<false>(a0, a1, m, l, o0, o1, true);
            pv_tile(tba + KT_BYTES, a0, a1, o0, o1, lane);
            softmax_step2<true>(b0, b1, m, l, o0, o1, ib_ < ntile);
            pv_tile(tbb + KT_BYTES, b0, b1, o0, o1, lane);
        ATT_PAIR_END()
        const float sc = gate2 / (l + __shfl_xor(l, 32));
#pragma unroll
        for (int i = 0; i < 16; ++i) { of0[i] += sc * o0[i]; of1[i] += sc * o1[i]; }
    }
    TICK(6);
    { bf16_t* o = (bf16_t*)(p.ws + WS_MIX) + row * DM + (g * 4 + r) * 64 + 4 * hi;
#pragma unroll
      for (int i = 0; i < 4; ++i) { epi::st_bf16x4(o + 8 * i, of0[4 * i], of0[4 * i + 1], of0[4 * i + 2], of0[4 * i + 3]);
                                    epi::st_bf16x4(o + 32 + 8 * i, of1[4 * i], of1[4 * i + 1], of1[4 * i + 2], of1[4 * i + 3]); } }
    TICK(7);
}
}
namespace gdn {
template <int I> struct SolveRow {
    static DI void run(float (&x)[64], const LAS float* LM, const LAS float* VF, const LAS float* KF, const LAS float* GC, bool isu, int col) {
        SolveRow<I - 1>::run(x, LM, VF, KF, GC, isu, col);
        float acc = isu ? VF[I * 128 + col] * GC[64 + I] : KF[I * 128 + col] * GC[64 + I] * GC[128 + I];
        float a1 = 0.f, a2 = 0.f, a3 = 0.f;
#pragma unroll
        for (int j = 0; j < I; ++j) { const float t = LM[I * 64 + j] * x[j]; if ((j & 3) == 0) acc -= t; else if ((j & 3) == 1) a1 -= t; else if ((j & 3) == 2) a2 -= t; else a3 -= t; }
        x[I] = (acc + a1) + (a2 + a3);
        asm volatile("" : "+v"(x[I]) :: "memory");
    }
};
template <> struct SolveRow<-1> { static DI void run(float (&)[64], const LAS float*, const LAS float*, const LAS float*, const LAS float*, bool, int) {} };
constexpr int P_KF = 0, P_VF = 32768, P_QB = 65536, P_KB = 82944, P_LM = 100352, P_GC = 116736, P_AQ = 117760  , PSTR = 136;
DI void prep_unit(const Params& p, LAS unsigned char* lds, int b, int h, int n) {
    int tid_ = threadIdx.x; asm volatile("" : "+v"(tid_)); const int tid = tid_, lane = tid & 63, wave = __builtin_amdgcn_readfirstlane(tid >> 6);
    const unsigned char* ws = p.ws;
    LAS float* KF = (LAS float*)(lds + P_KF); LAS float* VF = (LAS float*)(lds + P_VF);
    LAS bf16_t* QB = (LAS bf16_t*)(lds + P_QB); LAS bf16_t* KB = (LAS bf16_t*)(lds + P_KB);
    LAS float* LM = (LAS float*)(lds + P_LM); LAS float* GC = (LAS float*)(lds + P_GC);
    const int chunk = (b * GH + h) * NCHUNK + n;
    const size_t row0 = (size_t)b * TP + (size_t)n * 64;
    __syncthreads();
    TICK3_INIT();
    if (wave == 0) {
        const float* gt = (const float*)(ws + WS_GT) + (row0 + lane) * 32;
        float g = gt[24 + h]; const float be = gt[28 + h];
#pragma unroll
        for (int o = 1; o < 64; o <<= 1) { const float x = __shfl_up(g, o); if (lane >= o) g += x; }
        GC[lane] = g; GC[64 + lane] = be; GC[128 + lane] = __expf(g);
    }
    __syncthreads();
    TICK3(0);
    {
        const int dd = (tid & 15) * 8;
        const float* cw = p.conv_w;
        const bf16_t* ci = (const bf16_t*)(ws + WS_CI);
#pragma unroll 1
        for (int cc = 0; cc < 2; ++cc) {
            const int c = (tid >> 4) + cc * 32; const int t = n * 64 + c;
            float val[3][8];
#pragma unroll
            for (int part = 0; part < 3; ++part) {
                const int ch = part * 512 + h * 128 + dd;
                float a[8]; for (int i = 0; i < 8; ++i) a[i] = 0.f;
#pragma unroll
                for (int j = 0; j < 4; ++j) {
                    const int tj = t - 3 + j;
                    if (tj >= 0) {
                        const u32x4 xv = *(const u32x4*)(ci + ((size_t)b * TP + tj) * CCH + ch);
                        const f32x4 w0 = *(const f32x4*)(cw + j * CCH + ch), w1 = *(const f32x4*)(cw + j * CCH + ch + 4);
                        const unsigned xs[4] = {xv.x, xv.y, xv.z, xv.w};
#pragma unroll
                        for (int i = 0; i < 4; ++i) { a[2 * i] += __uint_as_float(xs[i] << 16) * (i < 2 ? w0[2 * i] : w1[2 * i - 4]); a[2 * i + 1] += __uint_as_float(xs[i] & 0xffff0000u) * (i < 2 ? w0[2 * i + 1] : w1[2 * i - 3]); }
                    }
                }
#pragma unroll
                for (int i = 0; i < 8; ++i) val[part][i] = siluf_(a[i]);
            }
            float sq = 0.f, sk = 0.f;
#pragma unroll
            for (int i = 0; i < 8; ++i) { sq += val[0][i] * val[0][i]; sk += val[1][i] * val[1][i]; }
#pragma unroll
            for (int o = 1; o < 16; o <<= 1) { sq += __shfl_xor(sq, o); sk += __shfl_xor(sk, o); }
            const float rq = rsqrtf(sq + EPS) * 0.08838834764831845f, rk = rsqrtf(sk + EPS), eg = GC[128 + c];
            float qn[8], qg[8], kn[8];
#pragma unroll
            for (int i = 0; i < 8; ++i) { qn[i] = val[0][i] * rq; qg[i] = qn[i] * eg; kn[i] = val[1][i] * rk; }
            {
              bf16_t* qf = (bf16_t*)(ws + WS_GQG) + (size_t)chunk * 8192 + (size_t)(((c >> 5) * 8 + (dd >> 4)) * 64 + (c & 31)) * 8 + ((dd >> 3) & 1) * 4;
              epi::st_bf16x4(qf, qg[0], qg[1], qg[2], qg[3]); epi::st_bf16x4(qf + 32 * 8, qg[4], qg[5], qg[6], qg[7]); }
            { u32x4 w; w.x = pk2(qn[0], qn[1]); w.y = pk2(qn[2], qn[3]); w.z = pk2(qn[4], qn[5]); w.w = pk2(qn[6], qn[7]); *(LAS u32x4*)(QB + c * PSTR + dd) = w; }
            { u32x4 w; w.x = pk2(kn[0], kn[1]); w.y = pk2(kn[2], kn[3]); w.z = pk2(kn[4], kn[5]); w.w = pk2(kn[6], kn[7]); *(LAS u32x4*)(KB + c * PSTR + dd) = w; }
            *(LAS f32x4*)(KF + c * 128 + dd) = (f32x4){kn[0], kn[1], kn[2], kn[3]}; *(LAS f32x4*)(KF + c * 128 + dd + 4) = (f32x4){kn[4], kn[5], kn[6], kn[7]};
            *(LAS f32x4*)(VF + c * 128 + dd) = (f32x4){val[2][0], val[2][1], val[2][2], val[2][3]}; *(LAS f32x4*)(VF + c * 128 + dd + 4) = (f32x4){val[2][4], val[2][5], val[2][6], val[2][7]};
        }
    }
    __syncthreads();
    TICK3(1);
    {
        const int mat = wave >> 2, ti = (wave >> 1) & 1, tj = wave & 1, hi = lane >> 5, cl = lane & 31;
        const LAS bf16_t* A = (mat == 0 ? KB : QB) + (ti * 32 + cl) * PSTR + hi * 8;
        const LAS bf16_t* B = KB + (tj * 32 + cl) * PSTR + hi * 8;
        f32x16 acc; for (int i = 0; i < 16; ++i) acc[i] = 0.f;
#pragma unroll
        for (int ks = 0; ks < 8; ++ks) acc = MFMA32(*(const LAS bf16x8*)(A + ks * 16), *(const LAS bf16x8*)(B + ks * 16), acc);
        const int j = tj * 32 + cl; const float gj = GC[j];
#pragma unroll
        for (int r = 0; r < 16; ++r) {
            const int i = ti * 32 + crow(r, hi);
            const float dec = __expf(fminf(GC[i] - gj, 0.f));
            if (mat == 0) LM[i * 64 + j] = i > j ? GC[64 + i] * acc[r] * dec : 0.f;
            else ((LAS bf16_t*)(lds + P_AQ))[(((i >> 5) * 4 + (j >> 4)) * 64 + (i & 31) + 32 * ((j >> 2) & 1)) * 8 + ((j >> 3) & 1) * 4 + (j & 3)] = f2bf(i >= j ? acc[r] * dec : 0.f);
        }
    }
    __syncthreads();
    TICK3(2);
    if (wave < 4) {
        const int cc = tid; const bool isu = cc < 128; const int col = cc & 127;
        float x[64];
        int zoff = 0; asm volatile("" : "+v"(zoff));
        SolveRow<63>::run(x, LM + zoff, VF, KF, GC + zoff, isu, col);
        if (isu) {
            float* gu = (float*)(ws + WS_GU) + (size_t)chunk * 8192 + (size_t)(col >> 5) * 2048;
#pragma unroll
            for (int ct = 0; ct < 2; ++ct)
#pragma unroll
                for (int i4 = 0; i4 < 4; ++i4)
#pragma unroll
                    for (int hh = 0; hh < 2; ++hh) { const int c0 = 32 * ct + 8 * i4 + 4 * hh;
                        *(f32x4*)(gu + ((ct * 4 + i4) * 64 + (col & 31) + 32 * hh) * 4) = (f32x4){x[c0], x[c0 + 1], x[c0 + 2], x[c0 + 3]}; }
        } else {
            LAS bf16_t* gw = (LAS bf16_t*)(lds + P_QB) + ((col >> 4) * 64 + 32 * ((col >> 2) & 1)) * 8 + ((col >> 3) & 1) * 4 + (col & 3);
#pragma unroll
            for (int i = 0; i < 64; ++i) gw[((i >> 5) * 8 * 64 + (i & 31)) * 8] = f2bf(-x[i]);
        }
    } else {
        const int t2 = tid - 256, dk = t2 & 127, c0 = (t2 >> 7) * 32; const float glast = GC[63];
        bf16_t* kg = (bf16_t*)(ws + WS_GKGT) + (size_t)chunk * 8192;
#pragma unroll
        for (int q = 0; q < 4; ++q) { const int kc = (c0 >> 4) + (q >> 1), hh = q & 1; float v[8];
#pragma unroll
            for (int e = 0; e < 8; ++e) { const int c = 16 * kc + 8 * (e >> 2) + 4 * hh + (e & 3); v[e] = KF[c * 128 + dk] * __expf(glast - GC[c]); }
            epi::st_bf16x8(kg + (size_t)(((dk >> 5) * 4 + kc) * 64 + (dk & 31) + 32 * hh) * 8, v); }
        if (t2 == 0) ((float*)(ws + WS_GGL))[chunk] = __expf(glast);
    }
    __syncthreads();
    TICK3(3);
    { const LAS u32x4* sw = (const LAS u32x4*)(lds + P_QB); u32x4* dw = (u32x4*)(p.ws + WS_GW + (size_t)chunk * 16384);
      dw[tid] = sw[tid]; dw[512 + tid] = sw[512 + tid];
      ((u32x4*)(p.ws + WS_GAQK + (size_t)chunk * 8192))[tid] = ((const LAS u32x4*)(lds + P_AQ))[tid]; }
    TICK3(4);
}

constexpr int SC_STAGE = 40960  , SC_X = 2 * SC_STAGE, SC_XB = 12288  ;
DI void scan_unit(const Params& p, LAS unsigned char* lds, int b, int h, int dvs) {
    int tid_ = threadIdx.x; asm volatile("" : "+v"(tid_)); const int tid = tid_, lane = tid & 63, wave = __builtin_amdgcn_readfirstlane(tid >> 6), hi = lane >> 5, cl = lane & 31;
    const unsigned char* ws = p.ws;
    const int chunk0 = (b * GH + h) * NCHUNK;
    __syncthreads();
    if (wave == 0) {
        f32x16 S[4]; for (int k = 0; k < 4; ++k) for (int i = 0; i < 16; ++i) S[k][i] = 0.f;
        float gl = ((const float*)(ws + WS_GGL))[chunk0];
        __syncthreads();
        for (int n = 0; n < NCHUNK; ++n) {
            const LAS unsigned char* st = lds + (n & 1) * SC_STAGE; LAS unsigned char* xb = lds + SC_X + (n & 1) * SC_XB;
            const float gln = n + 1 < NCHUNK ? ((const float*)(ws + WS_GGL))[chunk0 + n + 1] : 0.f;
            bf16x8 Sb[8];
#pragma unroll
            for (int ks = 0; ks < 8; ++ks) { Sb[ks] = attn::pack8(S[ks >> 1], (ks & 1) * 8); *(LAS bf16x8*)(xb + ks * 1024 + lane * 16) = Sb[ks]; }
            bf16x8 vb[4];
#pragma unroll
            for (int ct = 0; ct < 2; ++ct) { f32x16 vn;
#pragma unroll
                for (int i4 = 0; i4 < 4; ++i4) { const f32x4 u4 = *(const LAS f32x4*)(st + 32768 + (ct * 4 + i4) * 1024 + lane * 16); vn[4 * i4] = u4[0]; vn[4 * i4 + 1] = u4[1]; vn[4 * i4 + 2] = u4[2]; vn[4 * i4 + 3] = u4[3]; }
#pragma unroll
                for (int ks = 0; ks < 8; ++ks) vn = MFMA32(*(const LAS bf16x8*)(st + (ct * 8 + ks) * 1024 + lane * 16), Sb[ks], vn);
                vb[2 * ct] = attn::pack8(vn, 0); vb[2 * ct + 1] = attn::pack8(vn, 8);
                *(LAS bf16x8*)(xb + 8192 + (2 * ct) * 1024 + lane * 16) = vb[2 * ct]; *(LAS bf16x8*)(xb + 8192 + (2 * ct + 1) * 1024 + lane * 16) = vb[2 * ct + 1]; }
#pragma unroll
            for (int dkt = 0; dkt < 4; ++dkt) {
#pragma unroll
                for (int i = 0; i < 16; ++i) S[dkt][i] *= gl;
#pragma unroll
                for (int kc = 0; kc < 4; ++kc) S[dkt] = MFMA32(*(const LAS bf16x8*)(st + 16384 + (dkt * 4 + kc) * 1024 + lane * 16), vb[kc], S[dkt]); }
            gl = gln;
            __syncthreads();
        }
        __syncthreads();
        float* so = p.out + O_SP + (size_t)(b * GH + h) * 16384 + dvs * 32 + cl;
#pragma unroll
        for (int dkt = 0; dkt < 4; ++dkt)
#pragma unroll
            for (int r = 0; r < 16; ++r) so[(size_t)(dkt * 32 + crow(r, hi)) * 128] = S[dkt][r];
    } else if (wave <= 2) {
        const int par = wave - 1;
        bf16x8 qf[16], af[8];
#define SCAN_LDF(n_) do { const bf16_t* q_ = (const bf16_t*)(ws + WS_GQG) + (size_t)(chunk0 + (n_)) * 8192 + lane * 8; const bf16_t* a_ = (const bf16_t*)(ws + WS_GAQK) + (size_t)(chunk0 + (n_)) * 4096 + lane * 8; \
            _Pragma("unroll") for (int f = 0; f < 16; ++f) qf[f] = *(const bf16x8*)(q_ + f * 512); _Pragma("unroll") for (int f = 0; f < 8; ++f) af[f] = *(const bf16x8*)(a_ + f * 512); } while (0)
        SCAN_LDF(par);
        __syncthreads();
        for (int n = 0; n <= NCHUNK; ++n) {
            const int m = n - 1;
            if (m >= 0 && (m & 1) == par) {
                const LAS unsigned char* xb = lds + SC_X + (m & 1) * SC_XB;
                bf16x8 Sb[8], vb[4];
#pragma unroll
                for (int ks = 0; ks < 8; ++ks) Sb[ks] = *(const LAS bf16x8*)(xb + ks * 1024 + lane * 16);
#pragma unroll
                for (int kc = 0; kc < 4; ++kc) vb[kc] = *(const LAS bf16x8*)(xb + 8192 + kc * 1024 + lane * 16);
                float* og = (float*)(p.ws + WS_OG) + ((size_t)(b * GH + h) * TP + (size_t)m * 64) * 128 + dvs * 32 + cl;
#pragma unroll
                for (int ct = 0; ct < 2; ++ct) { f32x16 o; for (int i = 0; i < 16; ++i) o[i] = 0.f;
#pragma unroll
                    for (int ks = 0; ks < 8; ++ks) o = MFMA32(qf[ct * 8 + ks], Sb[ks], o);
#pragma unroll
                    for (int kc = 0; kc < 4; ++kc) o = MFMA32(af[ct * 4 + kc], vb[kc], o);
#pragma unroll
                    for (int r = 0; r < 16; ++r) og[(size_t)(ct * 32 + crow(r, hi)) * 128] = o[r]; }
                if (m + 2 < NCHUNK) SCAN_LDF(m + 2);
            }
            __syncthreads();
        }
    } else {
        const int t3 = tid - 192;
        u32x4 r0[8], r1[8], r2[8], r3[8];
#define SCAN_SRC(n_, q_) ({ const int pc_ = (q_) * 320 + t3; const unsigned char* s_ = pc_ < 1024 ? ws + WS_GW + (size_t)(chunk0 + (n_)) * 16384 + (size_t)pc_ * 16 \
            : pc_ < 2048 ? ws + WS_GKGT + (size_t)(chunk0 + (n_)) * 16384 + (size_t)(pc_ - 1024) * 16 : ws + WS_GU + (size_t)(chunk0 + (n_)) * 32768 + (size_t)dvs * 8192 + (size_t)(pc_ - 2048) * 16; s_; })
#define SCAN_ISSUE(R, n_) do { if ((n_) < NCHUNK) { _Pragma("unroll") for (int q = 0; q < 8; ++q) R[q] = *(const u32x4*)SCAN_SRC(n_, q); } } while (0)
#define SCAN_COMMIT(R, n_) do { if ((n_) < NCHUNK) { LAS unsigned char* d_ = lds + ((n_) & 1) * SC_STAGE; _Pragma("unroll") for (int q = 0; q < 8; ++q) *(LAS u32x4*)(d_ + (q * 320 + t3) * 16) = R[q]; } } while (0)
        SCAN_ISSUE(r0, 0); SCAN_ISSUE(r1, 1); SCAN_ISSUE(r2, 2); SCAN_ISSUE(r3, 3); SCAN_COMMIT(r0, 0);
        __syncthreads();
        for (int n = 0; n < NCHUNK; n += 4) {
            SCAN_COMMIT(r1, n + 1); SCAN_ISSUE(r0, n + 4); __syncthreads();
            SCAN_COMMIT(r2, n + 2); SCAN_ISSUE(r1, n + 5); __syncthreads();
            SCAN_COMMIT(r3, n + 3); SCAN_ISSUE(r2, n + 6); __syncthreads();
            SCAN_COMMIT(r0, n + 4); SCAN_ISSUE(r3, n + 7); __syncthreads();
        }
        __syncthreads();
    }
}

DI void post(const Params& p) {
    int tid_ = threadIdx.x; asm volatile("" : "+v"(tid_)); const int tid = tid_, lane = tid & 63;
    const int gh = (blockIdx.x * 512 + tid) >> 5, NGH = (gridDim.x * 512) >> 5, l32 = lane & 31;
    const f32x4 nw = *(const f32x4*)(p.gdn_norm + l32 * 4);
#pragma unroll 2
    for (int it = gh; it < MP * GH; it += NGH) {
        const int row = it >> 2, h = it & 3, b = row >> 13, t = row & (TP - 1);
        const f32x4 o = *(const f32x4*)((const float*)(p.ws + WS_OG) + ((size_t)(b * GH + h) * TP + t) * 128 + l32 * 4);
        float s = o[0] * o[0] + o[1] * o[1] + o[2] * o[2] + o[3] * o[3];
#pragma unroll
        for (int x = 1; x < 32; x <<= 1) s += __shfl_xor(s, x);
        const float rs = rsqrtf(s * (1.f / 128.f) + EPS);
        const u32x2 zz = *(const u32x2*)((const bf16_t*)(p.ws + WS_Z) + (size_t)row * 512 + h * 128 + l32 * 4);
        const float z0 = __uint_as_float(zz.x << 16), z1 = __uint_as_float(zz.x & 0xffff0000u), z2 = __uint_as_float(zz.y << 16), z3 = __uint_as_float(zz.y & 0xffff0000u);
        epi::st_bf16x4((bf16_t*)(p.ws + WS_MIX) + (size_t)row * DM + 512 + h * 128 + l32 * 4, o[0] * rs * nw[0] * siluf_(z0), o[1] * rs * nw[1] * siluf_(z1), o[2] * rs * nw[2] * siluf_(z2), o[3] * rs * nw[3] * siluf_(z3));
    }
}
}
namespace cmp {
constexpr int TSTR = 72, C_TOK = 0, C_PART = 76032, C_LDS = C_PART + 8 * 32 * 64 * 4;
constexpr int NSLAB = 8 + 128, NUNIT = NSLAB * 16;
DI void unit(const Params& p, LAS unsigned char* lds, int u) {
    int tid_ = threadIdx.x; asm volatile("" : "+v"(tid_)); const int tid = tid_, lane = tid & 63, wave = __builtin_amdgcn_readfirstlane(tid >> 6), hi = lane >> 5, cl = lane & 31;
    const unsigned char* ws = p.ws;
    const int sl = u >> 4, n0 = (u & 15) * 32;
    const bool samp = sl >= 8;
    int kv, bb, g;
    if (!samp) { kv = sl >> 2; bb = (sl >> 1) & 1; g = sl & 1; } else { const int s2 = sl - 8; kv = s2 >> 6; bb = (s2 >> 1) & 31; g = s2 & 1; }
    LAS bf16_t* TOK = (LAS bf16_t*)(lds + C_TOK); LAS float* PART = (LAS float*)(lds + C_PART);
    __syncthreads();
    if (!samp) {
        u32x4 w[9];
        const bf16_t* src = (const bf16_t*)(ws + (kv ? WS_VC : WS_KC)) + (size_t)(bb * 2 + g) * TP * 64;
#pragma unroll
        for (int q = 0; q < 9; ++q) { const int i = q * 512 + tid, tok = i >> 3, ch = i & 7, tk = n0 * 16 + tok;
            w[q] = (i < 528 * 8 && tk < TP) ? *(const u32x4*)(src + (size_t)tk * 64 + ch * 8) : (u32x4){0u, 0u, 0u, 0u}; }
#pragma unroll
        for (int q = 0; q < 9; ++q) { const int i = q * 512 + tid, tok = i >> 3, ch = i & 7;
            if (i < 528 * 8) *(LAS u32x4*)(TOK + ((tok & 15) * 33 + (tok >> 4)) * TSTR + ch * 8) = w[q]; }
    } else {
        int pg[9];
#pragma unroll
        for (int q = 0; q < 9; ++q) { const int i = q * 512 + tid, tok = i >> 3, tk = n0 * 16 + tok;
            pg[q] = (i < 528 * 8 && tk < TP) ? p.page_table[bb * NPAGES + (tk >> 7)] : -1; }
        f32x4 a[9], c[9];
#pragma unroll
        for (int q = 0; q < 9; ++q) { const int i = q * 512 + tid, tok = i >> 3, ch = i & 7, tk = n0 * 16 + tok;
            if (pg[q] >= 0) { const float* src = p.cache_kv + (((size_t)pg[q] * PAGE + (tk & 127)) * 4 + kv) * 128 + g * 64 + ch * 8;
                a[q] = __builtin_nontemporal_load((const f32x4*)src); c[q] = __builtin_nontemporal_load((const f32x4*)(src + 4)); }
            else { a[q] = (f32x4){0.f, 0.f, 0.f, 0.f}; c[q] = a[q]; } }
#pragma unroll
        for (int q = 0; q < 9; ++q) { const int i = q * 512 + tid, tok = i >> 3, ch = i & 7;
            u32x4 w; w.x = pk2(a[q][0], a[q][1]); w.y = pk2(a[q][2], a[q][3]); w.z = pk2(c[q][0], c[q][1]); w.w = pk2(c[q][2], c[q][3]);
            if (i < 528 * 8) *(LAS u32x4*)(TOK + ((tok & 15) * 33 + (tok >> 4)) * TSTR + ch * 8) = w; }
    }
    __syncthreads();
    f32x16 acc[2]; for (int i = 0; i < 16; ++i) { acc[0][i] = 0.f; acc[1][i] = 0.f; }
    const bf16_t* wt = (const bf16_t*)(ws + WS_WCMP) + (size_t)kv * 64 * 2048 + lane * 8;
#pragma unroll
    for (int k = 0; k < 16; ++k) {
        const int ks = wave * 16 + k, l = ks >> 2, d0 = (ks & 3) * 16;
        const bf16x8 a = *(const LAS bf16x8*)(TOK + ((l & 15) * 33 + cl + (l >> 4)) * TSTR + d0 + hi * 8);
        const bf16x8 b0 = *(const bf16x8*)(wt + (size_t)ks * 1024), b1 = *(const bf16x8*)(wt + (size_t)ks * 1024 + 512);
        acc[0] = MFMA32(a, b0, acc[0]); acc[1] = MFMA32(a, b1, acc[1]);
    }
#pragma unroll
    for (int et = 0; et < 2; ++et)
#pragma unroll
        for (int r = 0; r < 16; ++r) PART[(wave * 32 + crow(r, hi)) * 64 + et * 32 + cl] = acc[et][r];
    __syncthreads();
    const float* cst = (const float*)(ws + WS_CST) + kv * 64;
    for (int i = tid; i < 32 * 64; i += 512) {
        const int n = i >> 6, e = i & 63;
        float s = cst[e];
#pragma unroll
        for (int w = 0; w < 8; ++w) s += PART[(w * 32 + n) * 64 + e];
        const int ng = n0 + n;
        if (ng >= NCMP) s = 0.f;
        if (!samp) { if (kv == 0) ((bf16_t*)(p.ws + WS_CKP))[((size_t)(bb * 2 + g) * 512 + ng) * 64 + e] = f2bf(s);
                     else ((bf16_t*)(p.ws + WS_CVTP))[((size_t)(bb * 2 + g) * 64 + e) * 512 + ng] = f2bf(s); }
        else ((float*)(p.ws + (kv == 0 ? WS_CKS : WS_CVS)))[((size_t)(bb * 2 + g) * 512 + ng) * 64 + e] = s;
    }
}
constexpr int NTRUNIT = 2 * 4 * 128;
DI void tr_unit(const Params& p, LAS unsigned char* lds, int u) {
    int tid_ = threadIdx.x; asm volatile("" : "+v"(tid_)); const int tid = tid_;
    const int br = u >> 9, slab = (u >> 7) & 3, tile = u & 127;
    const bf16_t* src = (const bf16_t*)(p.ws + (br == 0 ? WS_VSEL : WS_VWIN)) + ((size_t)slab * TP + (size_t)tile * 64) * 64;
    bf16_t* dst = (bf16_t*)(p.ws + (br == 0 ? WS_VSELT : WS_VWINT)) + (size_t)slab * 64 * TP + (size_t)tile * 64;
    LAS bf16_t* T = (LAS bf16_t*)lds;
    __syncthreads();
    { const u32x4 w = *(const u32x4*)(src + (size_t)tid * 8); const int key = tid >> 3, d0 = (tid & 7) * 8; const unsigned ws4[4] = {w.x, w.y, w.z, w.w};
#pragma unroll
      for (int j = 0; j < 4; ++j) { T[(d0 + 2 * j) * 66 + key] = (bf16_t)(ws4[j] & 0xffffu); T[(d0 + 2 * j + 1) * 66 + key] = (bf16_t)(ws4[j] >> 16); } }
    __syncthreads();
    { const int d = tid >> 3, k0 = (tid & 7) * 8; unsigned o[4];
#pragma unroll
      for (int j = 0; j < 4; ++j) o[j] = (unsigned)T[d * 66 + k0 + 2 * j] | ((unsigned)T[d * 66 + k0 + 2 * j + 1] << 16);
      *(u32x4*)(dst + (size_t)d * TP + k0) = (u32x4){o[0], o[1], o[2], o[3]}; }
}
}
namespace samp {
constexpr int L_KP = 0, L_VP = 8192, L_SC = 16384, L_RED = 32768, L_QS = 34816, L_IMP = 35840, L_SELB = 36400, L_STAT = 36480;
constexpr int L_RED2 = 40960;
DI float attend(LAS unsigned char* lds, int nk) {
    int tid_ = threadIdx.x; asm volatile("" : "+v"(tid_)); const int tid = tid_, lane = tid & 63, wave = tid >> 6, kq = tid >> 4, dq = tid & 15;
    const float* const LAS* KP = (const float* const LAS*)(lds + L_KP); const float* const LAS* VP = (const float* const LAS*)(lds + L_VP);
    LAS float* SC = (LAS float*)(lds + L_SC); LAS float* RED2 = (LAS float*)(lds + L_RED2); const LAS float* QS = (const LAS float*)(lds + L_QS);
    __syncthreads();
    {
        f32x4 q[4];
#pragma unroll
        for (int r = 0; r < 4; ++r) q[r] = *(const LAS f32x4*)(QS + r * 64 + dq * 4);
        for (int j0 = 0; j0 < nk; j0 += 128) {
            f32x4 kv[4];
#pragma unroll
            for (int u = 0; u < 4; ++u) { const int j = j0 + u * 32 + kq; kv[u] = j < nk ? ((const f32x4*)KP[j])[dq] : (f32x4){0.f, 0.f, 0.f, 0.f}; }
#pragma unroll
            for (int u = 0; u < 4; ++u) { const int j = j0 + u * 32 + kq;
                float pr[4];
#pragma unroll
                for (int r = 0; r < 4; ++r) { float a = (kv[u][0] * q[r][0] + kv[u][1] * q[r][1]) + (kv[u][2] * q[r][2] + kv[u][3] * q[r][3]);
                    a += __shfl_xor(a, 1); a += __shfl_xor(a, 2); a += __shfl_xor(a, 4); a += __shfl_xor(a, 8); pr[r] = a; }
                if (j < nk && dq < 4) SC[dq * 1024 + j] = dq == 0 ? pr[0] : dq == 1 ? pr[1] : dq == 2 ? pr[2] : pr[3]; }
        }
    }
    __syncthreads();
    if (wave < 4) {
        LAS float* sc = SC + wave * 1024;
        float m = NEGBIG; for (int j = lane; j < nk; j += 64) m = fmaxf(m, sc[j]);
#pragma unroll
        for (int o = 1; o < 64; o <<= 1) m = fmaxf(m, __shfl_xor(m, o));
        float l = 0.f; for (int j = lane; j < nk; j += 64) { const float e = __builtin_amdgcn_exp2f(sc[j] - m); sc[j] = e; l += e; }
        l = wave_sum(l); const float inv = 1.f / l;
        for (int j = lane; j < nk; j += 64) sc[j] *= inv;
    }
    __syncthreads();
    {
        f32x4 acc[4]; for (int r = 0; r < 4; ++r) acc[r] = (f32x4){0.f, 0.f, 0.f, 0.f};
        for (int j0 = 0; j0 < nk; j0 += 128) {
            f32x4 vv[4];
#pragma unroll
            for (int u = 0; u < 4; ++u) { const int j = j0 + u * 32 + kq; vv[u] = j < nk ? ((const f32x4*)VP[j])[dq] : (f32x4){0.f, 0.f, 0.f, 0.f}; }
#pragma unroll
            for (int u = 0; u < 4; ++u) { const int j = j0 + u * 32 + kq;
                if (j < nk) {
#pragma unroll
                    for (int r = 0; r < 4; ++r) acc[r] += SC[r * 1024 + j] * vv[u]; } }
        }
#pragma unroll
        for (int r = 0; r < 4; ++r) *(LAS f32x4*)(RED2 + kq * 256 + r * 64 + dq * 4) = acc[r];
    }
    __syncthreads();
    float o = 0.f;
    if (tid < 256) {
#pragma unroll 8
        for (int k = 0; k < 32; ++k) o += RED2[k * 256 + tid];
    }
    return o;
}

DI void attn_unit(const Params& p, LAS unsigned char* lds, int bs, int g) {
    int tid_ = threadIdx.x; asm volatile("" : "+v"(tid_)); const int tid = tid_, lane = tid & 63, wave = tid >> 6;
    const unsigned char* ws = p.ws;
    const float* LAS* KP = (const float* LAS*)(lds + L_KP); const float* LAS* VP = (const float* LAS*)(lds + L_VP);
    LAS float* SC = (LAS float*)(lds + L_SC); LAS float* QS = (LAS float*)(lds + L_QS); LAS float* IMP = (LAS float*)(lds + L_IMP); LAS int* SELB = (LAS int*)(lds + L_SELB);
    const size_t row = (size_t)MP + bs;
    __syncthreads();
    if (tid < 256) QS[tid] = bf2f(((const bf16_t*)(ws + WS_QB))[row * 512 + g * 256 + tid]);
    float gate[3] = {0.f, 0.f, 0.f};
    if (tid < 256) { const float* gt = (const float*)(ws + WS_GT) + row * 32 + (g * 4 + (tid >> 6)) * 3; gate[0] = gt[0]; gate[1] = gt[1]; gate[2] = gt[2]; }
    { const float* ck = (const float*)(ws + WS_CKS) + (size_t)(bs * 2 + g) * 512 * 64; const float* cv = (const float*)(ws + WS_CVS) + (size_t)(bs * 2 + g) * 512 * 64;
      for (int j = tid; j < NCMP; j += 512) { KP[j] = ck + j * 64; VP[j] = cv + j * 64; } }
    float ofin = gate[0] * attend(lds, NCMP);
    if (tid < 128) { const int s = tid; float a = 0.f;
        for (int n = 4 * s - 1; n <= 4 * s + 3; ++n) if (n >= 0 && n < NCMP) a += (SC[n] + SC[1024 + n]) + (SC[2048 + n] + SC[3072 + n]);
        IMP[s] = a; }
    __syncthreads();
    if (wave == 0) {
        const unsigned long long lt = (1ull << lane) - 1ull;
        const int xA = __float_as_int(IMP[lane] + (lane == 0 ? 1e4f : 0.f)), xB = __float_as_int(IMP[64 + lane] + (lane == 63 ? 1e4f : 0.f));
        int T = 0;
        for (int bit = 30; bit >= 0; --bit) { const int T2 = T | (1 << bit); const int c = __popcll(__ballot(xA >= T2)) + __popcll(__ballot(xB >= T2)); if (c >= 15) T = T2; }
        const bool gA = xA > T, gB = xB > T, eA = xA == T, eB = xB == T;
        const int need = 15 - (__popcll(__ballot(gA)) + __popcll(__ballot(gB)));
        const unsigned long long beA = __ballot(eA), beB = __ballot(eB);
        const bool sA = gA || (eA && __popcll(beA & lt) < need), sB = gB || (eB && __popcll(beA) + __popcll(beB & lt) < need);
        const unsigned long long mA = __ballot(sA), mB = __ballot(sB);
        if (sA) SELB[__popcll(mA & lt)] = lane;
        if (sB) SELB[__popcll(mA) + __popcll(mB & lt)] = 64 + lane;
    }
    __syncthreads();
    for (int j = tid; j < 961; j += 512) {
        if (j < 960) { const int tp = SELB[j >> 6] * 64 + (j & 63); const int page = p.page_table[bs * NPAGES + (tp >> 7)];
            const float* rb = p.cache_kv + ((size_t)page * PAGE + (tp & 127)) * 512 + g * 64; KP[j] = rb + 256; VP[j] = rb + 384; }
        else { const float* rb = p.out + O_KVS + (size_t)bs * 512 + g * 64; KP[j] = rb + 256; VP[j] = rb + 384; }
    }
    ofin += gate[1] * attend(lds, 961);
    for (int j = tid; j < 513; j += 512) {
        const float* rb = j < 512 ? p.cache_win + ((size_t)bs * 512 + j) * 256 + g * 64 : p.out + O_WINS + ((size_t)bs * 512 + 511) * 256 + g * 64;
        KP[j] = rb; VP[j] = rb + 128; }
    ofin += gate[2] * attend(lds, 513);
    if (tid < 256) ((bf16_t*)(p.ws + WS_MIX))[row * DM + g * 256 + tid] = f2bf(ofin);
}

DI void gdn_unit(const Params& p, LAS unsigned char* lds, int bs, int h) {
    int tid_ = threadIdx.x; asm volatile("" : "+v"(tid_)); const int tid = tid_, lane = tid & 63;
    const unsigned char* ws = p.ws;
    LAS float* QKV = (LAS float*)lds;
    LAS float* RED = QKV + 384;
    LAS float* VN = RED + 1024;
    LAS float* ST = VN + 128;
    const size_t row = (size_t)MP + bs;
    __syncthreads();
    if (tid < 384) {
        const int part = tid >> 7, dd = tid & 127, ch = part * 512 + h * 128 + dd;
        const float* st = p.state_conv + (size_t)bs * 3 * CCH + ch;
        const float xn = p.out[O_CONVS + (size_t)(bs * 3 + 2) * CCH + ch];
        const float a = st[0] * p.conv_w[ch] + st[CCH] * p.conv_w[CCH + ch] + st[2 * CCH] * p.conv_w[2 * CCH + ch] + xn * p.conv_w[3 * CCH + ch];
        const float c = siluf_(a);
        QKV[tid] = c;
        float s = wave_sum(c * c);
        if (lane == 0) ST[tid >> 6] = s;
    }
    __syncthreads();
    const float rq = rsqrtf(ST[0] + ST[1] + EPS) * 0.08838834764831845f, rk = rsqrtf(ST[2] + ST[3] + EPS);
    const float* gt = (const float*)(ws + WS_GT) + row * 32;
    const float eg = __expf(gt[24 + h]), beta = gt[28 + h];
    const int dv = tid & 127, qd = tid >> 7;
    const float* S0 = p.state_S + (size_t)(bs * GH + h) * 16384;
    float sreg[32], ks = 0.f, qs = 0.f, qk = 0.f;
#pragma unroll
    for (int i = 0; i < 32; ++i) { const int dk = qd * 32 + i; const float s = S0[dk * 128 + dv]; sreg[i] = s; const float kk = QKV[128 + dk] * rk, qq = QKV[dk] * rq; ks += kk * s; qs += qq * s; qk += kk * qq; }
    RED[(qd * 2 + 0) * 128 + dv] = ks; RED[(qd * 2 + 1) * 128 + dv] = qs;
    if (dv == 0) ST[8 + qd] = qk;
    __syncthreads();
    const float kS = (RED[dv] + RED[256 + dv]) + (RED[512 + dv] + RED[768 + dv]);
    const float qS = (RED[128 + dv] + RED[384 + dv]) + (RED[640 + dv] + RED[896 + dv]);
    const float qkd = (ST[8] + ST[9]) + (ST[10] + ST[11]);
    const float vn = beta * (QKV[256 + dv] - eg * kS);
    const float o = eg * qS + qkd * vn;
    float* Sn = p.out + O_SS + (size_t)(bs * GH + h) * 16384;
#pragma unroll
    for (int i = 0; i < 32; ++i) { const int dk = qd * 32 + i; Sn[dk * 128 + dv] = eg * sreg[i] + QKV[128 + dk] * rk * vn; }
    if (tid < 128) {
        float s = wave_sum(o * o); if (lane == 0) ST[16 + (tid >> 6)] = s;
    }
    __syncthreads();
    if (tid < 128) {
        const float rs = rsqrtf((ST[16] + ST[17]) * (1.f / 128.f) + EPS);
        const float z = bf2f(((const bf16_t*)(ws + WS_Z))[row * 512 + h * 128 + tid]);
        ((bf16_t*)(p.ws + WS_MIX))[row * DM + 512 + h * 128 + tid] = f2bf(o * rs * p.gdn_norm[tid] * siluf_(z));
    }
}
}
#define RLX_AGENT __ATOMIC_RELAXED, __HIP_MEMORY_SCOPE_AGENT
#define XB_TMO      128
#define XB_XCNT(j)  (256  + 64 * (j))
#define XB_XSUB(j)  (1280 + 64 * (j))
#define XB_XGEN(j)  (2304 + 64 * (j))
#define XB_TOP      3328
#define XB_TOPGEN   3392
#define XCD_BAR_WORDS 3456
#define XB_SPIN_CAP (1u << 18)

__device__ __forceinline__ unsigned xb_ld(unsigned* p)              { return __hip_atomic_load(p, __ATOMIC_RELAXED, __HIP_MEMORY_SCOPE_AGENT); }
__device__ __forceinline__ unsigned xb_add(unsigned* p, unsigned v) { return __hip_atomic_fetch_add(p, v, __ATOMIC_RELAXED, __HIP_MEMORY_SCOPE_AGENT); }
__device__ __forceinline__ unsigned xb_xcc_id() { return (unsigned)__builtin_amdgcn_s_getreg((3 << 11) | 20) & 0xFu; }
#define XB_SPIN(cond, bar) do { unsigned _sp = 0; while (cond) { __builtin_amdgcn_s_sleep(1); \
    if ((++_sp & 255u) == 0u) { if (xb_ld(&(bar)[XB_TMO])) break; if (_sp > XB_SPIN_CAP) { atomicAdd(&(bar)[XB_TMO], 1u); break; } } } } while (0)

struct XcdBarrier {
    unsigned* bar; unsigned x;
    volatile LAS unsigned* st;
};

__device__ __forceinline__ XcdBarrier xcd_barrier_post(unsigned* bar, volatile LAS unsigned* st) {
    XcdBarrier b; b.bar = bar; b.x = xb_xcc_id(); b.st = st;
    if (threadIdx.x == 0) (void)xb_add(&bar[XB_XCNT(b.x)], 1u);
    return b;
}
__device__ __forceinline__ void xcd_barrier_complete(unsigned* bar, unsigned x, unsigned& nloc, unsigned& nx) {
    const unsigned G = gridDim.x * gridDim.y * gridDim.z;
    unsigned sum, cnt, mine, sp = 0u;
    for (;;) {
        sum = 0u; cnt = 0u; mine = 0u;
#pragma unroll
        for (unsigned j = 0; j < 16; ++j) { const unsigned c = xb_ld(&bar[XB_XCNT(j)]); sum += c; cnt += (c > 0u) ? 1u : 0u; mine = (j == x) ? c : mine; }
        if (sum == G) break;
        __builtin_amdgcn_s_sleep(1);
        if ((++sp & 255u) == 0u) { if (xb_ld(&bar[XB_TMO])) break; if (sp > XB_SPIN_CAP) { atomicAdd(&bar[XB_TMO], 1u); break; } }
    }
    nloc = mine > 0u ? mine : 1u; nx = cnt > 0u ? cnt : 1u;
}

__device__ __forceinline__ void xcd_barrier(const XcdBarrier& b) {
    asm volatile("s_waitcnt vmcnt(0)" ::: "memory");
    __syncthreads();
    if (threadIdx.x == 0) {
        unsigned* bar = b.bar;
        __builtin_amdgcn_s_waitcnt(0);
        unsigned nloc = b.st[0], nx = b.st[1];
        if (nloc == 0u) { xcd_barrier_complete(bar, b.x, nloc, nx); b.st[0] = nloc; b.st[1] = nx; }
        const unsigned old = xb_add(&bar[XB_XSUB(b.x)], 1u);
        const unsigned gen = old / nloc;
        if (old + 1u == (gen + 1u) * nloc) {
            __builtin_amdgcn_fence(__ATOMIC_RELEASE, "agent");
            asm volatile("s_waitcnt vmcnt(0)" ::: "memory");
            const unsigned og = xb_add(&bar[XB_TOP], 1u);
            const unsigned tg = og / nx;
            if (og + 1u == (tg + 1u) * nx) xb_add(&bar[XB_TOPGEN], 1u);
            else XB_SPIN(xb_ld(&bar[XB_TOPGEN]) == tg, bar);
            __builtin_amdgcn_fence(__ATOMIC_ACQUIRE, "agent");
            xb_add(&bar[XB_XGEN(b.x)], 1u);
            asm volatile("s_waitcnt vmcnt(0)" ::: "memory");
        } else {
            XB_SPIN(xb_ld(&bar[XB_XGEN(b.x)]) == gen, bar);
            __builtin_amdgcn_fence(__ATOMIC_ACQUIRE, "agent");
            asm volatile("s_waitcnt vmcnt(0)" ::: "memory");
        }
    }
    __syncthreads();
}
constexpr int NTHREADS = 512;
constexpr int LDS_BYTES = 147456;
constexpr int LDS_SLOT = LDS_BYTES - 16, LDS_BARW = LDS_BYTES - 32;
constexpr int CW_BAR = 4096;

DI int next_unit(unsigned* ctr, LAS unsigned char* lds) {
    LAS int* slot = (LAS int*)(lds + LDS_SLOT);
    __syncthreads();
    if (threadIdx.x == 0) *slot = (int)atomicAdd(ctr, 1u);
    __syncthreads();
    return *slot;
}

DI void phase_proj(const Params& p, LAS unsigned char* lds) {
    pg8::Gemm g{(const bf16_t*)(p.ws + WS_XN), (const bf16_t*)(p.ws + WS_WIN), MROWS, INW_PAD, DM};
    pg8::StaticOrder S; S.init(MROWS, INW_PAD, gridDim.x, blockIdx.x);
    epi::EpiProj E{p.out, p.ws, p.a_log, p.dt_bias};
    pg8::gemm_phase<epi::EpiProj, pg8::StaticOrder, true, true>(lds, g, S, E);
}
#if MK_PROBE == 2
DI void probe_prep_part(const Params& p, LAS unsigned char* lds, int part) {
    unsigned* ctr = (unsigned*)(p.ws + WS_CTL) + 512 + 16 * part;
    const int nu = part == 0 ? cmp::NUNIT : part == 1 ? NBP * GH * NCHUNK : cmp::NTRUNIT;
    for (;;) { const int u = next_unit(ctr, lds); if (u >= nu) break; Params q = p; asm volatile("" : "+s"(q.ws), "+s"(q.out));
        if (part == 0) cmp::unit(q, lds, cmp::NUNIT - 1 - u); else if (part == 1) gdn::prep_unit(q, lds, u >> 9, (u >> 7) & 3, u & 127); else cmp::tr_unit(q, lds, u); }
}
DI void probe_mix_part(const Params& p, LAS unsigned char* lds, int part) {
    unsigned* ctr = (unsigned*)(p.ws + WS_CTL) + 640 + 16 * part;
    const int nu = part == 0 ? 32 : part == 1 ? 192 : 512;
    for (;;) { const int u = next_unit(ctr, lds); if (u >= nu) break; Params q = p; asm volatile("" : "+s"(q.ws), "+s"(q.out));
        if (part == 0) gdn::scan_unit(q, lds, u >> 4, (u >> 2) & 3, u & 3);
        else if (part == 1) { if (u < 64) samp::attn_unit(q, lds, u >> 1, u & 1); else { const int v = u - 64; samp::gdn_unit(q, lds, v >> 2, v & 3); } }
        else attn::unit(q, lds, (u >> 1) & 1, u & 1, 127 - (u >> 2)); }
}
#endif
DI void phase_prep(const Params& p, LAS unsigned char* lds, int rep = 0) {
    unsigned* ctr = (unsigned*)(p.ws + WS_CTL) + 64 + 256 * rep;
    constexpr int NU = cmp::NUNIT + NBP * GH * NCHUNK + cmp::NTRUNIT;
    for (;;) {
        const int u = next_unit(ctr, lds); if (u >= NU) break;
        Params q = p; asm volatile("" : "+s"(q.ws), "+s"(q.out));
        if (u < cmp::NUNIT) { const int v = cmp::NUNIT - 1 - u; cmp::unit(q, lds, v); }
        else if (u < cmp::NUNIT + NBP * GH * NCHUNK) { const int v = u - cmp::NUNIT; gdn::prep_unit(q, lds, v >> 9, (v >> 7) & 3, v & 127); }
        else cmp::tr_unit(q, lds, u - cmp::NUNIT - NBP * GH * NCHUNK);
    }
}
DI void phase_mix(const Params& p, LAS unsigned char* lds, int rep = 0) {
    unsigned* ctr = (unsigned*)(p.ws + WS_CTL) + 128 + 256 * rep;
    for (;;) {
        const int u = next_unit(ctr, lds); if (u >= 224) break;
        Params q = p; asm volatile("" : "+s"(q.ws), "+s"(q.out));
        if (u < 32) gdn::scan_unit(q, lds, u >> 4, (u >> 2) & 3, u & 3);
        else if (u < 96) { const int v = u - 32; samp::attn_unit(q, lds, v >> 1, v & 1); }
        else { const int v = u - 96; samp::gdn_unit(q, lds, v >> 2, v & 3); }
    }
    const int myq = (int)((xb_xcc_id() >> 1) & 3u);
    for (int k = 0; k < 4; ++k) {
        const int qq = (myq + k) & 3;
        for (;;) {
            const int v = next_unit(ctr + 16 * (1 + qq), lds); if (v >= 128) break;
            Params q = p; asm volatile("" : "+s"(q.ws), "+s"(q.out));
            attn::unit(q, lds, qq >> 1, qq & 1, 127 - v);
        }
    }
}
template <int MODE> DI void skinny_rows(const Params& p, LAS unsigned char* lds, const bf16_t* A, const bf16_t* Bt, int K, int N) {
    int tid_ = threadIdx.x; asm volatile("" : "+v"(tid_)); const int tid = tid_, lane = tid & 63, wave = __builtin_amdgcn_readfirstlane(tid >> 6), hi = lane >> 5, cl = lane & 31;
    const int tile = blockIdx.x; if (tile >= N / 32) return;
    const int nks = K / 16, per = (nks + 7) / 8, k0 = wave * per, k1 = (k0 + per < nks) ? k0 + per : nks;
    const bf16_t* a = A + (size_t)(MP + cl) * K + hi * 8; const bf16_t* b = Bt + (size_t)(tile * 32 + cl) * K + hi * 8;
    f32x16 acc; for (int i = 0; i < 16; ++i) acc[i] = 0.f;
#pragma unroll 4
    for (int ks = k0; ks < k1; ++ks) acc = MFMA32(*(const bf16x8*)(a + ks * 16), *(const bf16x8*)(b + ks * 16), acc);
    LAS float* PART = (LAS float*)lds;
    __syncthreads();
#pragma unroll
    for (int r = 0; r < 16; ++r) PART[(wave * 32 + crow(r, hi)) * 32 + cl] = acc[r];
    __syncthreads();
    for (int i = tid; i < 1024; i += NTHREADS) {
        const int row = i >> 5, col = tile * 32 + (i & 31); float s = 0.f;
#pragma unroll
        for (int w = 0; w < 8; ++w) s += PART[(w * 32 + row) * 32 + (i & 31)];
        float* hp = (float*)(p.ws + WS_HP) + (size_t)(MP + row) * DM + col;
        if (MODE == 0) { const float h = p.x_sample[(size_t)row * DM + col] + s; *hp = h; ((bf16_t*)(p.ws + WS_HPB))[(size_t)(MP + row) * DM + col] = f2bf(h);
            float sq = h * h; sq += __shfl_xor(sq, 1); sq += __shfl_xor(sq, 2); sq += __shfl_xor(sq, 4); sq += __shfl_xor(sq, 8); sq += __shfl_xor(sq, 16);
            if ((i & 31) == 0) atomicAdd((float*)(p.ws + WS_SSQ1) + MP + row, sq); }
        else *hp += s;
    }
    __syncthreads();
}

DI void phase_out(const Params& p, LAS unsigned char* lds) {
    pg8::Gemm g{(const bf16_t*)(p.ws + WS_MIX), (const bf16_t*)(p.ws + WS_WOUT), MP, DM, DM};
    pg8::StaticOrder S; S.init(MP, DM, gridDim.x, blockIdx.x);
    epi::EpiOut E{p.x_prompt, p.x_sample, p.ws};
    pg8::gemm_phase<epi::EpiOut, pg8::StaticOrder, true, true>(lds, g, S, E);
    skinny_rows<0>(p, lds, (const bf16_t*)(p.ws + WS_MIX), (const bf16_t*)(p.ws + WS_WOUT), DM, DM);
}
DI void phase_up(const Params& p, LAS unsigned char* lds) {
    pg8::Gemm g{(const bf16_t*)(p.ws + WS_HPB), (const bf16_t*)(p.ws + WS_WGU), MROWS, 2 * DFF, DM};
    pg8::StaticOrder S; S.init(MROWS, 2 * DFF, gridDim.x, blockIdx.x);
    epi::EpiUp E{p.ws};
    pg8::gemm_phase<epi::EpiUp, pg8::StaticOrder, true, true>(lds, g, S, E);
}
DI void phase_down(const Params& p, LAS unsigned char* lds) {
    pg8::Gemm g{(const bf16_t*)(p.ws + WS_HID), (const bf16_t*)(p.ws + WS_WDN), MP, DM, DFF};
    pg8::StaticOrder S; S.init(MP, DM, gridDim.x, blockIdx.x);
    epi::EpiDown E{p.ws};
    pg8::gemm_phase<epi::EpiDown, pg8::StaticOrder, true, true>(lds, g, S, E);
    skinny_rows<1>(p, lds, (const bf16_t*)(p.ws + WS_HID), (const bf16_t*)(p.ws + WS_WDN), DFF, DM);
}
DI void phase_final(const Params& p) {
    int tid_ = threadIdx.x; asm volatile("" : "+v"(tid_)); const int tid = tid_, lane = tid & 63, gw = blockIdx.x * 8 + (tid >> 6), NGW = gridDim.x * 8;
    f32x4 g[4];
#pragma unroll
    for (int j = 0; j < 4; ++j) g[j] = *(const f32x4*)(p.norm_final + (j * 64 + lane) * 4);
    for (int row0 = gw; row0 < MP + NBS; row0 += 2 * NGW) {
        const int row1 = row0 + NGW; const bool has1 = row1 < MP + NBS;
        const float* h0 = (const float*)(p.ws + WS_HP) + (size_t)row0 * DM; const float* h1 = (const float*)(p.ws + WS_HP) + (size_t)(has1 ? row1 : row0) * DM;
        f32x4 v0[4], v1[4]; float s0 = 0.f, s1 = 0.f;
#pragma unroll
        for (int j = 0; j < 4; ++j) { v0[j] = __builtin_nontemporal_load((const f32x4*)(h0 + (j * 64 + lane) * 4)); v1[j] = __builtin_nontemporal_load((const f32x4*)(h1 + (j * 64 + lane) * 4)); }
#pragma unroll
        for (int j = 0; j < 4; ++j) { s0 += v0[j][0] * v0[j][0] + v0[j][1] * v0[j][1] + v0[j][2] * v0[j][2] + v0[j][3] * v0[j][3]; s1 += v1[j][0] * v1[j][0] + v1[j][1] * v1[j][1] + v1[j][2] * v1[j][2] + v1[j][3] * v1[j][3]; }
        const float r0 = rsqrtf(wave_sum(s0) * (1.f / DM) + EPS), r1 = rsqrtf(wave_sum(s1) * (1.f / DM) + EPS);
        float* o0 = row0 < MP ? p.out + O_YP + (size_t)row0 * DM : p.out + O_YS + (size_t)(row0 - MP) * DM;
#pragma unroll
        for (int j = 0; j < 4; ++j) __builtin_nontemporal_store((f32x4){v0[j][0] * r0 * g[j][0], v0[j][1] * r0 * g[j][1], v0[j][2] * r0 * g[j][2], v0[j][3] * r0 * g[j][3]}, (f32x4*)(o0 + (j * 64 + lane) * 4));
        if (has1) { float* o1 = row1 < MP ? p.out + O_YP + (size_t)row1 * DM : p.out + O_YS + (size_t)(row1 - MP) * DM;
#pragma unroll
            for (int j = 0; j < 4; ++j) __builtin_nontemporal_store((f32x4){v1[j][0] * r1 * g[j][0], v1[j][1] * r1 * g[j][1], v1[j][2] * r1 * g[j][2], v1[j][3] * r1 * g[j][3]}, (f32x4*)(o1 + (j * 64 + lane) * 4)); }
    }
}

#define LDS_DECL extern __shared__ __attribute__((aligned(16))) unsigned char lds_raw[]; LAS unsigned char* lds = (LAS unsigned char*)lds_raw
#ifndef MK_MULTI
#define MK_MULTI 0
#endif
#ifndef MK_DUP
#define MK_DUP 0
#endif
#if MK_MULTI
__global__ void __launch_bounds__(NTHREADS, 2) k_p0(Params p) { LDS_DECL; p0::run(p, lds); }
__global__ void __launch_bounds__(NTHREADS, 2) k_p1(Params p) { LDS_DECL; phase_proj(p, lds); }
__global__ void __launch_bounds__(NTHREADS, 2) k_p2(Params p) { LDS_DECL; phase_prep(p, lds); }
__global__ void __launch_bounds__(NTHREADS, 2) k_p3(Params p) { LDS_DECL; phase_mix(p, lds); }
__global__ void __launch_bounds__(NTHREADS, 2) k_p4(Params p) { gdn::post(p); }
__global__ void __launch_bounds__(NTHREADS, 2) k_p5(Params p) { LDS_DECL; phase_out(p, lds); }
__global__ void __launch_bounds__(NTHREADS, 2) k_p6(Params p) { LDS_DECL; phase_up(p, lds); }
__global__ void __launch_bounds__(NTHREADS, 2) k_p7(Params p) { LDS_DECL; phase_down(p, lds); }
__global__ void __launch_bounds__(NTHREADS, 2) k_p8(Params p) { phase_final(p); }
#else
__global__ void __launch_bounds__(NTHREADS, 2) k_mega(Params p) {
    LDS_DECL;
    cg::grid_group grid = cg::this_grid();
    if (p.ws == nullptr) grid.sync();
    if (threadIdx.x < 2) ((LAS unsigned*)(lds + LDS_BARW))[threadIdx.x] = 0u;
    __syncthreads();
    const XcdBarrier xbar = xcd_barrier_post((unsigned*)(p.ws + WS_CTL) + CW_BAR, (volatile LAS unsigned*)(lds + LDS_BARW));
#define SEAM() xcd_barrier(xbar)
#define PHASE(call) do { Params q = p; asm volatile("" : "+s"(q.ws), "+s"(q.out)); call; } while (0)
#if MK_PROBE
    unsigned long long* ts = (unsigned long long*)(p.ws + WS_CTL) + 1024;
#define STAMP(k) do { if (blockIdx.x == 0 && threadIdx.x == 0) ts[k] = __builtin_amdgcn_s_memrealtime(); } while (0)
#else
#define STAMP(k) do { } while (0)
#endif
    STAMP(0);
#if MK_PROBE >= 2
    if (blockIdx.x == 0 && threadIdx.x < 16) g_acc[threadIdx.x] = 0ull;
#endif
    PHASE(p0::run(q, lds));            SEAM();      STAMP(1);
#if MK_DUP & 1
    PHASE(p0::run(q, lds));            SEAM();
#endif
    PHASE(phase_proj(q, lds));    SEAM();      STAMP(2);
#if MK_DUP & 16
    PHASE(phase_proj(q, lds));    SEAM();
#endif
#if MK_PROBE == 2
    PHASE(probe_prep_part(q, lds, 0)); SEAM(); STAMP(10);
    PHASE(probe_prep_part(q, lds, 1)); SEAM(); STAMP(11);
    PHASE(probe_prep_part(q, lds, 2)); SEAM(); STAMP(3);
#else
    PHASE(phase_prep(q, lds));    SEAM();      STAMP(3);
#endif
#if MK_DUP & 2
    PHASE(phase_prep(q, lds, 1)); SEAM();
#endif
#if MK_PROBE == 2
    PHASE(probe_mix_part(q, lds, 0)); SEAM(); STAMP(12);
    PHASE(probe_mix_part(q, lds, 1)); SEAM(); STAMP(13);
    PHASE(probe_mix_part(q, lds, 2)); SEAM(); STAMP(4);
#else
    PHASE(phase_mix(q, lds));     SEAM();      STAMP(4);
#endif
#if MK_DUP & 4
    PHASE(phase_mix(q, lds, 1));  SEAM();
#endif
#if MK_DUP & 8
    SEAM(); SEAM(); SEAM(); SEAM(); SEAM(); SEAM(); SEAM(); SEAM();
#endif
    PHASE(gdn::post(q));          SEAM();      STAMP(5);
#if MK_DUP & 64
    PHASE(gdn::post(q));          SEAM();
#endif
    PHASE(phase_out(q, lds));     SEAM();      STAMP(6);
    PHASE(phase_up(q, lds));      SEAM();      STAMP(7);
#if MK_DUP & 32
    PHASE(phase_up(q, lds));      SEAM();
#endif
    PHASE(phase_down(q, lds));    SEAM();      STAMP(8);
    PHASE(phase_final(q));
#if MK_PROBE
    grid.sync(); STAMP(9);
    if (blockIdx.x == 0) {
        __syncthreads();
        const size_t offs[10] = {O_YP, O_YS, O_KVP, O_WINP, O_SP, O_CONVP, O_KVS, O_WINS, O_SS, O_CONVS};
#if MK_PROBE == 3
        { const unsigned long long dur[10] = {g_acc[0], g_acc[1], g_acc[2], g_acc[3], g_acc[4], g_acc[8], g_acc[9], g_acc[10], g_acc[11], ts[1] - ts[0]};
        for (int k = 0; k < 10; ++k) { int n = (int)(dur[k] / (k == 9 ? 500ull : 100ull)); if (n > 9000) n = 9000; if (n < 1) n = 1;
            unsigned* o = (unsigned*)(p.out + offs[k]); for (int i = threadIdx.x; i < n; i += NTHREADS) o[i] = 0xAAAAAAAAu; } }
        if (false)
#elif MK_PROBE == 2
        const unsigned long long dur[10] = {ts[4] - ts[13], g_acc[0], g_acc[1], g_acc[2], g_acc[3], g_acc[4], g_acc[5], g_acc[6], g_acc[7], ts[12] - ts[3]};
        for (int k = 0; k < 10; ++k) { int n = (int)(dur[k] / 500ull); if (n > 9000) n = 9000; if (n < 1) n = 1;
            unsigned* o = (unsigned*)(p.out + offs[k]); for (int i = threadIdx.x; i < n; i += NTHREADS) o[i] = 0xAAAAAAAAu; }
        if (false)
#endif
        for (int k = 0; k < 10; ++k) {
            const unsigned long long t0 = k < 9 ? ts[k] : ts[0], t1 = k < 9 ? ts[k + 1] : ts[9];
            int n = (int)((t1 - t0) / 500ull); if (k == 9) n = (int)((t1 - t0) / 2000ull);
            if (n > 9000) n = 9000; if (n < 1) n = 1;
            unsigned* o = (unsigned*)(p.out + offs[k]);
            for (int i = threadIdx.x; i < n; i += NTHREADS) o[i] = 0xAAAAAAAAu;
        }
    }
#endif
}
#endif

extern "C" void kernel_launch(void* const* d_in, const int* in_sizes, int n_in, void* d_out, int out_size, void* d_ws, size_t ws_size, hipStream_t stream) {
    static int grid = 0;
    if (grid == 0) {
        if (n_in != 20 || out_size != (int)O_END || ws_size < WS_END) { fprintf(stderr, "kernel_launch: unexpected shapes n_in %d out %d ws %zu\n", n_in, out_size, ws_size); grid = -1; return; }
        int dev = 0, cus = 0;
        (void)hipGetDevice(&dev); (void)hipDeviceGetAttribute(&cus, hipDeviceAttributeMultiprocessorCount, dev);
#if MK_MULTI
        const void* ks[] = {(const void*)k_p1, (const void*)k_p2, (const void*)k_p3, (const void*)k_p5, (const void*)k_p6, (const void*)k_p7};
        for (auto k : ks) (void)hipFuncSetAttribute(k, hipFuncAttributeMaxDynamicSharedMemorySize, LDS_BYTES);
        grid = cus > 0 ? cus : 256;
#else
        (void)hipFuncSetAttribute((const void*)k_mega, hipFuncAttributeMaxDynamicSharedMemorySize, LDS_BYTES);
        int per_cu = 0;
        if (hipOccupancyMaxActiveBlocksPerMultiprocessor(&per_cu, (const void*)k_mega, NTHREADS, LDS_BYTES) != hipSuccess || per_cu < 1) { fprintf(stderr, "kernel_launch: occupancy query failed (%d)\n", per_cu); (void)hipGetLastError(); per_cu = 1; }
        if (per_cu > 1) per_cu = 1;
        grid = (cus > 0 ? cus : 256) * per_cu;
#endif
    }
    if (grid < 0) return;
    Params p{};
    p.x_prompt = (const float*)d_in[0]; p.x_sample = (const float*)d_in[1]; p.cache_kv = (const float*)d_in[2]; p.cache_win = (const float*)d_in[3];
    p.state_S = (const float*)d_in[4]; p.state_conv = (const float*)d_in[5]; p.page_table = (const int*)d_in[6]; p.norm_mix = (const float*)d_in[7];
    p.w_in = (const float*)d_in[8]; p.cmp_pe = (const float*)d_in[9]; p.cmp_w = (const float*)d_in[10]; p.conv_w = (const float*)d_in[11];
    p.a_log = (const float*)d_in[12]; p.dt_bias = (const float*)d_in[13]; p.gdn_norm = (const float*)d_in[14]; p.w_out = (const float*)d_in[15];
    p.norm_ffn = (const float*)d_in[16]; p.w_gate_up = (const float*)d_in[17]; p.w_down = (const float*)d_in[18]; p.norm_final = (const float*)d_in[19];
    p.out = (float*)d_out; p.ws = (unsigned char*)d_ws;
    (void)hipMemsetAsync((char*)d_ws + WS_CTL, 0, WS_ZERO_BYTES, stream);
#if MK_MULTI
    hipLaunchKernelGGL(k_p0, dim3(grid), dim3(NTHREADS), 0, stream, p);
    hipLaunchKernelGGL(k_p1, dim3(grid), dim3(NTHREADS), LDS_BYTES, stream, p);
    hipLaunchKernelGGL(k_p2, dim3(grid), dim3(NTHREADS), LDS_BYTES, stream, p);
    hipLaunchKernelGGL(k_p3, dim3(grid), dim3(NTHREADS), LDS_BYTES, stream, p);
    hipLaunchKernelGGL(k_p4, dim3(grid), dim3(NTHREADS), 0, stream, p);
    hipLaunchKernelGGL(k_p5, dim3(grid), dim3(NTHREADS), LDS_BYTES, stream, p);
    hipLaunchKernelGGL(k_p6, dim3(grid), dim3(NTHREADS), LDS_BYTES, stream, p);
    hipLaunchKernelGGL(k_p7, dim3(grid), dim3(NTHREADS), LDS_BYTES, stream, p);
    hipLaunchKernelGGL(k_p8, dim3(grid), dim3(NTHREADS), 0, stream, p);
#else
    void* args[] = {&p};
    hipError_t e = hipLaunchCooperativeKernel((const void*)k_mega, dim3(grid), dim3(NTHREADS), args, LDS_BYTES, stream);
    if (e != hipSuccess) fprintf(stderr, "kernel_launch: cooperative launch failed: %s (grid %d)\n", hipGetErrorString(e), grid);
#endif
}
```
